# Optimizing an MI355X kernel written in HIP

```python
import math
import jax
import jax.numpy as jnp
from jax import lax
import numpy as np


D_MODEL = 1024
BATCH = 8
SEQ = 2048
DEPTH = 2

CTX_LEN = 256
GRID_W = 64
N_EVEN = (DEPTH + 1) // 2
N_ODD = DEPTH // 2
N_ADA = 9
D_FF = 2816

HY_WIDTH = 512
RG_WIDTH = 512
EV_IN = 3 * HY_WIDTH + 2 * RG_WIDTH
EV_MIX = HY_WIDTH + RG_WIDTH
HY_SHORT = 3
HY_EMB = 33
HY_BANDS = (HY_EMB - 1) // 2
HY_FILT_HIDDEN = 64
HY_TARGET = 1e-2
HY_DECAY_PCT_SHORT = 0.3
HY_DECAY_PCT_LONG = 1.5
HY_MAX_DECAY = math.log(HY_TARGET) / HY_DECAY_PCT_SHORT
HY_MIN_DECAY = math.log(HY_TARGET) / HY_DECAY_PCT_LONG
HY_SHIFT = 0.05
RG_CONV = 4
RG_PAD_L = 2
RG_PAD_R = 1
RG_BLOCKS = 8
RG_BLOCK_DIM = RG_WIDTH // RG_BLOCKS
RG_C = 8.0

MLA_HEADS = 16
MLA_Q_LORA = 768
MLA_KV_LORA = 256
MLA_NOPE = 64
MLA_ROPE = 32
MLA_V = 64
MLA_IN = MLA_Q_LORA + MLA_KV_LORA + MLA_ROPE
MLA_SCALE = (MLA_NOPE + MLA_ROPE) ** -0.5
ROPE_AXIS_PAIRS = MLA_ROPE // 4
ROPE_BASE = 10000.0
Q_BLOCK = 128

ALPHA = (2.0 * DEPTH) ** 0.25
BETA = (8.0 * DEPTH) ** -0.25
LN_EPS = 1e-6
RMS_EPS = 1e-6
F32 = jnp.float32

kernel_name = 'hybrid_hyena_rglru_mla_prefix_dit'


def layernorm(x, g, b):
    xf = x.astype(F32)
    mu = jnp.mean(xf, axis=-1, keepdims=True)
    var = jnp.mean(jnp.square(xf - mu), axis=-1, keepdims=True)
    return ((xf - mu) * lax.rsqrt(var + LN_EPS) * g + b).astype(x.dtype)


def rmsnorm(x, g):
    xf = x.astype(F32)
    y = xf * lax.rsqrt(jnp.mean(jnp.square(xf), axis=-1, keepdims=True) + RMS_EPS)
    return (y * g).astype(x.dtype)


def modulate(x, shift, scale):
    return x * (1 + scale) + shift


def adaln(cond, w, b):
    m = jax.nn.silu(cond) @ w + b
    return m.reshape(cond.shape[0], N_ADA, D_MODEL).transpose(1, 0, 2)[:, :, None, :]


def half_ffn(x, shift, scale, gate, w_in, w_out, g, b):
    h = modulate(x, shift, scale)
    a, u = jnp.split(h @ w_in, 2, axis=-1)
    y = (jax.nn.silu(a) * u) @ w_out
    return layernorm(ALPHA * x + 0.5 * gate * y, g, b)


def dwconv(x, w, b, pad_l, pad_r):
    L = x.shape[1]
    xp = jnp.pad(x, ((0, 0), (pad_l, pad_r), (0, 0)))
    y = xp[:, 0:L] * w[0]
    for k in range(1, w.shape[0]):
        y = y + xp[:, k:k + L] * w[k]
    return y + b


def hyena_filters(L, w1, b1, w2, b2, w3, sin_freq):
    pos = jnp.arange(L, dtype=F32)
    t = pos / L
    bands = jnp.linspace(1e-4, HY_BANDS - 1, HY_BANDS, dtype=F32)
    ang = (2.0 * math.pi * pos / L)[:, None] * bands[None, :]
    feats = jnp.concatenate([t[:, None], jnp.cos(ang), -jnp.sin(ang)], axis=-1)
    h = jnp.sin(sin_freq[0] * (feats @ w1 + b1))
    h = jnp.sin(sin_freq[1] * (h @ w2 + b2))
    h = (h @ w3).astype(F32).reshape(L, 2, HY_WIDTH)
    deltas = jnp.abs(jnp.linspace(HY_MIN_DECAY, HY_MAX_DECAY, HY_WIDTH, dtype=F32))
    window = jnp.exp(-t[:, None] * deltas[None, :]) + HY_SHIFT
    h = h * window[:, None, :]
    return h[:, 0], h[:, 1]


def bidir_fftconv(u, h_fwd, h_bwd, bias):
    L, C = h_fwd.shape
    k = jnp.concatenate([h_fwd, jnp.zeros((1, C), F32), h_bwd[1:][::-1]], axis=0)
    U = jnp.fft.rfft(u.astype(F32), n=2 * L, axis=1)
    K = jnp.fft.rfft(k, n=2 * L, axis=0)
    y = jnp.fft.irfft(U * K[None], n=2 * L, axis=1)[:, :L]
    return (y + u.astype(F32) * bias).astype(u.dtype)


def hyena(u, conv_w, conv_b, f_w1, f_b1, f_w2, f_b2, f_w3, sin_freq, bias):
    u = dwconv(u, conv_w, conv_b, 1, 1)
    x0, x1, v = jnp.split(u, 3, axis=-1)
    h_fwd, h_bwd = hyena_filters(u.shape[1], f_w1, f_b1, f_w2, f_b2, f_w3, sin_freq)
    return x0 * bidir_fftconv(v * x1, h_fwd, h_bwd, bias)


def rglru_coeffs(xc, a_w, a_b, x_w, x_b, lam):
    B, L, _ = xc.shape
    xb = xc.reshape(B, L, RG_BLOCKS, RG_BLOCK_DIM)
    r = jax.nn.sigmoid(jnp.einsum('blnd,nde->blne', xb, a_w).reshape(B, L, RG_WIDTH) + a_b)
    i = jax.nn.sigmoid(jnp.einsum('blnd,nde->blne', xb, x_w).reshape(B, L, RG_WIDTH) + x_b)
    log_a = -RG_C * r.astype(F32) * jax.nn.softplus(-lam.astype(F32))
    a = jnp.exp(log_a)
    b = jnp.sqrt(-jnp.expm1(2.0 * log_a)) * (i * xc).astype(F32)
    return a, b


def linear_scan(a, b, h0, reverse):
    if h0 is not None:
        first = -1 if reverse else 0
        b = b.at[:, first].add(a[:, first] * h0)

    def combine(e1, e2):
        a1, b1 = e1
        a2, b2 = e2
        return a1 * a2, a2 * b1 + b2

    _, h = lax.associative_scan(combine, (a, b), reverse=reverse, axis=1)
    return h


def even_mixer(h_lat, h_ctx, w_in, w_out, conv_w, conv_b, f_w1, f_b1, f_w2, f_b2, f_w3,
               sin_freq, hy_b, rc_w, rc_b, a_w, a_b, x_w, x_b, lam, need_ctx):
    def split(u):
        return (u[..., :3 * HY_WIDTH], u[..., 3 * HY_WIDTH:3 * HY_WIDTH + RG_WIDTH],
                u[..., 3 * HY_WIDTH + RG_WIDTH:])

    hy_l, rx_l, gate_l = split(h_lat @ w_in)
    hy_c, rx_c, gate_c = split(h_ctx @ w_in)
    xc_l = dwconv(rx_l, rc_w, rc_b, RG_PAD_L, RG_PAD_R)
    xc_c = dwconv(rx_c, rc_w, rc_b, RG_PAD_L, RG_PAD_R)
    rnn_l, rnn_c = [], []
    for d, reverse in enumerate((False, True)):
        a_c, b_c = rglru_coeffs(xc_c, a_w[d], a_b[d], x_w[d], x_b[d], lam[d])
        hc = linear_scan(a_c, b_c, None, reverse)
        h_final = hc[:, 0] if reverse else hc[:, -1]
        a_l, b_l = rglru_coeffs(xc_l, a_w[d], a_b[d], x_w[d], x_b[d], lam[d])
        rnn_l.append(linear_scan(a_l, b_l, h_final, reverse))
        rnn_c.append(hc)

    def merge(hy_u, rnn, gate):
        y_hy = hyena(hy_u, conv_w, conv_b, f_w1, f_b1, f_w2, f_b2, f_w3, sin_freq, hy_b)
        y_rg = (rnn[0] + rnn[1]).astype(gate.dtype) * jax.nn.gelu(gate)
        return jnp.concatenate([y_hy, y_rg], axis=-1) @ w_out

    out_lat = merge(hy_l, rnn_l, gate_l)
    out_ctx = merge(hy_c, rnn_c, gate_c) if need_ctx else None
    return out_lat, out_ctx


def mla_queries(q_c, q_norm, w_q_up):
    B, L, _ = q_c.shape
    q = (rmsnorm(q_c, q_norm) @ w_q_up).reshape(B, L, MLA_HEADS, MLA_NOPE + MLA_ROPE)
    return q[..., :MLA_NOPE], q[..., MLA_NOPE:]


def mla_kv(kv_c, kv_norm, w_kv_up):
    B, L, _ = kv_c.shape
    kv = (rmsnorm(kv_c, kv_norm) @ w_kv_up).reshape(B, L, MLA_HEADS, MLA_NOPE + MLA_V)
    return kv[..., :MLA_NOPE], kv[..., MLA_NOPE:]


def apply_rope(x, cos, sin):
    xs = x.reshape(x.shape[:-1] + (2, 2, ROPE_AXIS_PAIRS))
    x1, x2 = xs[..., 0, :], xs[..., 1, :]
    out = jnp.stack([x1 * cos - x2 * sin, x2 * cos + x1 * sin], axis=-2)
    return out.reshape(x.shape).astype(x.dtype)


def blocked_attention(q_nope, q_rope, k_nope, k_rope, v):
    B, Lq, H, _ = q_nope.shape
    nblk = Lq // Q_BLOCK

    def to_blocks(t):
        return t.reshape(B, nblk, Q_BLOCK, H, t.shape[-1]).swapaxes(0, 1)

    def one_block(qb):
        qn, qr = qb
        s = jnp.einsum('bqhd,bkhd->bhqk', qn, k_nope) + jnp.einsum('bqhr,bkr->bhqk', qr, k_rope)
        p = jax.nn.softmax(s.astype(F32) * MLA_SCALE, axis=-1)
        return jnp.einsum('bhqk,bkhd->bqhd', p.astype(v.dtype), v)

    o = lax.map(one_block, (to_blocks(q_nope), to_blocks(q_rope)))
    return o.swapaxes(0, 1).reshape(B, Lq, H, v.shape[-1])


def odd_mixer(h_lat, h_ctx, w_in, q_norm, kv_norm, w_q_up, w_kv_up, w_out, cos, sin, need_ctx):
    B, L, _ = h_lat.shape
    p_l = h_lat @ w_in
    p_c = h_ctx @ w_in
    q_cl, kv_cl, kr_l = p_l[..., :MLA_Q_LORA], p_l[..., MLA_Q_LORA:MLA_Q_LORA + MLA_KV_LORA], p_l[..., MLA_Q_LORA + MLA_KV_LORA:]
    q_cc, kv_cc, kr_c = p_c[..., :MLA_Q_LORA], p_c[..., MLA_Q_LORA:MLA_Q_LORA + MLA_KV_LORA], p_c[..., MLA_Q_LORA + MLA_KV_LORA:]
    qn_l, qr_l = mla_queries(q_cl, q_norm, w_q_up)
    kn_l, v_l = mla_kv(kv_cl, kv_norm, w_kv_up)
    kn_c, v_c = mla_kv(kv_cc, kv_norm, w_kv_up)
    qr_l = apply_rope(qr_l, cos[:, None], sin[:, None])
    kr_l = apply_rope(kr_l, cos, sin)
    o_l = blocked_attention(qn_l, qr_l,
                            jnp.concatenate([kn_l, kn_c], axis=1),
                            jnp.concatenate([kr_l, kr_c], axis=1),
                            jnp.concatenate([v_l, v_c], axis=1))
    out_lat = o_l.reshape(B, L, MLA_HEADS * MLA_V) @ w_out
    out_ctx = None
    if need_ctx:
        qn_c, qr_c = mla_queries(q_cc, q_norm, w_q_up)
        o_c = blocked_attention(qn_c, qr_c, kn_c, kr_c, v_c)
        out_ctx = o_c.reshape(B, h_ctx.shape[1], MLA_HEADS * MLA_V) @ w_out
    return out_lat, out_ctx


def setup_inputs(seed: int = 0) -> dict:
    key = jax.random.key(seed)
    keys = iter(jax.random.split(key, 48))

    def rnd(shape, std):
        return std * jax.random.normal(next(keys), shape, F32)

    a_base = jax.random.uniform(next(keys), (N_EVEN, 2, RG_WIDTH), F32, 0.9, 0.999) ** (1.0 / RG_C)
    rg_lambda = jnp.log(a_base) - jnp.log1p(-a_base)
    return {
        'x': rnd((BATCH, SEQ, D_MODEL), 1.0),
        'c': rnd((BATCH, D_MODEL), 1.0),
        'ctx': rnd((BATCH, CTX_LEN, D_MODEL), 1.0),
        'c_ctx': rnd((D_MODEL,), 1.0),
        'ada_w': rnd((DEPTH, D_MODEL, N_ADA * D_MODEL), 0.5 * D_MODEL ** -0.5),
        'ada_b': rnd((DEPTH, N_ADA * D_MODEL), 0.01),
        'ln_g': 1.0 + rnd((DEPTH, 3, D_MODEL), 0.02),
        'ln_b': rnd((DEPTH, 3, D_MODEL), 0.02),
        'ffn_w_in': rnd((DEPTH, 2, D_MODEL, 2 * D_FF), D_MODEL ** -0.5),
        'ffn_w_out': rnd((DEPTH, 2, D_FF, D_MODEL), BETA * D_FF ** -0.5),
        'ev_w_in': rnd((N_EVEN, D_MODEL, EV_IN), D_MODEL ** -0.5),
        'ev_w_out': rnd((N_EVEN, EV_MIX, D_MODEL), BETA * EV_MIX ** -0.5),
        'hy_conv_w': rnd((N_EVEN, HY_SHORT, 3 * HY_WIDTH), HY_SHORT ** -0.5),
        'hy_conv_b': rnd((N_EVEN, 3 * HY_WIDTH), 0.02),
        'hy_filt_w1': rnd((N_EVEN, HY_EMB, HY_FILT_HIDDEN), HY_EMB ** -0.5),
        'hy_filt_b1': rnd((N_EVEN, HY_FILT_HIDDEN), 0.1),
        'hy_filt_w2': rnd((N_EVEN, HY_FILT_HIDDEN, HY_FILT_HIDDEN), HY_FILT_HIDDEN ** -0.5),
        'hy_filt_b2': rnd((N_EVEN, HY_FILT_HIDDEN), 0.1),
        'hy_filt_w3': rnd((N_EVEN, HY_FILT_HIDDEN, 2 * HY_WIDTH), 0.1 * HY_FILT_HIDDEN ** -0.5),
        'hy_sin_freq': 1.0 + rnd((N_EVEN, 2, HY_FILT_HIDDEN), 0.02),
        'hy_bias': rnd((N_EVEN, HY_WIDTH), 0.5),
        'rg_conv_w': rnd((N_EVEN, RG_CONV, RG_WIDTH), RG_CONV ** -0.5),
        'rg_conv_b': rnd((N_EVEN, RG_WIDTH), 0.02),
        'rg_a_w': rnd((N_EVEN, 2, RG_BLOCKS, RG_BLOCK_DIM, RG_BLOCK_DIM), RG_BLOCK_DIM ** -0.5),
        'rg_a_b': rnd((N_EVEN, 2, RG_WIDTH), 0.02),
        'rg_x_w': rnd((N_EVEN, 2, RG_BLOCKS, RG_BLOCK_DIM, RG_BLOCK_DIM), RG_BLOCK_DIM ** -0.5),
        'rg_x_b': rnd((N_EVEN, 2, RG_WIDTH), 0.02),
        'rg_lambda': rg_lambda,
        'mla_w_in': rnd((N_ODD, D_MODEL, MLA_IN), D_MODEL ** -0.5),
        'mla_q_norm': 1.0 + rnd((N_ODD, MLA_Q_LORA), 0.02),
        'mla_kv_norm': 1.0 + rnd((N_ODD, MLA_KV_LORA), 0.02),
        'mla_w_q_up': rnd((N_ODD, MLA_Q_LORA, MLA_HEADS * (MLA_NOPE + MLA_ROPE)), MLA_Q_LORA ** -0.5),
        'mla_w_kv_up': rnd((N_ODD, MLA_KV_LORA, MLA_HEADS * (MLA_NOPE + MLA_V)), MLA_KV_LORA ** -0.5),
        'mla_w_out': rnd((N_ODD, MLA_HEADS * MLA_V, D_MODEL), BETA * (MLA_HEADS * MLA_V) ** -0.5),
    }


def reference(x, c, ctx, c_ctx, ada_w, ada_b, ln_g, ln_b, ffn_w_in, ffn_w_out, ev_w_in, ev_w_out,
              hy_conv_w, hy_conv_b, hy_filt_w1, hy_filt_b1, hy_filt_w2, hy_filt_b2, hy_filt_w3,
              hy_sin_freq, hy_bias, rg_conv_w, rg_conv_b, rg_a_w, rg_a_b, rg_x_w, rg_x_b, rg_lambda,
              mla_w_in, mla_q_norm, mla_kv_norm, mla_w_q_up, mla_w_kv_up, mla_w_out):
    L = x.shape[1]
    ROWS = L // GRID_W
    rows = jnp.repeat(jnp.arange(ROWS, dtype=F32), GRID_W)
    cols = jnp.tile(jnp.arange(GRID_W, dtype=F32), ROWS)
    inv_freq = ROPE_BASE ** (-jnp.arange(ROPE_AXIS_PAIRS, dtype=F32) / ROPE_AXIS_PAIRS)
    ang = jnp.stack([rows[:, None] * inv_freq, cols[:, None] * inv_freq], axis=1)
    cos, sin = jnp.cos(ang), jnp.sin(ang)

    x_lat, x_ctx = x, ctx
    for l in range(DEPTH):
        last = l == DEPTH - 1
        m_lat = adaln(c, ada_w[l], ada_b[l])
        m_ctx = adaln(c_ctx[None], ada_w[l], ada_b[l])
        x_lat = half_ffn(x_lat, m_lat[0], m_lat[1], m_lat[2], ffn_w_in[l, 0], ffn_w_out[l, 0], ln_g[l, 0], ln_b[l, 0])
        x_ctx = half_ffn(x_ctx, m_ctx[0], m_ctx[1], m_ctx[2], ffn_w_in[l, 0], ffn_w_out[l, 0], ln_g[l, 0], ln_b[l, 0])
        h_lat = modulate(x_lat, m_lat[3], m_lat[4])
        h_ctx = modulate(x_ctx, m_ctx[3], m_ctx[4])
        if l % 2 == 0:
            e = l // 2
            y_lat, y_ctx = even_mixer(h_lat, h_ctx, ev_w_in[e], ev_w_out[e], hy_conv_w[e], hy_conv_b[e],
                                      hy_filt_w1[e], hy_filt_b1[e], hy_filt_w2[e], hy_filt_b2[e], hy_filt_w3[e],
                                      hy_sin_freq[e], hy_bias[e], rg_conv_w[e], rg_conv_b[e], rg_a_w[e], rg_a_b[e],
                                      rg_x_w[e], rg_x_b[e], rg_lambda[e], not last)
        else:
            o = l // 2
            y_lat, y_ctx = odd_mixer(h_lat, h_ctx, mla_w_in[o], mla_q_norm[o], mla_kv_norm[o], mla_w_q_up[o],
                                     mla_w_kv_up[o], mla_w_out[o], cos, sin, not last)
        x_lat = layernorm(ALPHA * x_lat + m_lat[5] * y_lat, ln_g[l, 1], ln_b[l, 1])
        if not last:
            x_ctx = layernorm(ALPHA * x_ctx + m_ctx[5] * y_ctx, ln_g[l, 1], ln_b[l, 1])
            x_ctx = half_ffn(x_ctx, m_ctx[6], m_ctx[7], m_ctx[8], ffn_w_in[l, 1], ffn_w_out[l, 1], ln_g[l, 2], ln_b[l, 2])
        x_lat = half_ffn(x_lat, m_lat[6], m_lat[7], m_lat[8], ffn_w_in[l, 1], ffn_w_out[l, 1], ln_g[l, 2], ln_b[l, 2])
    return x_lat
```

```cpp
#include <hip/hip_runtime.h>
namespace pg8 {
#define PG8_LAS __attribute__((address_space(3)))
typedef unsigned short bf16_t;
typedef short bf16x8 __attribute__((ext_vector_type(8)));
typedef float f32x4 __attribute__((ext_vector_type(4)));
typedef unsigned u32x4 __attribute__((ext_vector_type(4)));
constexpr int BM = 256, BK = 64, HALF = 128, HTB = HALF * BK * 2  , STAGE_BYTES = 8 * HTB, NXCD = 8, WGM = 8;

__host__ __device__ __forceinline__ int lds_byte(int r, int c) { const int st = (r >> 4) * 2 + (c >> 5), rr = r & 15, cc = c & 31, ob = rr * 64 + cc * 2; return st * 1024 + (ob ^ (((ob >> 9) & 1) << 5)); }
__host__ __device__ __forceinline__ void stage_rc(int b, int& R, int& C) { const int st = b / 1024, sb = b % 1024, swz = sb ^ (((sb >> 9) & 1) << 5); R = (st >> 1) * 16 + swz / 64; C = (st & 1) * 32 + (swz % 64) / 2; }
__host__ __device__ __forceinline__ int perm32(int rho) { const int n = rho >> 4, i = rho & 15; return 8 * (i >> 2) + 4 * n + (i & 3); }

struct Unit { int pm, pn; };
struct Gemm { const bf16_t* A; const bf16_t* Bt; int M, N, K; };

struct StaticOrder {
    int nM, nN, nwg, G, c;
    __host__ __device__ void init(int M, int N, int G_, int c_) { nM = M / BM; nN = N / BM; nwg = nM * nN; G = G_; c = c_; }
    __host__ __device__ bool next(int i, Unit& u) const {
        const long L = (long)i * G + c; if (L >= nwg) return false;
        int wgid = (int)L; { const int q = nwg / NXCD, r = nwg % NXCD, xcd = wgid % NXCD, off = wgid / NXCD; wgid = (xcd < r ? xcd * (q + 1) : r * (q + 1) + (xcd - r) * q) + off; }
        const int nig = WGM * nN, gid = wgid / nig, fm = gid * WGM, gsz = (nM - fm) < WGM ? (nM - fm) : WGM;
        u.pm = fm + ((wgid % nig) % gsz); u.pn = (wgid % nig) / gsz; return true;
    }
    __device__ __forceinline__ void a_ready(const Unit&) const {}
    __device__ __forceinline__ void done(const Unit&) const {}
};
struct CountedOrder : StaticOrder {
    const unsigned* ready; unsigned need; unsigned* tmo;
    __device__ __forceinline__ void a_ready(const Unit& u) const {
        if (threadIdx.x < 64) {
            const unsigned long long t0 = __builtin_amdgcn_s_memrealtime(); unsigned polls = 0;
            while ((unsigned)__builtin_amdgcn_readfirstlane(__hip_atomic_load(ready + 64 * u.pm, __ATOMIC_RELAXED, __HIP_MEMORY_SCOPE_AGENT)) < need) {
                if ((++polls & 255u) == 0u && __builtin_amdgcn_readfirstlane(__hip_atomic_load(tmo, __ATOMIC_RELAXED, __HIP_MEMORY_SCOPE_AGENT)) != 0u) break;
                if (__builtin_amdgcn_s_memrealtime() - t0 > 2000000ull) {
                    if (threadIdx.x == 0) { unsigned expect = 0u; __hip_atomic_compare_exchange_strong(tmo + 1, &expect, 0x600u | (unsigned)(u.pm & 0xff), __ATOMIC_RELAXED, __ATOMIC_RELAXED, __HIP_MEMORY_SCOPE_AGENT); __hip_atomic_store(tmo, 1u, __ATOMIC_RELAXED, __HIP_MEMORY_SCOPE_AGENT); }
                    break; }
                __builtin_amdgcn_s_sleep(2); }
            __builtin_amdgcn_fence(__ATOMIC_ACQUIRE, "agent");
            asm volatile("s_waitcnt vmcnt(0)" ::: "memory");
        }
#if !defined(BROKEN_HOOK_NO_BARRIER)
        asm volatile("" ::: "memory"); __builtin_amdgcn_s_barrier(); asm volatile("" ::: "memory");
#endif
    }
};

__device__ __forceinline__ unsigned cvt_pk_bf16(float lo, float hi) { unsigned r; asm volatile("v_cvt_pk_bf16_f32 %0, %1, %2" : "=v"(r) : "v"(lo), "v"(hi)); return r; }
typedef float f32x2 __attribute__((ext_vector_type(2)));
__device__ __forceinline__ f32x2 gelu_pk(f32x2 v) {
    const f32x2 av = __builtin_elementwise_abs(v), d = av * 0.2316418882f + 1.0f;
    f32x2 t; t.x = __builtin_amdgcn_rcpf(d.x); t.y = __builtin_amdgcn_rcpf(d.y);
    f32x2 q = t * 0.5307027145f + (-0.7265760135f); q = q * t + 0.7107068705f; q = q * t + (-0.142248368f); q = q * t + 0.127414796f; q = q * t;
    const f32x2 s = (v * v) * (-0.72134752044f);
    f32x2 e; e.x = __builtin_amdgcn_exp2f(s.x); e.y = __builtin_amdgcn_exp2f(s.y);
    const f32x2 m = v * (q * e), r = v - m;
    f32x2 o; o.x = v.x < 0.f ? m.x : r.x; o.y = v.y < 0.f ? m.y : r.y; return o;
}

struct EpiF32 {
    static constexpr bool PERM = false, AFTER_DRAIN = false;
    float* C; int ldc; const float* bias;
    __device__ __forceinline__ void operator()(const f32x4 (&acc)[2][2][4][2], const Unit& u, int wr, int wc, int fr, int fq) const {
        const int row0 = u.pm * BM + wr * 64 + fr, col0 = u.pn * BM + wc * 32 + 4 * fq;
        f32x4 bv[2][2];
#pragma unroll
        for (int bj = 0; bj < 2; ++bj)
#pragma unroll
            for (int n = 0; n < 2; ++n) bv[bj][n] = bias ? *(const f32x4*)(bias + col0 + bj * HALF + n * 16) : (f32x4){0.f, 0.f, 0.f, 0.f};
#pragma unroll
        for (int ai = 0; ai < 2; ++ai)
#pragma unroll
            for (int m = 0; m < 4; ++m) { float* rowp = C + (size_t)(row0 + ai * HALF + m * 16) * ldc + col0;
#pragma unroll
                for (int bj = 0; bj < 2; ++bj)
#pragma unroll
                    for (int n = 0; n < 2; ++n) *(f32x4*)(rowp + bj * HALF + n * 16) = acc[ai][bj][m][n] + bv[bj][n]; }
    }
};
template <int ACT  > struct EpiBf16 {
    static constexpr bool PERM = true, AFTER_DRAIN = false;
    bf16_t* O; int ldc; const float* bias; int split_cols; size_t split_stride;
    __device__ __forceinline__ void operator()(const f32x4 (&acc)[2][2][4][2], const Unit& u, int wr, int wc, int fr, int fq) const {
        const int row0 = u.pm * BM + wr * 64 + fr; int colt = u.pn * BM; bf16_t* base = O;
        if (split_cols) { const int t = colt / split_cols; base += (size_t)t * split_stride; colt -= t * split_cols; }
        const int col0 = colt + wc * 32 + 8 * fq, bcol0 = u.pn * BM + wc * 32 + 8 * fq;
        f32x4 bv[2][2];
#pragma unroll
        for (int bj = 0; bj < 2; ++bj)
#pragma unroll
            for (int n = 0; n < 2; ++n) bv[bj][n] = bias ? *(const f32x4*)(bias + bcol0 + bj * HALF + 4 * n) : (f32x4){0.f, 0.f, 0.f, 0.f};
#pragma unroll
        for (int ai = 0; ai < 2; ++ai)
#pragma unroll
            for (int m = 0; m < 4; ++m) { bf16_t* rowp = base + (size_t)(row0 + ai * HALF + m * 16) * ldc + col0;
#pragma unroll
                for (int bj = 0; bj < 2; ++bj) { f32x4 v0 = acc[ai][bj][m][0] + bv[bj][0], v1 = acc[ai][bj][m][1] + bv[bj][1];
                    if (ACT == 1) { f32x2 a = gelu_pk((f32x2){v0[0], v0[1]}), b = gelu_pk((f32x2){v0[2], v0[3]}), c = gelu_pk((f32x2){v1[0], v1[1]}), d = gelu_pk((f32x2){v1[2], v1[3]});
                        v0 = (f32x4){a.x, a.y, b.x, b.y}; v1 = (f32x4){c.x, c.y, d.x, d.y}; }
                    if (ACT == 2) {
#pragma unroll
                        for (int j = 0; j < 4; ++j) { v0[j] = 0.5f * v0[j] * (1.0f + erff(v0[j] * 0.70710678f)); v1[j] = 0.5f * v1[j] * (1.0f + erff(v1[j] * 0.70710678f)); } }
                    u32x4 w; w.x = cvt_pk_bf16(v0[0], v0[1]); w.y = cvt_pk_bf16(v0[2], v0[3]); w.z = cvt_pk_bf16(v1[0], v1[1]); w.w = cvt_pk_bf16(v1[2], v1[3]);
                    *(u32x4*)(rowp + bj * HALF) = w; } }
    }
};

struct PanelStats {
    unsigned* xbuf;
    unsigned* cnt;
    unsigned* tmo;
    int ntn; float eps;
    unsigned code;
    __device__ __forceinline__ bool run(const f32x4 (&v)[2][2][4][2], const Unit& u, int wr, int wc, int fr, int fq, PG8_LAS unsigned char* lds, int wid, int lane) const {
        typedef float f32x2v __attribute__((ext_vector_type(2)));
        PG8_LAS f32x2v* P = (PG8_LAS f32x2v*)lds;
        PG8_LAS f32x2v* S = (PG8_LAS f32x2v*)(lds + 8192);
        PG8_LAS unsigned* flag = (PG8_LAS unsigned*)(lds + 8192 + 2048);
#pragma unroll
        for (int ai = 0; ai < 2; ++ai)
#pragma unroll
            for (int m = 0; m < 4; ++m) {
                float s = 0.f;
#pragma unroll
                for (int bj = 0; bj < 2; ++bj)
#pragma unroll
                    for (int n = 0; n < 2; ++n) { const f32x4 x = v[ai][bj][m][n]; s += (x[0] + x[1]) + (x[2] + x[3]); }
                s += __shfl_xor(s, 16); s += __shfl_xor(s, 32);
                const float mw = s * (1.0f / 64.0f); float q = 0.f;
#pragma unroll
                for (int bj = 0; bj < 2; ++bj)
#pragma unroll
                    for (int n = 0; n < 2; ++n) { const f32x4 d = v[ai][bj][m][n] - mw; q += (d[0] * d[0] + d[1] * d[1]) + (d[2] * d[2] + d[3] * d[3]); }
                q += __shfl_xor(q, 16); q += __shfl_xor(q, 32);
                if (fq == 0) P[(ai * HALF + wr * 64 + m * 16 + fr) * 4 + wc] = (f32x2v){mw, q};
            }
        asm volatile("s_waitcnt lgkmcnt(0)" ::: "memory"); __builtin_amdgcn_s_barrier(); asm volatile("" ::: "memory");
#if defined(BROKEN_NO_WAIT)
        if (blockIdx.x >= 64) { const long long t0 = clock64(); while (clock64() - t0 < 60000) __builtin_amdgcn_s_sleep(8); }
#endif
        const int row = wid * 32 + (lane & 31);
        if (lane < 32) {
            const f32x2v a = P[row * 4 + 0], b = P[row * 4 + 1], c = P[row * 4 + 2], d = P[row * 4 + 3];
            const float mt = (a.x + b.x + c.x + d.x) * 0.25f;
            const float da = a.x - mt, db = b.x - mt, dc = c.x - mt, dd = d.x - mt;
            const float m2 = (a.y + b.y) + (c.y + d.y) + 64.0f * ((da * da + db * db) + (dc * dc + dd * dd));
            unsigned long long* slot = (unsigned long long*)xbuf + ((size_t)(u.pm * BM + row) * 4 + u.pn);
            __hip_atomic_store(slot, ((unsigned long long)__float_as_uint(m2) << 32) | __float_as_uint(mt), __ATOMIC_RELAXED, __HIP_MEMORY_SCOPE_AGENT);
        }
        asm volatile("s_waitcnt vmcnt(0)" ::: "memory");
        if (lane == 0) __hip_atomic_fetch_add(cnt + 64 * u.pm, 1u, __ATOMIC_RELAXED, __HIP_MEMORY_SCOPE_AGENT);
        if (wid == 0) {
            bool dead = false; const unsigned long long t0 = __builtin_amdgcn_s_memrealtime(); const unsigned want = 8u * (unsigned)ntn;
            for (;;) {
#if defined(BROKEN_NO_WAIT)
                break;
#endif
                if ((unsigned)__builtin_amdgcn_readfirstlane(__hip_atomic_load(cnt + 64 * u.pm, __ATOMIC_RELAXED, __HIP_MEMORY_SCOPE_AGENT)) >= want) break;
                if (__builtin_amdgcn_s_memrealtime() - t0 > 2000000ull) {
                    if (lane == 0) { unsigned expect = 0u; __hip_atomic_compare_exchange_strong(tmo + 1, &expect, code | (unsigned)(u.pm & 0xff), __ATOMIC_RELAXED, __ATOMIC_RELAXED, __HIP_MEMORY_SCOPE_AGENT);
                                     __hip_atomic_store(tmo, 1u, __ATOMIC_RELAXED, __HIP_MEMORY_SCOPE_AGENT); }
                    dead = true; break; }
                __builtin_amdgcn_s_sleep(2);
            }
            __builtin_amdgcn_fence(__ATOMIC_ACQUIRE, "agent");
            if (lane == 0) flag[0] = dead ? 1u : 0u;
        }
        asm volatile("s_waitcnt vmcnt(0) lgkmcnt(0)" ::: "memory"); __builtin_amdgcn_s_barrier(); asm volatile("" ::: "memory");
        const bool bad = flag[0] != 0u;
        if (lane < 32) {
            const unsigned long long* slot = (const unsigned long long*)xbuf + (size_t)(u.pm * BM + row) * 4; float mt[4], m2[4]; float ms = 0.f;
#pragma unroll
            for (int t = 0; t < 4; ++t) { if (t < ntn) { const unsigned long long w = __hip_atomic_load(slot + t, __ATOMIC_RELAXED, __HIP_MEMORY_SCOPE_AGENT); mt[t] = __uint_as_float((unsigned)w); m2[t] = __uint_as_float((unsigned)(w >> 32)); } else { mt[t] = 0.f; m2[t] = 0.f; } ms += mt[t]; }
            const float mean = ms / (float)ntn; float q = 0.f;
#pragma unroll
            for (int t = 0; t < 4; ++t) if (t < ntn) { const float dm = mt[t] - mean; q += m2[t] + 256.0f * dm * dm; }
            S[row] = (f32x2v){mean, 1.0f / sqrtf(q / (256.0f * (float)ntn) + eps)};
        }
        asm volatile("s_waitcnt lgkmcnt(0)" ::: "memory"); __builtin_amdgcn_s_barrier(); asm volatile("" ::: "memory");
        return bad;
    }
};
struct EpiLnRes {
    static constexpr bool PERM = false, AFTER_DRAIN = true;
    const float* base; float* out; int ldc; const float* bias; PanelStats st; unsigned poison;
    __device__ __forceinline__ void refuse(size_t i0, size_t stride, int M, int N) const { const float q = __builtin_nanf(""); for (size_t i = i0; i < (size_t)M * N; i += stride) out[(i / N) * ldc + i % N] = q;
        if (i0 == 0) { unsigned expect = 0u; __hip_atomic_compare_exchange_strong(st.tmo + 1, &expect, 0x7f0u, __ATOMIC_RELAXED, __ATOMIC_RELAXED, __HIP_MEMORY_SCOPE_AGENT); __hip_atomic_store(st.tmo, 1u, __ATOMIC_RELAXED, __HIP_MEMORY_SCOPE_AGENT); } }
    __device__ __forceinline__ void fused(f32x4 (&acc)[2][2][4][2], const Unit& u, int wr, int wc, int fr, int fq, PG8_LAS unsigned char* lds, int wid, int lane) const {
        typedef float f32x2v __attribute__((ext_vector_type(2)));
        const PG8_LAS f32x2v* S = (const PG8_LAS f32x2v*)(lds + 8192);
        const int col0 = u.pn * BM + wc * 32 + 4 * fq;
#pragma unroll
        for (int bj = 0; bj < 2; ++bj)
#pragma unroll
            for (int n = 0; n < 2; ++n) { const f32x4 bv = bias ? *(const f32x4*)(bias + col0 + bj * HALF + n * 16) : (f32x4){0.f, 0.f, 0.f, 0.f};
#pragma unroll
                for (int ai = 0; ai < 2; ++ai)
#pragma unroll
                    for (int m = 0; m < 4; ++m) acc[ai][bj][m][n] += bv; }
        const bool bad = st.run(acc, u, wr, wc, fr, fq, lds, wid, lane) || poison != 0u;
        const float qnan = __builtin_nanf("");
#pragma unroll
        for (int ai = 0; ai < 2; ++ai)
#pragma unroll
            for (int m = 0; m < 4; ++m) { const int r = ai * HALF + wr * 64 + m * 16 + fr; const f32x2v sr = S[r]; const size_t off = (size_t)(u.pm * BM + r) * ldc + col0;
#pragma unroll
                for (int bj = 0; bj < 2; ++bj)
#pragma unroll
                    for (int n = 0; n < 2; ++n) { const f32x4 bs = *(const f32x4*)(base + off + bj * HALF + n * 16); f32x4 o = bs + (acc[ai][bj][m][n] - sr.x) * sr.y;
                        if (bad) o = (f32x4){qnan, qnan, qnan, qnan}; *(f32x4*)(out + off + bj * HALF + n * 16) = o; }
                asm volatile("" ::: "memory"); }
    }
};
struct EpiLnResLn {
    static constexpr bool PERM = false, AFTER_DRAIN = true;
    const float* base; float* out; bf16_t* xn; int ldc; const float* bias; PanelStats st1, st2; unsigned poison;
    __device__ __forceinline__ void refuse(size_t i0, size_t stride, int M, int N) const { const float q = __builtin_nanf(""); for (size_t i = i0; i < (size_t)M * N; i += stride) { const size_t o = (i / N) * ldc + i % N; out[o] = q; xn[o] = (bf16_t)0x7fc0u; }
        if (i0 == 0) { unsigned expect = 0u; __hip_atomic_compare_exchange_strong(st1.tmo + 1, &expect, 0x7f0u, __ATOMIC_RELAXED, __ATOMIC_RELAXED, __HIP_MEMORY_SCOPE_AGENT); __hip_atomic_store(st1.tmo, 1u, __ATOMIC_RELAXED, __HIP_MEMORY_SCOPE_AGENT); } }
    __device__ __forceinline__ void fused(f32x4 (&acc)[2][2][4][2], const Unit& u, int wr, int wc, int fr, int fq, PG8_LAS unsigned char* lds, int wid, int lane) const {
        typedef float f32x2v __attribute__((ext_vector_type(2))); typedef unsigned u32x2v __attribute__((ext_vector_type(2)));
        const PG8_LAS f32x2v* S = (const PG8_LAS f32x2v*)(lds + 8192);
        const int col0 = u.pn * BM + wc * 32 + 4 * fq;
#pragma unroll
        for (int bj = 0; bj < 2; ++bj)
#pragma unroll
            for (int n = 0; n < 2; ++n) { const f32x4 bv = bias ? *(const f32x4*)(bias + col0 + bj * HALF + n * 16) : (f32x4){0.f, 0.f, 0.f, 0.f};
#pragma unroll
                for (int ai = 0; ai < 2; ++ai)
#pragma unroll
                    for (int m = 0; m < 4; ++m) acc[ai][bj][m][n] += bv; }
        bool bad = st1.run(acc, u, wr, wc, fr, fq, lds, wid, lane) || poison != 0u;
        const float qnan = __builtin_nanf("");
#pragma unroll
        for (int ai = 0; ai < 2; ++ai)
#pragma unroll
            for (int m = 0; m < 4; ++m) { const int r = ai * HALF + wr * 64 + m * 16 + fr; const f32x2v sr = S[r]; const size_t off = (size_t)(u.pm * BM + r) * ldc + col0;
#pragma unroll
                for (int bj = 0; bj < 2; ++bj)
#pragma unroll
                    for (int n = 0; n < 2; ++n) { const f32x4 bs = *(const f32x4*)(base + off + bj * HALF + n * 16); acc[ai][bj][m][n] = bs + (acc[ai][bj][m][n] - sr.x) * sr.y; }
                asm volatile("" : "+v"(acc[ai][0][m][0]), "+v"(acc[ai][0][m][1]), "+v"(acc[ai][1][m][0]), "+v"(acc[ai][1][m][1]));
                if (m & 1) asm volatile("" ::: "memory"); }
        const bool bad1 = bad;
        bad = st2.run(acc, u, wr, wc, fr, fq, lds, wid, lane) || bad;
#pragma unroll
        for (int ai = 0; ai < 2; ++ai)
#pragma unroll
            for (int m = 0; m < 4; ++m) { const int r = ai * HALF + wr * 64 + m * 16 + fr; const f32x2v sr = S[r]; const size_t off = (size_t)(u.pm * BM + r) * ldc + col0;
#pragma unroll
                for (int bj = 0; bj < 2; ++bj)
#pragma unroll
                    for (int n = 0; n < 2; ++n) { const f32x4 x1 = acc[ai][bj][m][n]; *(f32x4*)(out + off + bj * HALF + n * 16) = bad1 ? (f32x4){qnan, qnan, qnan, qnan} : x1;
                        const f32x4 o = (x1 - sr.x) * sr.y; u32x2v w; w.x = cvt_pk_bf16(o[0], o[1]); w.y = cvt_pk_bf16(o[2], o[3]);
                        if (bad) { w.x = 0x7fc07fc0u; w.y = 0x7fc07fc0u; } *(u32x2v*)(xn + off + bj * HALF + n * 16) = w; }
                asm volatile("" ::: "memory"); }
    }
};

template <class Epi, class Sched, bool STAMP = false>
__device__ __forceinline__ void gemm_phase(PG8_LAS unsigned char* lds, const Gemm g, const Sched& S, const Epi& E, unsigned long long* stamps) {
    int tid_l = threadIdx.x; asm volatile("" : "+v"(tid_l));
    const int tid = tid_l, wid = __builtin_amdgcn_readfirstlane(tid >> 6), lane = tid & 63, wr = wid >> 2, wc = wid & 3, fr = lane & 15, fq = lane >> 4;
    const int K = g.K, nt = K / BK;
    int ts_lo = 0, ts_hi = 0, nts = 0; const unsigned long long rt_entry = STAMP ? (unsigned long long)wall_clock64() : 0ull;
#define PG8_STAMP() do { if (STAMP && wid == 0 && nts < 64) { const unsigned long long _c = (unsigned long long)clock64(); \
        ts_lo = (lane == nts) ? (int)(unsigned)_c : ts_lo; ts_hi = (lane == nts) ? (int)(unsigned)(_c >> 32) : ts_hi; ++nts; } } while (0)
    PG8_STAMP();
    unsigned voffA[2], voffB[2];
#pragma unroll
    for (int i = 0; i < 2; ++i) { int R, C; stage_rc(tid * 16 + i * 8192, R, C); const int Rb = Epi::PERM ? ((R & ~31) + perm32(R & 31)) : R;
        voffA[i] = (unsigned)(R * K + C) * 2u; voffB[i] = (unsigned)(Rb * K + C) * 2u; }
    const size_t kstep = (size_t)(BK * 2);
    const size_t hstep = (size_t)HALF * K * 2;
    const size_t tstep = 2 * hstep;
    const unsigned ldsw = (unsigned)wid * 1024u;
    const int aoff = lds_byte(wr * 64 + fr, fq * 8), boff = lds_byte(wc * 32 + fr, fq * 8);
#define PG8_SA(b, h) (((b) * 2 + (h)) * HTB)
#define PG8_SB(b, h) ((4 + (b) * 2 + (h)) * HTB)
#define PG8_STAGE(bufoff, gbase, voff) do { _Pragma("unroll") for (int _i = 0; _i < 2; ++_i) \
        __builtin_amdgcn_global_load_lds((const unsigned*)((const char*)(gbase) + (voff)[_i]), (PG8_LAS unsigned*)(lds + (bufoff) + ldsw + _i * 8192), 16, 0, 0); } while (0)
#define PG8_LDA(dst, b, h) do { _Pragma("unroll") for (int m = 0; m < 4; ++m) _Pragma("unroll") for (int k = 0; k < 2; ++k) dst[m][k] = *(const PG8_LAS bf16x8*)(lds + PG8_SA(b, h) + aoff + m * 2048 + k * 1024); } while (0)
#define PG8_LDB(dst, b, h) do { _Pragma("unroll") for (int n = 0; n < 2; ++n) _Pragma("unroll") for (int k = 0; k < 2; ++k) dst[n][k] = *(const PG8_LAS bf16x8*)(lds + PG8_SB(b, h) + boff + n * 2048 + k * 1024); } while (0)
#define PG8_MMA(ai, bj, At, Bt) do { __builtin_amdgcn_s_setprio(1); _Pragma("unroll") for (int m = 0; m < 4; ++m) _Pragma("unroll") for (int n = 0; n < 2; ++n) _Pragma("unroll") for (int k = 0; k < 2; ++k) \
        acc[ai][bj][m][n] = __builtin_amdgcn_mfma_f32_16x16x32_bf16(Bt[n][k], At[m][k], acc[ai][bj][m][n], 0, 0, 0); __builtin_amdgcn_s_setprio(0); } while (0)
#define PG8_WAIT_V(n) asm volatile("s_waitcnt vmcnt(" #n ")" ::: "memory")
#define PG8_WAIT_L(n) asm volatile("s_waitcnt lgkmcnt(" #n ")" ::: "memory")
#define PG8_BAR __builtin_amdgcn_s_barrier()
#define PG8_SCHED __builtin_amdgcn_sched_barrier(0)
    Unit cur, nxt; int ui = 0;
    if (!S.next(0, cur)) return;
    f32x4 acc[2][2][4][2];
#pragma unroll
    for (int a = 0; a < 2; ++a)
#pragma unroll
        for (int b = 0; b < 2; ++b)
#pragma unroll
            for (int m = 0; m < 4; ++m)
#pragma unroll
                for (int n = 0; n < 2; ++n) acc[a][b][m][n] = (f32x4){0.f, 0.f, 0.f, 0.f};
    bf16x8 At[4][2], B0[2][2], B1[2][2];
    const char* cA = (const char*)g.A + (size_t)cur.pm * tstep; const char* cB = (const char*)g.Bt + (size_t)cur.pn * tstep;
    S.a_ready(cur);
    PG8_STAGE(PG8_SB(0, 0), cB, voffB); PG8_STAGE(PG8_SA(0, 0), cA, voffA); PG8_STAGE(PG8_SB(0, 1), cB + hstep, voffB); PG8_STAGE(PG8_SA(0, 1), cA + hstep, voffA);
    if (wr == 1) PG8_BAR;
    PG8_WAIT_V(4); PG8_BAR;
    PG8_STAGE(PG8_SB(1, 0), cB + kstep, voffB); PG8_STAGE(PG8_SA(1, 0), cA + kstep, voffA); PG8_STAGE(PG8_SB(1, 1), cB + hstep + kstep, voffB);
    PG8_WAIT_V(6); PG8_BAR;
    PG8_STAMP();
    for (;;) {
        const bool has_next = S.next(ui + 1, nxt);
        const char* nA = has_next ? (const char*)g.A + (size_t)nxt.pm * tstep : cA; const char* nB = has_next ? (const char*)g.Bt + (size_t)nxt.pn * tstep : cB;
        for (int t = 0; t < nt; t += 2) {
            const bool last = (t == nt - 2);
            const char* a1 = cA + (size_t)(t + 1) * kstep;
            const char* a2 = last ? nA : cA + (size_t)(t + 2) * kstep; const char* b2 = last ? nB : cB + (size_t)(t + 2) * kstep;
            const char* a3 = a2 + kstep; const char* b3 = b2 + kstep;
            if (last && has_next) S.a_ready(nxt);
            PG8_LDB(B0, 0, 0); PG8_SCHED; PG8_LDA(At, 0, 0); PG8_STAGE(PG8_SA(1, 1), a1 + hstep, voffA);
            PG8_WAIT_L(8); PG8_BAR; PG8_WAIT_L(0); PG8_MMA(0, 0, At, B0); PG8_BAR; PG8_SCHED;
            PG8_LDB(B1, 0, 1); PG8_STAGE(PG8_SB(0, 0), b2, voffB);
            PG8_BAR; PG8_WAIT_L(0); PG8_MMA(0, 1, At, B1); PG8_BAR;
            PG8_LDA(At, 0, 1); PG8_STAGE(PG8_SA(0, 0), a2, voffA);
            PG8_BAR; PG8_WAIT_L(0); PG8_MMA(1, 0, At, B0); PG8_BAR; PG8_SCHED;
            PG8_STAGE(PG8_SB(0, 1), b2 + hstep, voffB);
            PG8_WAIT_V(6); PG8_BAR; PG8_MMA(1, 1, At, B1); PG8_BAR;
            PG8_LDB(B0, 1, 0); PG8_SCHED; PG8_LDA(At, 1, 0); PG8_STAGE(PG8_SA(0, 1), a2 + hstep, voffA);
            PG8_WAIT_L(8); PG8_BAR; PG8_WAIT_L(0); PG8_MMA(0, 0, At, B0); PG8_BAR; PG8_SCHED;
            PG8_LDB(B1, 1, 1); PG8_STAGE(PG8_SB(1, 0), b3, voffB);
            PG8_BAR; PG8_WAIT_L(0); PG8_MMA(0, 1, At, B1); PG8_BAR;
            PG8_LDA(At, 1, 1); PG8_STAGE(PG8_SA(1, 0), a3, voffA);
            PG8_BAR; PG8_WAIT_L(0); PG8_MMA(1, 0, At, B0); PG8_BAR; PG8_SCHED;
            PG8_STAGE(PG8_SB(1, 1), b3 + hstep, voffB);
            PG8_WAIT_V(6); PG8_BAR; PG8_MMA(1, 1, At, B1); PG8_BAR;
        }
        PG8_STAMP();
        if constexpr (!Epi::AFTER_DRAIN) { E(acc, cur, wr, wc, fr, fq); S.done(cur); }
        PG8_STAMP();
        if (!has_next) break;
#pragma unroll
        for (int a = 0; a < 2; ++a)
#pragma unroll
            for (int b = 0; b < 2; ++b)
#pragma unroll
                for (int m = 0; m < 4; ++m)
#pragma unroll
                    for (int n = 0; n < 2; ++n) acc[a][b][m][n] = (f32x4){0.f, 0.f, 0.f, 0.f};
        cur = nxt; cA = nA; cB = nB; ++ui;
    }
    PG8_WAIT_V(0);
    if (wr == 0) PG8_BAR;
    PG8_BAR;
    if constexpr (Epi::AFTER_DRAIN) { E.fused(acc, cur, wr, wc, fr, fq, lds, wid, lane); S.done(cur); }
    PG8_STAMP();
    if (STAMP && wid == 0) { stamps[lane] = lane < nts ? (((unsigned long long)(unsigned)ts_hi << 32) | (unsigned)ts_lo) : 0ull;
        if (lane == 62) stamps[62] = rt_entry; if (lane == 63) stamps[63] = (unsigned long long)wall_clock64(); }
#undef PG8_STAMP
#undef PG8_SA
#undef PG8_SB
#undef PG8_STAGE
#undef PG8_LDA
#undef PG8_LDB
#undef PG8_MMA
#undef PG8_WAIT_V
#undef PG8_WAIT_L
#undef PG8_BAR
#undef PG8_SCHED
}
}

#include <hip/hip_cooperative_groups.h>
#include <cstdio>
namespace cg = cooperative_groups;
using namespace pg8;
#define LAS PG8_LAS
typedef float f32x16 __attribute__((ext_vector_type(16)));
typedef unsigned u32x2 __attribute__((ext_vector_type(2)));

constexpr int D = 1024, NB = 8, SEQ = 2048, CTXL = 256, NLAT = NB * SEQ, NCTX = NB * CTXL, NROW = NLAT + NCTX, DFF = 2816;
constexpr float ALPHA_F = 1.41421356237309515f;
constexpr int LDS_BYTES = 135168;

constexpr size_t al256(size_t x) { return (x + 255) & ~(size_t)255; }
constexpr size_t WS_MOD = 0;
constexpr size_t WS_KF = al256(WS_MOD + (size_t)2 * 9 * 9216 * 4);
constexpr size_t WS_KFC = al256(WS_KF + (size_t)512 * 4096 * 4);
constexpr size_t WS_XCTX = al256(WS_KFC + (size_t)512 * 512 * 4);
constexpr size_t WS_AGG = al256(WS_XCTX + (size_t)NCTX * D * 4);
constexpr size_t WS_WFI = al256(WS_AGG + (size_t)2 * 8 * 36 * 512 * 2 * 4);
constexpr size_t SZ_WFI = (size_t)5632 * 1024 * 2;
constexpr size_t WS_WFO = al256(WS_WFI + 4 * SZ_WFI);
constexpr size_t SZ_WFO = (size_t)1024 * 2816 * 2;
constexpr size_t WS_WEI = al256(WS_WFO + 4 * SZ_WFO);
constexpr size_t WS_WEO = al256(WS_WEI + (size_t)2560 * 1024 * 2);
constexpr size_t WS_WRG = al256(WS_WEO + (size_t)1024 * 1024 * 2);
constexpr size_t WS_WMI = al256(WS_WRG + (size_t)2048 * 512 * 2);
constexpr size_t WS_WQU = al256(WS_WMI + (size_t)1280 * 1024 * 2);
constexpr size_t WS_WKU = al256(WS_WQU + (size_t)1536 * 768 * 2);
constexpr size_t WS_WVU = al256(WS_WKU + (size_t)1024 * 256 * 2);
constexpr size_t WS_WMO = al256(WS_WVU + (size_t)1024 * 256 * 2);
constexpr size_t WS_H = al256(WS_WMO + (size_t)1024 * 1024 * 2);
constexpr size_t WS_ACT = al256(WS_H + (size_t)NROW * D * 2);
constexpr size_t WS_G = al256(WS_ACT + (size_t)NROW * DFF * 2);
constexpr size_t WS_XC = al256(WS_G + (size_t)NROW * 2048 * 2);
constexpr size_t WS_YT = al256(WS_XC + (size_t)NROW * 512 * 2);
constexpr size_t WS_END = al256(WS_YT + (size_t)512 * NROW * 2);
constexpr size_t WS_UT = WS_ACT;
constexpr size_t WS_URG = al256(WS_UT + (size_t)1536 * NROW * 2);
constexpr size_t WS_P = WS_ACT;
constexpr size_t WS_Q = WS_ACT;
constexpr size_t WS_QN = al256(WS_ACT + (size_t)NLAT * 1536 * 2);
constexpr size_t WS_KVN = al256(WS_QN + (size_t)NLAT * 768 * 2);
constexpr size_t WS_KR = al256(WS_KVN + (size_t)NROW * 256 * 2);
static_assert(WS_KR + (size_t)NROW * 32 * 2 <= WS_G, "layer-1 aliases overflow ACT");
static_assert(WS_URG + (size_t)NROW * 1024 * 2 <= WS_G, "layer-0 aliases overflow ACT");
constexpr size_t WS_K = WS_G;
constexpr size_t WS_VT = WS_G + (size_t)NROW * 1024 * 2;

struct Params { const float* in[34]; float* out; unsigned char* ws; };
enum { I_X = 0, I_C, I_CTX, I_CCTX, I_ADAW, I_ADAB, I_LNG, I_LNB, I_FWI, I_FWO, I_EWI, I_EWO, I_HCW, I_HCB, I_HW1, I_HB1, I_HW2, I_HB2, I_HW3, I_HSF, I_HBIAS,
       I_RCW, I_RCB, I_RAW, I_RAB, I_RXW, I_RXB, I_RLAM, I_MWI, I_MQN, I_MKVN, I_MWQ, I_MWKV, I_MWO };

__device__ __forceinline__ int ltid() { int t = threadIdx.x; asm volatile("" : "+v"(t)); return t; }
__device__ __forceinline__ float bf2f(unsigned short b) { return __uint_as_float(((unsigned)b) << 16); }
__device__ __forceinline__ float bflo(unsigned w) { return __uint_as_float(w << 16); }
__device__ __forceinline__ float bfhi(unsigned w) { return __uint_as_float(w & 0xffff0000u); }
__device__ __forceinline__ float wave_sum(float v) {
#pragma unroll
  for (int o = 1; o < 64; o <<= 1) v += __shfl_xor(v, o);
  return v;
}
__device__ __forceinline__ float sigmoidf_(float x) { return 1.0f / (1.0f + __expf(-x)); }

struct EpiSwiGLU {
  static constexpr bool PERM = true, AFTER_DRAIN = false;
  bf16_t* O;
  __device__ __forceinline__ void operator()(const f32x4 (&acc)[2][2][4][2], const Unit& u, int wr, int wc, int fr, int fq) const {
    const int row0 = u.pm * BM + wr * 64 + fr, col0 = u.pn * 128 + wc * 32 + 8 * fq;
#pragma unroll
    for (int ai = 0; ai < 2; ++ai)
#pragma unroll
      for (int m = 0; m < 4; ++m) {
        float v[8];
#pragma unroll
        for (int n = 0; n < 2; ++n)
#pragma unroll
          for (int j = 0; j < 4; ++j) { const float a = acc[ai][0][m][n][j], g = acc[ai][1][m][n][j]; v[4 * n + j] = a * sigmoidf_(a) * g; }
        u32x4 w; w.x = cvt_pk_bf16(v[0], v[1]); w.y = cvt_pk_bf16(v[2], v[3]); w.z = cvt_pk_bf16(v[4], v[5]); w.w = cvt_pk_bf16(v[6], v[7]);
        *(u32x4*)(O + (size_t)(row0 + ai * HALF + m * 16) * DFF + col0) = w;
      }
  }
};
struct EpiResid {
  static constexpr bool PERM = false, AFTER_DRAIN = false;
  float* xlat; float* xctx; const float* mod; int gidx; float gs;
  __device__ __forceinline__ void operator()(const f32x4 (&acc)[2][2][4][2], const Unit& u, int wr, int wc, int fr, int fq) const {
    const int rt = u.pm * BM; const int mr = rt < NLAT ? rt / SEQ : 8;
    float* base = rt < NLAT ? xlat + (size_t)rt * D : xctx + (size_t)(rt - NLAT) * D;
    const int col0 = u.pn * BM + wc * 32 + 4 * fq;
    const float* gp = mod + (size_t)(mr * 9 + gidx) * D + col0;
    f32x4 gv[2][2];
#pragma unroll
    for (int bj = 0; bj < 2; ++bj)
#pragma unroll
      for (int n = 0; n < 2; ++n) gv[bj][n] = *(const f32x4*)(gp + bj * HALF + n * 16) * gs;
#pragma unroll
    for (int ai = 0; ai < 2; ++ai)
#pragma unroll
      for (int m = 0; m < 4; ++m) {
        float* rowp = base + (size_t)(wr * 64 + fr + ai * HALF + m * 16) * D + col0;
#pragma unroll
        for (int bj = 0; bj < 2; ++bj)
#pragma unroll
          for (int n = 0; n < 2; ++n) { f32x4 x = *(const f32x4*)(rowp + bj * HALF + n * 16); x = x * ALPHA_F + gv[bj][n] * acc[ai][bj][m][n]; *(f32x4*)(rowp + bj * HALF + n * 16) = x; }
      }
  }
};
struct EpiBf16P {
  static constexpr bool PERM = true, AFTER_DRAIN = false;
  bf16_t* O; size_t ldc;
  __device__ __forceinline__ void operator()(const f32x4 (&acc)[2][2][4][2], const Unit& u, int wr, int wc, int fr, int fq) const {
    const int row0 = u.pm * BM + wr * 64 + fr, col0 = u.pn * BM + wc * 32 + 8 * fq;
#pragma unroll
    for (int ai = 0; ai < 2; ++ai)
#pragma unroll
      for (int m = 0; m < 4; ++m) {
        bf16_t* rowp = O + (size_t)(row0 + ai * HALF + m * 16) * ldc + col0;
#pragma unroll
        for (int bj = 0; bj < 2; ++bj) { const f32x4 v0 = acc[ai][bj][m][0], v1 = acc[ai][bj][m][1];
          u32x4 w; w.x = cvt_pk_bf16(v0[0], v0[1]); w.y = cvt_pk_bf16(v0[2], v0[3]); w.z = cvt_pk_bf16(v1[0], v1[1]); w.w = cvt_pk_bf16(v1[2], v1[3]);
          *(u32x4*)(rowp + bj * HALF) = w; }
      }
  }
};
struct EpiGate {
  static constexpr bool PERM = true, AFTER_DRAIN = false;
  bf16_t* O; const float* ab; const float* xb;
  __device__ __forceinline__ void operator()(const f32x4 (&acc)[2][2][4][2], const Unit& u, int wr, int wc, int fr, int fq) const {
    const int row0 = u.pm * BM + wr * 64 + fr, col0 = u.pn * BM + wc * 32 + 8 * fq;
    f32x4 bv[2][2];
#pragma unroll
    for (int bj = 0; bj < 2; ++bj) { const int c = col0 + bj * HALF, g = c >> 9, e = c & 511; const float* bp = ((g & 1) ? xb : ab) + (g >> 1) * 512 + e;
      bv[bj][0] = *(const f32x4*)bp; bv[bj][1] = *(const f32x4*)(bp + 4); }
#pragma unroll
    for (int ai = 0; ai < 2; ++ai)
#pragma unroll
      for (int m = 0; m < 4; ++m) {
        bf16_t* rowp = O + (size_t)(row0 + ai * HALF + m * 16) * 2048 + col0;
#pragma unroll
        for (int bj = 0; bj < 2; ++bj) { f32x4 v0 = acc[ai][bj][m][0] + bv[bj][0], v1 = acc[ai][bj][m][1] + bv[bj][1];
#pragma unroll
          for (int j = 0; j < 4; ++j) { v0[j] = sigmoidf_(v0[j]); v1[j] = sigmoidf_(v1[j]); }
          u32x4 w; w.x = cvt_pk_bf16(v0[0], v0[1]); w.y = cvt_pk_bf16(v0[2], v0[3]); w.z = cvt_pk_bf16(v1[0], v1[1]); w.w = cvt_pk_bf16(v1[2], v1[3]);
          *(u32x4*)(rowp + bj * HALF) = w; }
      }
  }
};
__device__ __forceinline__ float rope_inv_freq(int p) { return exp2f(-(float)p * (13.287712379549449f / 8.0f)); }
struct EpiQ {
  static constexpr bool PERM = true, AFTER_DRAIN = false;
  bf16_t* O;
  __device__ __forceinline__ void operator()(const f32x4 (&acc)[2][2][4][2], const Unit& u, int wr, int wc, int fr, int fq) const {
    const int row0 = u.pm * BM + wr * 64 + fr, col0 = u.pn * BM + wc * 32 + 8 * fq;
#pragma unroll
    for (int bj = 0; bj < 2; ++bj) {
      const int c8 = col0 + bj * HALF; const int f = c8 % 96; const bool rope = f >= 64; const int rp = f - 64; const int a = (rp >> 4) & 1, e = (rp >> 3) & 1;
      float invf[4];
#pragma unroll
      for (int jj = 0; jj < 4; ++jj) invf[jj] = rope_inv_freq(4 * e + jj);
#pragma unroll
      for (int ai = 0; ai < 2; ++ai)
#pragma unroll
        for (int m = 0; m < 4; ++m) {
          const int row = row0 + ai * HALF + m * 16; const int t = row & (SEQ - 1); const float pos = (float)(a == 0 ? (t >> 6) : (t & 63));
          const f32x4 v0 = acc[ai][bj][m][0], v1 = acc[ai][bj][m][1];
          float v[8] = {v0[0], v0[1], v0[2], v0[3], v1[0], v1[1], v1[2], v1[3]};
          if (rope) {
#pragma unroll
            for (int jj = 0; jj < 4; ++jj) { const float ang = pos * invf[jj]; const float cs = __cosf(ang), sn = __sinf(ang); const float x1 = v[2 * jj], x2 = v[2 * jj + 1];
              v[2 * jj] = x1 * cs - x2 * sn; v[2 * jj + 1] = x2 * cs + x1 * sn; }
          }
          u32x4 w; w.x = cvt_pk_bf16(v[0], v[1]); w.y = cvt_pk_bf16(v[2], v[3]); w.z = cvt_pk_bf16(v[4], v[5]); w.w = cvt_pk_bf16(v[6], v[7]);
          *(u32x4*)(O + (size_t)row * 1536 + c8) = w;
        }
    }
  }
};

enum { MAP_ID = 0, MAP_SWIGLU, MAP_MLAIN, MAP_QUP, MAP_KUP, MAP_VUP, MAP_RG };
__device__ __forceinline__ void conv_tile(LAS float* scr, int kind, const float* W, const float* W2, const float* scale, int K, int ld, bf16_t* dst, int tile) {
  const int nkt = K >> 6; const int kt = tile % nkt, nt = tile / nkt; const int k0 = kt * 64, n0 = nt * 64;
  const int tid = ltid(), nn = tid & 63, kq = tid >> 6; const int n = n0 + nn;
  int col = n;
  if (kind == MAP_SWIGLU) { const int t = n >> 8, h = (n >> 7) & 1, j = n & 127; col = h * DFF + t * 128 + j; }
  else if (kind == MAP_MLAIN) { col = n < 1056 ? n : -1; }
  else if (kind == MAP_QUP) { const int hh = n / 96, f = n % 96; if (f >= 64) { const int rp = f - 64, a = rp >> 4, w = rp & 15, pp = w >> 1, hf = w & 1; col = hh * 96 + 64 + a * 16 + hf * 8 + pp; } }
  else if (kind == MAP_KUP) { col = (n >> 6) * 128 + (n & 63); }
  else if (kind == MAP_VUP) { col = (n >> 6) * 128 + 64 + (n & 63); }
#pragma unroll
  for (int i = 0; i < 8; ++i) {
    const int kk = i * 8 + kq, k = k0 + kk; float v;
    if (kind == MAP_RG) { const int g = n >> 9, e = n & 511, nb = e >> 6; v = ((k >> 6) == nb) ? ((g & 1) ? W2 : W)[((((g >> 1) * 8 + nb) * 64 + (k & 63)) << 6) + (e & 63)] : 0.f; }
    else v = col >= 0 ? W[(size_t)k * ld + col] : 0.f;
    if (scale) v *= scale[k];
    scr[kk * 65 + nn] = v;
  }
  __syncthreads();
  { const int nl = tid >> 3, c = tid & 7; const LAS float* s = scr + (8 * c) * 65 + nl;
    u32x4 o; o.x = cvt_pk_bf16(s[0], s[65]); o.y = cvt_pk_bf16(s[2 * 65], s[3 * 65]); o.z = cvt_pk_bf16(s[4 * 65], s[5 * 65]); o.w = cvt_pk_bf16(s[6 * 65], s[7 * 65]);
    *(u32x4*)(dst + (size_t)(n0 + nl) * K + k0 + 8 * c) = o; }
  __syncthreads();
}
__device__ __forceinline__ void adaln_job(LAS float* L, const Params& p, int z, float* MOD, int job) {
  const int tid = ltid(); const int l = job / 144, col0 = (job % 144) * 64;
  for (int i = tid; i < 9 * 1024; i += 512) { const int r = i >> 10, k = i & 1023; const float x = r < 8 ? p.in[I_C + z][r * 1024 + k] : p.in[I_CCTX + z][k]; L[i] = x * sigmoidf_(x); }
  __syncthreads();
  const int col = tid & 63, kg = tid >> 6;
  const float* W = p.in[I_ADAW + z] + (size_t)l * 1024 * 9216 + col0 + col;
  float acc[9];
#pragma unroll
  for (int r = 0; r < 9; ++r) acc[r] = 0.f;
#pragma unroll 4
  for (int k = kg * 128; k < kg * 128 + 128; ++k) { const float w = W[(size_t)k * 9216];
#pragma unroll
    for (int r = 0; r < 9; ++r) acc[r] += L[r * 1024 + k] * w; }
  LAS float* part = L + 9 * 1024;
#pragma unroll
  for (int r = 0; r < 9; ++r) part[(kg * 9 + r) * 64 + col] = acc[r];
  __syncthreads();
  for (int i = tid; i < 576; i += 512) { const int r = i >> 6, cc = i & 63; float s = 0.f;
#pragma unroll
    for (int g = 0; g < 8; ++g) s += part[(g * 9 + r) * 64 + cc];
    MOD[(size_t)(l * 9 + r) * 9216 + col0 + cc] = s + p.in[I_ADAB + z][l * 9216 + col0 + cc]; }
  __syncthreads();
}
__device__ __forceinline__ void filter_job(LAS float* Ls, const Params& p, int z, float* KF, int L, int job) {
  const int tid = ltid(); const int pos0 = job * 8;
  LAS float* feats = Ls; LAS float* h1 = Ls + 8 * 33; LAS float* h2 = h1 + 512;
  if (tid < 8 * 33) { const int pp = tid / 33, i = tid % 33; const float pos = (float)(pos0 + pp); const float t = pos / (float)L; float v;
    if (i == 0) v = t;
    else { const int j = (i - 1) & 15; const float band = 1e-4f + (float)j * ((15.0f - 1e-4f) / 15.0f); const float rev = t * band;
      v = (i <= 16) ? __builtin_amdgcn_cosf(rev) : -__builtin_amdgcn_sinf(rev); }
    feats[tid] = v; }
  __syncthreads();
  { const int pp = tid >> 6, j = tid & 63; float s = p.in[I_HB1 + z][j];
    for (int i = 0; i < 33; ++i) s += feats[pp * 33 + i] * p.in[I_HW1 + z][i * 64 + j];
    h1[tid] = __sinf(p.in[I_HSF + z][j] * s); }
  __syncthreads();
  { const int pp = tid >> 6, j = tid & 63; float s = p.in[I_HB2 + z][j];
    for (int i = 0; i < 64; ++i) s += h1[pp * 64 + i] * p.in[I_HW2 + z][i * 64 + j];
    h2[tid] = __sinf(p.in[I_HSF + z][64 + j] * s); }
  __syncthreads();
  const int ch = tid; const float delta = fabsf(-3.0701134573253945f + (float)ch * ((-15.350567286626973f + 3.0701134573253945f) / 511.0f));
#pragma unroll
  for (int q = 0; q < 2; ++q) {
    const int n = q * 512 + ch; float acc[8];
#pragma unroll
    for (int pp = 0; pp < 8; ++pp) acc[pp] = 0.f;
    for (int i = 0; i < 64; ++i) { const float w = p.in[I_HW3 + z][i * 1024 + n];
#pragma unroll
      for (int pp = 0; pp < 8; ++pp) acc[pp] += h2[pp * 64 + i] * w; }
#pragma unroll
    for (int pp = 0; pp < 8; ++pp) { const int d = pos0 + pp; const float t = (float)d / (float)L; const float val = acc[pp] * (__expf(-t * delta) + 0.05f);
      if (q == 0) KF[(size_t)ch * (2 * L) + L + d] = val; else if (d >= 1) KF[(size_t)ch * (2 * L) + L - d] = val; }
  }
  __syncthreads();
}

__device__ __forceinline__ void row_pass(const float* srcLat, const float* srcCtx, float* dstLat, float* dstCtx, bool do_ln, const float* g, const float* b, bf16_t* H, const float* modn  , int sidx, int nrows) {
  const int lane = ltid() & 63; const int gw = blockIdx.x * 8 + (ltid() >> 6), ngw = gridDim.x * 8;
  for (int row = gw; row < nrows; row += ngw) {
    const bool lat = row < NLAT; const float* src = lat ? srcLat + (size_t)row * D : srcCtx + (size_t)(row - NLAT) * D;
    float* dst = lat ? dstLat + (size_t)row * D : dstCtx + (size_t)(row - NLAT) * D;
    f32x4 v[4];
#pragma unroll
    for (int j = 0; j < 4; ++j) v[j] = *(const f32x4*)(src + lane * 4 + 256 * j);
    if (do_ln) {
      float s = 0.f;
#pragma unroll
      for (int j = 0; j < 4; ++j) s += (v[j][0] + v[j][1]) + (v[j][2] + v[j][3]);
      const float mean = wave_sum(s) * (1.0f / D); float q = 0.f;
#pragma unroll
      for (int j = 0; j < 4; ++j) { v[j] = v[j] - mean; q += (v[j][0] * v[j][0] + v[j][1] * v[j][1]) + (v[j][2] * v[j][2] + v[j][3] * v[j][3]); }
      const float rstd = 1.0f / sqrtf(wave_sum(q) * (1.0f / D) + 1e-6f);
#pragma unroll
      for (int j = 0; j < 4; ++j) { const f32x4 gg = *(const f32x4*)(g + lane * 4 + 256 * j), bb = *(const f32x4*)(b + lane * 4 + 256 * j); v[j] = v[j] * rstd * gg + bb; }
    }
    if (do_ln || src != dst) {
#pragma unroll
      for (int j = 0; j < 4; ++j) *(f32x4*)(dst + lane * 4 + 256 * j) = v[j];
    }
    if (H) {
      const int mr = lat ? row / SEQ : 8; const float* sh = modn + (size_t)(mr * 9 + sidx) * D; const float* sc = sh + D;
#pragma unroll
      for (int j = 0; j < 4; ++j) { const f32x4 s1 = *(const f32x4*)(sh + lane * 4 + 256 * j), s2 = *(const f32x4*)(sc + lane * 4 + 256 * j); const f32x4 h = v[j] * (s2 + 1.0f) + s1;
        u32x2 w; w.x = cvt_pk_bf16(h[0], h[1]); w.y = cvt_pk_bf16(h[2], h[3]); *(u32x2*)(H + (size_t)row * D + lane * 4 + 256 * j) = w; }
    }
  }
}
__device__ __forceinline__ void mla_rownorm(const bf16_t* P, bf16_t* QN, bf16_t* KVN, bf16_t* KR) {
  const int lane = ltid() & 63; const int gw = blockIdx.x * 8 + (ltid() >> 6), ngw = gridDim.x * 8;
  for (int row = gw; row < NROW; row += ngw) {
    const bf16_t* pr = P + (size_t)row * 1280; const bool lat = row < NLAT;
    if (lat) {
      u32x2 w[3]; float ss = 0.f;
#pragma unroll
      for (int j = 0; j < 3; ++j) { w[j] = *(const u32x2*)(pr + lane * 4 + 256 * j); const float a = bflo(w[j].x), b = bfhi(w[j].x), c = bflo(w[j].y), d = bfhi(w[j].y); ss += (a * a + b * b) + (c * c + d * d); }
      const float r = 1.0f / sqrtf(wave_sum(ss) * (1.0f / 768.0f) + 1e-6f);
#pragma unroll
      for (int j = 0; j < 3; ++j) { u32x2 o; o.x = cvt_pk_bf16(bflo(w[j].x) * r, bfhi(w[j].x) * r); o.y = cvt_pk_bf16(bflo(w[j].y) * r, bfhi(w[j].y) * r); *(u32x2*)(QN + (size_t)row * 768 + lane * 4 + 256 * j) = o; }
    }
    { const u32x2 w = *(const u32x2*)(pr + 768 + lane * 4); const float a = bflo(w.x), b = bfhi(w.x), c = bflo(w.y), d = bfhi(w.y);
      const float r = 1.0f / sqrtf(wave_sum((a * a + b * b) + (c * c + d * d)) * (1.0f / 256.0f) + 1e-6f);
      u32x2 o; o.x = cvt_pk_bf16(a * r, b * r); o.y = cvt_pk_bf16(c * r, d * r); *(u32x2*)(KVN + (size_t)row * 256 + lane * 4) = o; }
    if (lane < 16) { const int a = lane >> 3, pp = lane & 7; float x1 = bf2f(pr[1024 + a * 16 + pp]), x2 = bf2f(pr[1024 + a * 16 + 8 + pp]);
      if (lat) { const int t = row & (SEQ - 1); const float pos = (float)(a == 0 ? (t >> 6) : (t & 63)); const float ang = pos * rope_inv_freq(pp); const float cs = __cosf(ang), sn = __sinf(ang);
        const float o1 = x1 * cs - x2 * sn, o2 = x2 * cs + x1 * sn; x1 = o1; x2 = o2; }
      *(unsigned*)(KR + (size_t)row * 32 + a * 16 + 2 * pp) = cvt_pk_bf16(x1, x2); }
  }
}

__device__ __forceinline__ void xc_build(const Params& p, int z, const bf16_t* URG, bf16_t* XC) {
  const float* cw = p.in[I_RCW + z]; const float* cb = p.in[I_RCB + z];
  for (int it = blockIdx.x * 512 + ltid(); it < NROW * 64; it += gridDim.x * 512) {
    const int row = it >> 6, c8 = (it & 63) * 8; int t, Ls; if (row < NLAT) { t = row & (SEQ - 1); Ls = SEQ; } else { t = (row - NLAT) & (CTXL - 1); Ls = CTXL; }
    float acc[8];
#pragma unroll
    for (int j = 0; j < 8; ++j) acc[j] = cb[c8 + j];
#pragma unroll
    for (int k = 0; k < 4; ++k) { const int tt = t + k - 2; if (tt >= 0 && tt < Ls) { const u32x4 w = *(const u32x4*)(URG + (size_t)(row + k - 2) * 1024 + c8);
        const f32x4 w0 = *(const f32x4*)(cw + k * 512 + c8), w1 = *(const f32x4*)(cw + k * 512 + c8 + 4);
        acc[0] += bflo(w.x) * w0[0]; acc[1] += bfhi(w.x) * w0[1]; acc[2] += bflo(w.y) * w0[2]; acc[3] += bfhi(w.y) * w0[3];
        acc[4] += bflo(w.z) * w1[0]; acc[5] += bfhi(w.z) * w1[1]; acc[6] += bflo(w.w) * w1[2]; acc[7] += bfhi(w.w) * w1[3]; } }
    u32x4 o; o.x = cvt_pk_bf16(acc[0], acc[1]); o.y = cvt_pk_bf16(acc[2], acc[3]); o.z = cvt_pk_bf16(acc[4], acc[5]); o.w = cvt_pk_bf16(acc[6], acc[7]);
    *(u32x4*)(XC + (size_t)row * 512 + c8) = o;
  }
}
constexpr int HY_CSTRIDE = 8224;
__device__ __forceinline__ void hyena_unit(LAS unsigned char* lds, const Params& p, int z, const bf16_t* UT, const float* KFa, bf16_t* YT, int c, int L, int tokbase) {
  const int tid = ltid(), lane = tid & 63, wid = tid >> 6;
  const int OFF = L + 16, NC = 2 * L + 16; const int rstride = L * 2 + 16;
  LAS unsigned char* cp = lds; LAS unsigned char* WT = lds + 8 * HY_CSTRIDE; LAS unsigned char* X0 = WT + 8 * (2048 * 2 + 16);
  { const float bias = p.in[I_HBIAS + z][c]; const float* kf = KFa + (size_t)c * (2 * L) + L;
    for (int idx = tid; idx < 8 * NC; idx += 512) { const int r = idx / NC, n = idx - r * NC; const int d = OFF + r - n; float v = 0.f;
      if (d > -L && d < L) v = kf[d]; if (d == 0) v += bias;
      *(LAS unsigned short*)(cp + r * HY_CSTRIDE + n * 2) = (unsigned short)(cvt_pk_bf16(v, 0.f) & 0xffffu); } }
  { const float* cw = p.in[I_HCW + z]; const float* cb = p.in[I_HCB + z];
    float w0[3], w1[3], w2[3], bb[3];
#pragma unroll
    for (int a = 0; a < 3; ++a) { w0[a] = cw[0 * 1536 + a * 512 + c]; w1[a] = cw[1 * 1536 + a * 512 + c]; w2[a] = cw[2 * 1536 + a * 512 + c]; bb[a] = cb[a * 512 + c]; }
    const int cpb = L >> 3;
    for (int ch = tid; ch < 8 * cpb; ch += 512) { const int b = ch / cpb, t8 = (ch - b * cpb) * 8; float res[3][8];
#pragma unroll
      for (int a = 0; a < 3; ++a) { const bf16_t* rowp = UT + (size_t)(a * 512 + c) * NROW + tokbase + b * L + t8; const u32x4 w = *(const u32x4*)rowp;
        float x[10]; x[0] = t8 > 0 ? bf2f(rowp[-1]) : 0.f; x[9] = t8 + 8 < L ? bf2f(rowp[8]) : 0.f;
        x[1] = bflo(w.x); x[2] = bfhi(w.x); x[3] = bflo(w.y); x[4] = bfhi(w.y); x[5] = bflo(w.z); x[6] = bfhi(w.z); x[7] = bflo(w.w); x[8] = bfhi(w.w);
#pragma unroll
        for (int j = 0; j < 8; ++j) res[a][j] = x[j] * w0[a] + x[j + 1] * w1[a] + x[j + 2] * w2[a] + bb[a]; }
      u32x4 ow, ox;
      ow.x = cvt_pk_bf16(res[2][0] * res[1][0], res[2][1] * res[1][1]); ow.y = cvt_pk_bf16(res[2][2] * res[1][2], res[2][3] * res[1][3]);
      ow.z = cvt_pk_bf16(res[2][4] * res[1][4], res[2][5] * res[1][5]); ow.w = cvt_pk_bf16(res[2][6] * res[1][6], res[2][7] * res[1][7]);
      ox.x = cvt_pk_bf16(res[0][0], res[0][1]); ox.y = cvt_pk_bf16(res[0][2], res[0][3]); ox.z = cvt_pk_bf16(res[0][4], res[0][5]); ox.w = cvt_pk_bf16(res[0][6], res[0][7]);
      *(LAS u32x4*)(WT + b * rstride + t8 * 2) = ow; *(LAS u32x4*)(X0 + b * rstride + t8 * 2) = ox; }
  }
  __syncthreads();
  { const int n = lane & 15, g = lane >> 4, bq = n & 7; const int i = lane & 15, q = i >> 3, r = i & 7;
    const int ngroups = L >> 6;
    const LAS unsigned char* bbase = WT + bq * rstride + g * 16;
    const LAS unsigned char* abase = cp + r * HY_CSTRIDE + (8 * g - 8 * q + OFF) * 2;
    for (int grp = wid; grp < ngroups; grp += 8) {
      f32x4 acc[4];
#pragma unroll
      for (int ii = 0; ii < 4; ++ii) acc[ii] = (f32x4){0.f, 0.f, 0.f, 0.f};
      const int t0 = grp * 64;
      for (int J = 0; J < (L >> 5); ++J) {
        const bf16x8 bf = *(const LAS bf16x8*)(bbase + J * 64);
#pragma unroll
        for (int ii = 0; ii < 4; ++ii) { const bf16x8 af = *(const LAS bf16x8*)(abase + (32 * J - t0 - 16 * ii) * 2);
          acc[ii] = __builtin_amdgcn_mfma_f32_16x16x32_bf16(af, bf, acc[ii], 0, 0, 0); }
      }
      if (n < 8) {
#pragma unroll
        for (int ii = 0; ii < 4; ++ii) { const int t = t0 + 16 * ii + 4 * g; const u32x2 xw = *(const LAS u32x2*)(X0 + n * rstride + t * 2);
          u32x2 o; o.x = cvt_pk_bf16(acc[ii][0] * bflo(xw.x), acc[ii][1] * bfhi(xw.x)); o.y = cvt_pk_bf16(acc[ii][2] * bflo(xw.y), acc[ii][3] * bfhi(xw.y));
          *(u32x2*)(YT + (size_t)c * NROW + tokbase + n * L + t) = o; }
      }
    }
  }
  __syncthreads();
}
__device__ __forceinline__ void yt_transpose(LAS unsigned char* lds, const bf16_t* YT, bf16_t* Y, int job) {
  const int tid = ltid(); const int ct = job & 7, tt = job >> 3; const int c0 = ct * 64, tok0 = tt * 64;
  LAS unsigned short* T = (LAS unsigned short*)lds;
  { const int i = tid >> 3, ch = tid & 7; const u32x4 w = *(const u32x4*)(YT + (size_t)(c0 + i) * NROW + tok0 + ch * 8); *(LAS u32x4*)(T + i * 72 + ch * 8) = w; }
  __syncthreads();
  { const int t = tid >> 3, cc = (tid & 7) * 8; unsigned short v[8];
#pragma unroll
    for (int j = 0; j < 8; ++j) v[j] = T[(cc + j) * 72 + t];
    u32x4 o; o.x = v[0] | ((unsigned)v[1] << 16); o.y = v[2] | ((unsigned)v[3] << 16); o.z = v[4] | ((unsigned)v[5] << 16); o.w = v[6] | ((unsigned)v[7] << 16);
    *(u32x4*)(Y + (size_t)(tok0 + t) * 1024 + c0 + cc) = o; }
  __syncthreads();
}
__device__ __forceinline__ int scan_row0(int b, int chunk) { return chunk < 4 ? NLAT + b * CTXL + chunk * 64 : b * SEQ + (chunk - 4) * 64; }
__device__ __forceinline__ void rg_coef(const bf16_t* G, const bf16_t* XC, int row, int dir, int ch, float cl, float& a, float& bb) {
  const float r = bf2f(G[(size_t)row * 2048 + (dir * 2) * 512 + ch]), ig = bf2f(G[(size_t)row * 2048 + (dir * 2 + 1) * 512 + ch]), xc = bf2f(XC[(size_t)row * 512 + ch]);
  const float la = r * cl; a = __expf(la); bb = sqrtf(fmaxf(-expm1f(2.0f * la), 0.f)) * (ig * xc);
}
__device__ __forceinline__ void scan_pass_a(const Params& p, int z, const bf16_t* G, const bf16_t* XC, float* AGG, int job) {
  const int ch = ltid(); const int b = job / 36, chunk = job % 36; const int row0 = scan_row0(b, chunk);
#pragma unroll
  for (int dir = 0; dir < 2; ++dir) {
    const float lam = p.in[I_RLAM + z][dir * 512 + ch]; const float cl = -8.0f * log1pf(__expf(-lam));
    float A = 1.f, B = 0.f;
#pragma unroll 8
    for (int tt = 0; tt < 64; ++tt) { const int t = dir ? 63 - tt : tt; float a, bb; rg_coef(G, XC, row0 + t, dir, ch, cl, a, bb); A *= a; B = B * a + bb; }
    float* ag = AGG + ((size_t)((dir * 8 + b) * 36 + chunk) * 512 + ch) * 2; ag[0] = A; ag[1] = B;
  }
}
__device__ __forceinline__ void scan_pass_b(LAS unsigned char* lds, const Params& p, int z, const bf16_t* G, const bf16_t* XC, const bf16_t* URG, const float* AGG, bf16_t* Y, int job) {
  const int ch = ltid(); const int b = job / 36, chunk = job % 36; const int row0 = scan_row0(b, chunk);
  LAS float* hf = (LAS float*)lds;
#pragma unroll
  for (int dir = 0; dir < 2; ++dir) {
    const float lam = p.in[I_RLAM + z][dir * 512 + ch]; const float cl = -8.0f * log1pf(__expf(-lam));
    const int pos = dir == 0 ? chunk : (chunk < 4 ? 3 - chunk : 39 - chunk);
    float h = 0.f;
    for (int o = 0; o < pos; ++o) { const int cj = dir == 0 ? o : (o < 4 ? 3 - o : 39 - o); const float* ag = AGG + ((size_t)((dir * 8 + b) * 36 + cj) * 512 + ch) * 2; h = ag[0] * h + ag[1]; }
    if (dir == 0) {
#pragma unroll 8
      for (int t = 0; t < 64; ++t) { float a, bb; rg_coef(G, XC, row0 + t, 0, ch, cl, a, bb); h = a * h + bb; hf[t * 512 + ch] = h; }
    } else {
#pragma unroll 8
      for (int tt = 0; tt < 64; ++tt) { const int t = 63 - tt; float a, bb; rg_coef(G, XC, row0 + t, 1, ch, cl, a, bb); h = a * h + bb;
        const float gt = bf2f(URG[(size_t)(row0 + t) * 1024 + 512 + ch]); const float z = 0.7978845608028654f * (gt + 0.044715f * gt * gt * gt);
        const float th = 1.0f - 2.0f / (1.0f + __expf(2.0f * z)); const float ge = 0.5f * gt * (1.0f + th);
        Y[(size_t)(row0 + t) * 1024 + 512 + ch] = (unsigned short)(cvt_pk_bf16((h + hf[t * 512 + ch]) * ge, 0.f) & 0xffffu); }
    }
  }
}

__device__ __forceinline__ void attn_phase(LAS unsigned char* lds, const bf16_t* Q, const bf16_t* Kb, const bf16_t* KR, const bf16_t* VT, bf16_t* O) {
  const int tid = ltid(), wid = tid >> 6, lane = tid & 63, l32 = lane & 31, hf = lane >> 5;
  constexpr int KROW = 208, KBUF = 64 * KROW, VROW = 136, VBUF = 64 * VROW;
  LAS unsigned char* Kl = lds; LAS unsigned char* Vl = lds + 2 * KBUF;
  const int G = gridDim.x; const float cs = 0.10206207261596575f * 1.4426950408889634f;
  const int kkey = tid >> 3, kpart = tid & 7, rkey = (tid >> 2) & 63, rpart = tid & 3, vdv = tid >> 3, vpart = tid & 7;
  for (int u = blockIdx.x; u < 1024; u += G) {
    int bh, qb;
    if (G == 256) { const int xcd = blockIdx.x & 7, within = blockIdx.x >> 3, r = u >> 8; bh = xcd * 16 + r * 4 + (within >> 3); qb = within & 7; } else { bh = u >> 3; qb = u & 7; }
    const int b = bh >> 4, h = bh & 15;
    const int q = qb * 256 + wid * 32 + l32;
    const bf16_t* qp = Q + (size_t)(b * SEQ + q) * 1536 + h * 96 + hf * 8;
    bf16x8 qf[6];
#pragma unroll
    for (int ks = 0; ks < 6; ++ks) qf[ks] = *(const bf16x8*)(qp + ks * 16);
    f32x16 o0, o1;
#pragma unroll
    for (int i = 0; i < 16; ++i) { o0[i] = 0.f; o1[i] = 0.f; }
    float mrun = -1e30f, lsum = 0.f;
    u32x4 kreg, rreg, vreg;
#define ATT_LOAD(j) do { const int tb_ = (j) < 32 ? b * SEQ + (j) * 64 : NLAT + b * CTXL + ((j) - 32) * 64; \
      kreg = *(const u32x4*)(Kb + (size_t)(tb_ + kkey) * 1024 + h * 64 + kpart * 8); \
      if (tid < 256) rreg = *(const u32x4*)(KR + (size_t)(tb_ + rkey) * 32 + rpart * 8); \
      vreg = *(const u32x4*)(VT + (size_t)(h * 64 + vdv) * NROW + tb_ + vpart * 8); } while (0)
#define ATT_STORE(buf) do { *(LAS u32x4*)(Kl + (buf) * KBUF + kkey * KROW + kpart * 16) = kreg; \
      if (tid < 256) *(LAS u32x4*)(Kl + (buf) * KBUF + rkey * KROW + 128 + rpart * 16) = rreg; \
      *(LAS u32x2*)(Vl + (buf) * VBUF + vdv * VROW + vpart * 16) = (u32x2){vreg.x, vreg.y}; *(LAS u32x2*)(Vl + (buf) * VBUF + vdv * VROW + vpart * 16 + 8) = (u32x2){vreg.z, vreg.w}; } while (0)
    ATT_LOAD(0); ATT_STORE(0); __syncthreads();
    for (int j = 0; j < 36; ++j) {
      if (j + 1 < 36) ATT_LOAD(j + 1);
      const int cur = j & 1;
      f32x16 s0, s1;
#pragma unroll
      for (int i = 0; i < 16; ++i) { s0[i] = 0.f; s1[i] = 0.f; }
      const LAS unsigned char* kb0 = Kl + cur * KBUF + l32 * KROW + hf * 16;
#pragma unroll
      for (int ks = 0; ks < 6; ++ks) { const bf16x8 a0 = *(const LAS bf16x8*)(kb0 + ks * 32), a1 = *(const LAS bf16x8*)(kb0 + 32 * KROW + ks * 32);
        s0 = __builtin_amdgcn_mfma_f32_32x32x16_bf16(a0, qf[ks], s0, 0, 0, 0); s1 = __builtin_amdgcn_mfma_f32_32x32x16_bf16(a1, qf[ks], s1, 0, 0, 0); }
      float tmax = s0[0];
#pragma unroll
      for (int i = 1; i < 16; ++i) tmax = fmaxf(tmax, s0[i]);
#pragma unroll
      for (int i = 0; i < 16; ++i) tmax = fmaxf(tmax, s1[i]);
      tmax = fmaxf(tmax, __shfl_xor(tmax, 32));
      const float mnew = fmaxf(mrun, tmax * cs); const float alpha = __builtin_amdgcn_exp2f(mrun - mnew); mrun = mnew;
      float psum = 0.f;
#pragma unroll
      for (int i = 0; i < 16; ++i) { s0[i] = __builtin_amdgcn_exp2f(s0[i] * cs - mnew); s1[i] = __builtin_amdgcn_exp2f(s1[i] * cs - mnew); psum += s0[i] + s1[i]; }
      lsum = lsum * alpha + psum;
#pragma unroll
      for (int i = 0; i < 16; ++i) { o0[i] *= alpha; o1[i] *= alpha; }
      const LAS unsigned char* vb0 = Vl + cur * VBUF + l32 * VROW + hf * 8;
#pragma unroll
      for (int kb = 0; kb < 2; ++kb)
#pragma unroll
        for (int k2 = 0; k2 < 2; ++k2) {
          bf16x8 pf; { unsigned w0, w1, w2, w3;
            if (kb == 0) { w0 = cvt_pk_bf16(s0[8 * k2 + 0], s0[8 * k2 + 1]); w1 = cvt_pk_bf16(s0[8 * k2 + 2], s0[8 * k2 + 3]); w2 = cvt_pk_bf16(s0[8 * k2 + 4], s0[8 * k2 + 5]); w3 = cvt_pk_bf16(s0[8 * k2 + 6], s0[8 * k2 + 7]); }
            else { w0 = cvt_pk_bf16(s1[8 * k2 + 0], s1[8 * k2 + 1]); w1 = cvt_pk_bf16(s1[8 * k2 + 2], s1[8 * k2 + 3]); w2 = cvt_pk_bf16(s1[8 * k2 + 4], s1[8 * k2 + 5]); w3 = cvt_pk_bf16(s1[8 * k2 + 6], s1[8 * k2 + 7]); }
            const u32x4 pw = {w0, w1, w2, w3}; pf = __builtin_bit_cast(bf16x8, pw); }
          const int koff = (32 * kb + 16 * k2) * 2;
          { const u32x2 va = *(const LAS u32x2*)(vb0 + koff), vb = *(const LAS u32x2*)(vb0 + koff + 16); const u32x4 vw = {va.x, va.y, vb.x, vb.y};
            o0 = __builtin_amdgcn_mfma_f32_32x32x16_bf16(__builtin_bit_cast(bf16x8, vw), pf, o0, 0, 0, 0); }
          { const u32x2 va = *(const LAS u32x2*)(vb0 + 32 * VROW + koff), vb = *(const LAS u32x2*)(vb0 + 32 * VROW + koff + 16); const u32x4 vw = {va.x, va.y, vb.x, vb.y};
            o1 = __builtin_amdgcn_mfma_f32_32x32x16_bf16(__builtin_bit_cast(bf16x8, vw), pf, o1, 0, 0, 0); }
        }
      if (j + 1 < 36) ATT_STORE(cur ^ 1);
      __syncthreads();
    }
#undef ATT_LOAD
#undef ATT_STORE
    const float inv = 1.0f / (lsum + __shfl_xor(lsum, 32));
    bf16_t* op = O + (size_t)(b * SEQ + q) * 1024 + h * 64 + 4 * hf;
#pragma unroll
    for (int i = 0; i < 4; ++i) {
      u32x2 w; w.x = cvt_pk_bf16(o0[4 * i] * inv, o0[4 * i + 1] * inv); w.y = cvt_pk_bf16(o0[4 * i + 2] * inv, o0[4 * i + 3] * inv); *(u32x2*)(op + 8 * i) = w;
      w.x = cvt_pk_bf16(o1[4 * i] * inv, o1[4 * i + 1] * inv); w.y = cvt_pk_bf16(o1[4 * i + 2] * inv, o1[4 * i + 3] * inv); *(u32x2*)(op + 32 + 8 * i) = w;
    }
  }
}

__device__ __forceinline__ unsigned char* launder_ptr(const void* q) { unsigned lo = (unsigned)(size_t)q, hi = (unsigned)((size_t)q >> 32); asm volatile("" : "+v"(lo), "+v"(hi));
  lo = __builtin_amdgcn_readfirstlane(lo); hi = __builtin_amdgcn_readfirstlane(hi); return (unsigned char*)(((size_t)hi << 32) | (size_t)lo); }
#define PHASE_BEGIN int zv_ = 0; asm volatile("" : "+v"(zv_)); const int z = __builtin_amdgcn_readfirstlane(zv_); unsigned char* ws = launder_ptr(p.ws); float* xout = (float*)launder_ptr(p.out); (void)ws; (void)xout
#define P_MOD ((float*)(ws + WS_MOD))
#define P_KF ((float*)(ws + WS_KF))
#define P_KFC ((float*)(ws + WS_KFC))
#define P_XCTX ((float*)(ws + WS_XCTX))
#define P_AGG ((float*)(ws + WS_AGG))
#define P_H ((bf16_t*)(ws + WS_H))
#define P_ACT ((bf16_t*)(ws + WS_ACT))
#define P_G ((bf16_t*)(ws + WS_G))
#define P_XC ((bf16_t*)(ws + WS_XC))
#define P_YT ((bf16_t*)(ws + WS_YT))
#define P_UT ((bf16_t*)(ws + WS_UT))
#define P_URG ((bf16_t*)(ws + WS_URG))
#define P_P ((bf16_t*)(ws + WS_P))
#define P_Q ((bf16_t*)(ws + WS_Q))
#define P_QN ((bf16_t*)(ws + WS_QN))
#define P_KVN ((bf16_t*)(ws + WS_KVN))
#define P_KR ((bf16_t*)(ws + WS_KR))
#define P_K ((bf16_t*)(ws + WS_K))
#define P_VT ((bf16_t*)(ws + WS_VT))
__global__ void __launch_bounds__(512) mk_fwd(Params p) {
  extern __shared__ __attribute__((aligned(16))) unsigned char lds_raw[];
  LAS unsigned char* lds = (LAS unsigned char*)lds_raw;
  cg::grid_group grid = cg::this_grid();
  const int G = gridDim.x, bid = blockIdx.x;

  {
    PHASE_BEGIN;
    LAS float* L = (LAS float*)lds;
    for (int job = bid; job < 288; job += G) adaln_job(L, p, z, P_MOD, job);
    for (int job = bid; job < 288; job += G) { if (job < 256) filter_job(L, p, z, P_KF, SEQ, job); else filter_job(L, p, z, P_KFC, CTXL, job - 256); }
    constexpr int T_FI = 16 * 88, T_FO = 44 * 16, T_EI = 16 * 40, T_EO = 256, T_RG = 8 * 32, T_MI = 16 * 20, T_QU = 12 * 24, T_KU = 64, T_VU = 64, T_MO = 256;
    constexpr int T_TOTAL = 4 * T_FI + 4 * T_FO + T_EI + T_EO + T_RG + T_MI + T_QU + T_KU + T_VU + T_MO;
#pragma unroll 1
    for (int it = bid; it < T_TOTAL; it += G) {
      int r = it; int kind, K, ld; const float* W; const float* W2 = nullptr; const float* sc = nullptr; bf16_t* dst;
      if (r < 4 * T_FI) { const int m = r / T_FI; r -= m * T_FI; kind = MAP_SWIGLU; W = p.in[I_FWI + z] + (size_t)m * 1024 * 5632; K = 1024; ld = 5632; dst = (bf16_t*)(ws + WS_WFI + m * SZ_WFI); }
      else if ((r -= 4 * T_FI) < 4 * T_FO) { const int m = r / T_FO; r -= m * T_FO; kind = MAP_ID; W = p.in[I_FWO + z] + (size_t)m * 2816 * 1024; K = 2816; ld = 1024; dst = (bf16_t*)(ws + WS_WFO + m * SZ_WFO); }
      else if ((r -= 4 * T_FO) < T_EI) { kind = MAP_ID; W = p.in[I_EWI + z]; K = 1024; ld = 2560; dst = (bf16_t*)(ws + WS_WEI); }
      else if ((r -= T_EI) < T_EO) { kind = MAP_ID; W = p.in[I_EWO + z]; K = 1024; ld = 1024; dst = (bf16_t*)(ws + WS_WEO); }
      else if ((r -= T_EO) < T_RG) { kind = MAP_RG; W = p.in[I_RAW + z]; W2 = p.in[I_RXW + z]; K = 512; ld = 0; dst = (bf16_t*)(ws + WS_WRG); }
      else if ((r -= T_RG) < T_MI) { kind = MAP_MLAIN; W = p.in[I_MWI + z]; K = 1024; ld = 1056; dst = (bf16_t*)(ws + WS_WMI); }
      else if ((r -= T_MI) < T_QU) { kind = MAP_QUP; W = p.in[I_MWQ + z]; sc = p.in[I_MQN + z]; K = 768; ld = 1536; dst = (bf16_t*)(ws + WS_WQU); }
      else if ((r -= T_QU) < T_KU) { kind = MAP_KUP; W = p.in[I_MWKV + z]; sc = p.in[I_MKVN + z]; K = 256; ld = 2048; dst = (bf16_t*)(ws + WS_WKU); }
      else if ((r -= T_KU) < T_VU) { kind = MAP_VUP; W = p.in[I_MWKV + z]; sc = p.in[I_MKVN + z]; K = 256; ld = 2048; dst = (bf16_t*)(ws + WS_WVU); }
      else { r -= T_VU; kind = MAP_ID; W = p.in[I_MWO + z]; K = 1024; ld = 1024; dst = (bf16_t*)(ws + WS_WMO); }
      conv_tile(L, kind, W, W2, sc, K, ld, dst, r);
    }
  }
  grid.sync();
  { PHASE_BEGIN; row_pass(p.in[I_X + z], p.in[I_CTX + z], xout, P_XCTX, false, nullptr, nullptr, P_H, P_MOD, 0, NROW); }
  grid.sync();

#pragma unroll 1
  for (int st = 0; st < 6; ++st) {
    const int l = st / 3, k = st % 3;
    const int Mrows = (st >= 4) ? NLAT : NROW;
    int rsel;
    if (k != 1) {
      { PHASE_BEGIN; const int wi = l * 2 + (k == 0 ? 0 : 1);
        Gemm g; g.A = P_H; g.Bt = (const bf16_t*)(ws + WS_WFI + wi * SZ_WFI); g.M = Mrows; g.N = 5632; g.K = 1024;
        StaticOrder S; S.init(g.M, g.N, G, bid); EpiSwiGLU E; E.O = P_ACT; gemm_phase<EpiSwiGLU, StaticOrder, false>(lds, g, S, E, nullptr); }
      grid.sync();
      rsel = 0;
    } else if (l == 0) {
#pragma unroll 1
      for (int gi = 0; gi < 2; ++gi) {
        PHASE_BEGIN; Gemm g; EpiBf16P E; int c;
        if (gi == 0) { g.A = (const bf16_t*)(ws + WS_WEI); g.Bt = P_H; g.M = 1536; g.N = NROW; g.K = 1024; E.O = P_UT; E.ldc = NROW; c = bid; }
        else { g.A = P_H; g.Bt = (const bf16_t*)(ws + WS_WEI) + (size_t)1536 * 1024; g.M = NROW; g.N = 1024; g.K = 1024; E.O = P_URG; E.ldc = 1024; c = (bid + G - (432 % G)) % G; }
        StaticOrder S; S.init(g.M, g.N, G, c); gemm_phase<EpiBf16P, StaticOrder, false>(lds, g, S, E, nullptr);
      }
      grid.sync();
      { PHASE_BEGIN; xc_build(p, z, P_URG, P_XC);
#pragma unroll 1
        for (int u = bid; u < 1024; u += G) { const bool lat = u < 512; hyena_unit(lds, p, z, P_UT, lat ? P_KF : P_KFC, P_YT, lat ? u : u - 512, lat ? SEQ : CTXL, lat ? 0 : NLAT); } }
      grid.sync();
      { PHASE_BEGIN; Gemm g; g.A = P_XC; g.Bt = (const bf16_t*)(ws + WS_WRG); g.M = NROW; g.N = 2048; g.K = 512;
        StaticOrder S; S.init(g.M, g.N, G, bid); EpiGate E; E.O = P_G; E.ab = p.in[I_RAB + z]; E.xb = p.in[I_RXB + z]; gemm_phase<EpiGate, StaticOrder, false>(lds, g, S, E, nullptr); }
      grid.sync();
      { PHASE_BEGIN;
        for (int job = bid; job < 288; job += G) scan_pass_a(p, z, P_G, P_XC, P_AGG, job);
        for (int job = bid; job < 8 * (NROW / 64); job += G) yt_transpose(lds, P_YT, P_H, job); }
      grid.sync();
      { PHASE_BEGIN; for (int job = bid; job < 288; job += G) scan_pass_b(lds, p, z, P_G, P_XC, P_URG, P_AGG, P_H, job); }
      grid.sync();
      rsel = 1;
    } else {
      { PHASE_BEGIN; Gemm g; g.A = P_H; g.Bt = (const bf16_t*)(ws + WS_WMI); g.M = NROW; g.N = 1280; g.K = 1024; EpiBf16P E; E.O = P_P; E.ldc = 1280;
        StaticOrder S; S.init(g.M, g.N, G, bid); gemm_phase<EpiBf16P, StaticOrder, false>(lds, g, S, E, nullptr); }
      grid.sync();
      { PHASE_BEGIN; mla_rownorm(P_P, P_QN, P_KVN, P_KR); }
      grid.sync();
      { PHASE_BEGIN; Gemm g; g.A = P_QN; g.Bt = (const bf16_t*)(ws + WS_WQU); g.M = NLAT; g.N = 1536; g.K = 768; EpiQ E; E.O = P_Q;
        StaticOrder S; S.init(g.M, g.N, G, bid); gemm_phase<EpiQ, StaticOrder, false>(lds, g, S, E, nullptr); }
#pragma unroll 1
      for (int gi = 0; gi < 2; ++gi) {
        PHASE_BEGIN; Gemm g; EpiBf16P E; int c;
        if (gi == 0) { g.A = P_KVN; g.Bt = (const bf16_t*)(ws + WS_WKU); g.M = NROW; g.N = 1024; g.K = 256; E.O = P_K; E.ldc = 1024; c = (bid + G - (384 % G)) % G; }
        else { g.A = (const bf16_t*)(ws + WS_WVU); g.Bt = P_KVN; g.M = 1024; g.N = NROW; g.K = 256; E.O = P_VT; E.ldc = NROW; c = (bid + G - ((384 + 288) % G)) % G; }
        StaticOrder S; S.init(g.M, g.N, G, c); gemm_phase<EpiBf16P, StaticOrder, false>(lds, g, S, E, nullptr);
      }
      grid.sync();
      { PHASE_BEGIN; attn_phase(lds, P_Q, P_K, P_KR, P_VT, P_H); }
      grid.sync();
      rsel = 2;
    }
    { PHASE_BEGIN; Gemm g; EpiResid E; g.M = Mrows; g.N = 1024; E.xlat = xout; E.xctx = P_XCTX; E.mod = P_MOD + (size_t)l * 9 * 9216;
      if (rsel == 0) { g.A = P_ACT; g.Bt = (const bf16_t*)(ws + WS_WFO + (l * 2 + (k == 0 ? 0 : 1)) * SZ_WFO); g.K = 2816; E.gidx = k == 0 ? 2 : 8; E.gs = 0.5f; }
      else if (rsel == 1) { g.A = P_H; g.Bt = (const bf16_t*)(ws + WS_WEO); g.K = 1024; E.gidx = 5; E.gs = 1.0f; }
      else { g.A = P_H; g.Bt = (const bf16_t*)(ws + WS_WMO); g.K = 1024; E.gidx = 5; E.gs = 1.0f; }
      StaticOrder S; S.init(g.M, g.N, G, bid); gemm_phase<EpiResid, StaticOrder, false>(lds, g, S, E, nullptr); }
    grid.sync();
    { PHASE_BEGIN; const float* lg = p.in[I_LNG + z] + (size_t)(l * 3 + k) * D; const float* lb = p.in[I_LNB + z] + (size_t)(l * 3 + k) * D;
      const bool hw = st < 5; const float* modn = P_MOD + (size_t)((k < 2) ? l : l + 1) * 9 * 9216; const int sidx = (k < 2) ? 3 * k + 3 : 0;
      row_pass(xout, P_XCTX, xout, P_XCTX, true, lg, lb, hw ? P_H : nullptr, modn, sidx, Mrows); }
    if (st < 5) grid.sync();
  }
}

extern "C" void kernel_launch(void* const* d_in, const int* in_sizes, int n_in, void* d_out, int out_size, void* d_ws, size_t ws_size, hipStream_t stream) {
  static int grid_blocks = 0;
  if (!grid_blocks) {
    int dev = 0, cus = 0, per_cu = 0;
    if (n_in != 34 || out_size != NLAT * D || ws_size < WS_END) { fprintf(stderr, "kernel_launch: unexpected problem (n_in %d out %d ws %zu need %zu)\n", n_in, out_size, ws_size, (size_t)WS_END); grid_blocks = -1; return; }
    (void)hipGetDevice(&dev);
    (void)hipDeviceGetAttribute(&cus, hipDeviceAttributeMultiprocessorCount, dev);
    (void)hipFuncSetAttribute((const void*)mk_fwd, hipFuncAttributeMaxDynamicSharedMemorySize, LDS_BYTES);
    (void)hipOccupancyMaxActiveBlocksPerMultiprocessor(&per_cu, (const void*)mk_fwd, 512, LDS_BYTES);
    if (per_cu < 1 || cus < 1) { fprintf(stderr, "kernel_launch: occupancy %d cus %d\n", per_cu, cus); grid_blocks = -1; return; }
    grid_blocks = cus;
  }
  if (grid_blocks < 0) return;
  Params p{};
  for (int i = 0; i < 34; ++i) p.in[i] = (const float*)d_in[i];
  p.out = (float*)d_out; p.ws = (unsigned char*)d_ws;
  void* args[] = {&p};
  hipError_t e = hipLaunchCooperativeKernel((const void*)mk_fwd, dim3(grid_blocks), dim3(512), args, LDS_BYTES, stream);
  if (e != hipSuccess) fprintf(stderr, "cooperative launch failed: %s (grid %d)\n", hipGetErrorString(e), grid_blocks);
}
```

```cpp
#include <hip/hip_runtime.h>
namespace pg8 {
#define PG8_LAS __attribute__((address_space(3)))
typedef unsigned short bf16_t;
typedef short bf16x8 __attribute__((ext_vector_type(8)));
typedef float f32x4 __attribute__((ext_vector_type(4)));
typedef unsigned u32x4 __attribute__((ext_vector_type(4)));
constexpr int BM = 256, BK = 64, HALF = 128, HTB = HALF * BK * 2  , STAGE_BYTES = 8 * HTB, NXCD = 8, WGM = 8;

__host__ __device__ __forceinline__ int lds_byte(int r, int c) { const int st = (r >> 4) * 2 + (c >> 5), rr = r & 15, cc = c & 31, ob = rr * 64 + cc * 2; return st * 1024 + (ob ^ (((ob >> 9) & 1) << 5)); }
__host__ __device__ __forceinline__ void stage_rc(int b, int& R, int& C) { const int st = b / 1024, sb = b % 1024, swz = sb ^ (((sb >> 9) & 1) << 5); R = (st >> 1) * 16 + swz / 64; C = (st & 1) * 32 + (swz % 64) / 2; }
__host__ __device__ __forceinline__ int perm32(int rho) { const int n = rho >> 4, i = rho & 15; return 8 * (i >> 2) + 4 * n + (i & 3); }

struct Unit { int pm, pn; };
struct Gemm { const bf16_t* A; const bf16_t* Bt; int M, N, K, kn; };

struct StaticOrder {
    int nM, nN, nwg, G, c;
    __host__ __device__ void init(int M, int N, int G_, int c_) { nM = M / BM; nN = N / BM; nwg = nM * nN; G = G_; c = c_; }
    __host__ __device__ bool next(int i, Unit& u) const {
        const long L = (long)i * G + c; if (L >= nwg) return false;
        int wgid = (int)L; { const int q = nwg / NXCD, r = nwg % NXCD, xcd = wgid % NXCD, off = wgid / NXCD; wgid = (xcd < r ? xcd * (q + 1) : r * (q + 1) + (xcd - r) * q) + off; }
        const int nig = WGM * nN, gid = wgid / nig, fm = gid * WGM, gsz = (nM - fm) < WGM ? (nM - fm) : WGM;
        u.pm = fm + ((wgid % nig) % gsz); u.pn = (wgid % nig) / gsz; return true;
    }
    __device__ __forceinline__ void a_ready(const Unit&) const {}
    __device__ __forceinline__ void done(const Unit&) const {}
};
struct CountedOrder : StaticOrder {
    const unsigned* ready; unsigned need; unsigned* tmo;
    __device__ __forceinline__ void a_ready(const Unit& u) const {
        if (threadIdx.x < 64) {
            const unsigned long long t0 = __builtin_amdgcn_s_memrealtime(); unsigned polls = 0;
            while ((unsigned)__builtin_amdgcn_readfirstlane(__hip_atomic_load(ready + 64 * u.pm, __ATOMIC_RELAXED, __HIP_MEMORY_SCOPE_AGENT)) < need) {
                if ((++polls & 255u) == 0u && __builtin_amdgcn_readfirstlane(__hip_atomic_load(tmo, __ATOMIC_RELAXED, __HIP_MEMORY_SCOPE_AGENT)) != 0u) break;
                if (__builtin_amdgcn_s_memrealtime() - t0 > 2000000ull) {
                    if (threadIdx.x == 0) { unsigned expect = 0u; __hip_atomic_compare_exchange_strong(tmo + 1, &expect, 0x600u | (unsigned)(u.pm & 0xff), __ATOMIC_RELAXED, __ATOMIC_RELAXED, __HIP_MEMORY_SCOPE_AGENT); __hip_atomic_store(tmo, 1u, __ATOMIC_RELAXED, __HIP_MEMORY_SCOPE_AGENT); }
                    break; }
                __builtin_amdgcn_s_sleep(2); }
            __builtin_amdgcn_fence(__ATOMIC_ACQUIRE, "agent");
            asm volatile("s_waitcnt vmcnt(0)" ::: "memory");
        }
#if !defined(BROKEN_HOOK_NO_BARRIER)
        asm volatile("" ::: "memory"); __builtin_amdgcn_s_barrier(); asm volatile("" ::: "memory");
#endif
    }
};

__device__ __forceinline__ unsigned cvt_pk_bf16(float lo, float hi) { unsigned r; asm volatile("v_cvt_pk_bf16_f32 %0, %1, %2" : "=v"(r) : "v"(lo), "v"(hi)); return r; }
typedef float f32x2 __attribute__((ext_vector_type(2)));
__device__ __forceinline__ f32x2 gelu_pk(f32x2 v) {
    const f32x2 av = __builtin_elementwise_abs(v), d = av * 0.2316418882f + 1.0f;
    f32x2 t; t.x = __builtin_amdgcn_rcpf(d.x); t.y = __builtin_amdgcn_rcpf(d.y);
    f32x2 q = t * 0.5307027145f + (-0.7265760135f); q = q * t + 0.7107068705f; q = q * t + (-0.142248368f); q = q * t + 0.127414796f; q = q * t;
    const f32x2 s = (v * v) * (-0.72134752044f);
    f32x2 e; e.x = __builtin_amdgcn_exp2f(s.x); e.y = __builtin_amdgcn_exp2f(s.y);
    const f32x2 m = v * (q * e), r = v - m;
    f32x2 o; o.x = v.x < 0.f ? m.x : r.x; o.y = v.y < 0.f ? m.y : r.y; return o;
}

struct EpiF32 {
    static constexpr bool PERM = false, AFTER_DRAIN = false;
    float* C; int ldc; const float* bias;
    __device__ __forceinline__ void operator()(const f32x4 (&acc)[2][2][4][2], const Unit& u, int wr, int wc, int fr, int fq) const {
        const int row0 = u.pm * BM + wr * 64 + fr, col0 = u.pn * BM + wc * 32 + 4 * fq;
        f32x4 bv[2][2];
#pragma unroll
        for (int bj = 0; bj < 2; ++bj)
#pragma unroll
            for (int n = 0; n < 2; ++n) bv[bj][n] = bias ? *(const f32x4*)(bias + col0 + bj * HALF + n * 16) : (f32x4){0.f, 0.f, 0.f, 0.f};
#pragma unroll
        for (int ai = 0; ai < 2; ++ai)
#pragma unroll
            for (int m = 0; m < 4; ++m) { float* rowp = C + (size_t)(row0 + ai * HALF + m * 16) * ldc + col0;
#pragma unroll
                for (int bj = 0; bj < 2; ++bj)
#pragma unroll
                    for (int n = 0; n < 2; ++n) *(f32x4*)(rowp + bj * HALF + n * 16) = acc[ai][bj][m][n] + bv[bj][n]; }
    }
};
template <int ACT  > struct EpiBf16 {
    static constexpr bool PERM = true, AFTER_DRAIN = false;
    bf16_t* O; int ldc; const float* bias; int split_cols; size_t split_stride;
    __device__ __forceinline__ void operator()(const f32x4 (&acc)[2][2][4][2], const Unit& u, int wr, int wc, int fr, int fq) const {
        const int row0 = u.pm * BM + wr * 64 + fr; int colt = u.pn * BM; bf16_t* base = O;
        if (split_cols) { const int t = colt / split_cols; base += (size_t)t * split_stride; colt -= t * split_cols; }
        const int col0 = colt + wc * 32 + 8 * fq, bcol0 = u.pn * BM + wc * 32 + 8 * fq;
        f32x4 bv[2][2];
#pragma unroll
        for (int bj = 0; bj < 2; ++bj)
#pragma unroll
            for (int n = 0; n < 2; ++n) bv[bj][n] = bias ? *(const f32x4*)(bias + bcol0 + bj * HALF + 4 * n) : (f32x4){0.f, 0.f, 0.f, 0.f};
#pragma unroll
        for (int ai = 0; ai < 2; ++ai)
#pragma unroll
            for (int m = 0; m < 4; ++m) { bf16_t* rowp = base + (size_t)(row0 + ai * HALF + m * 16) * ldc + col0;
#pragma unroll
                for (int bj = 0; bj < 2; ++bj) { f32x4 v0 = acc[ai][bj][m][0] + bv[bj][0], v1 = acc[ai][bj][m][1] + bv[bj][1];
                    if (ACT == 1) { f32x2 a = gelu_pk((f32x2){v0[0], v0[1]}), b = gelu_pk((f32x2){v0[2], v0[3]}), c = gelu_pk((f32x2){v1[0], v1[1]}), d = gelu_pk((f32x2){v1[2], v1[3]});
                        v0 = (f32x4){a.x, a.y, b.x, b.y}; v1 = (f32x4){c.x, c.y, d.x, d.y}; }
                    if (ACT == 2) {
#pragma unroll
                        for (int j = 0; j < 4; ++j) { v0[j] = 0.5f * v0[j] * (1.0f + erff(v0[j] * 0.70710678f)); v1[j] = 0.5f * v1[j] * (1.0f + erff(v1[j] * 0.70710678f)); } }
                    u32x4 w; w.x = cvt_pk_bf16(v0[0], v0[1]); w.y = cvt_pk_bf16(v0[2], v0[3]); w.z = cvt_pk_bf16(v1[0], v1[1]); w.w = cvt_pk_bf16(v1[2], v1[3]);
                    *(u32x4*)(rowp + bj * HALF) = w; } }
    }
};

struct PanelStats {
    unsigned* xbuf;
    unsigned* cnt;
    unsigned* tmo;
    int ntn; float eps;
    unsigned code;
    __device__ __forceinline__ bool run(const f32x4 (&v)[2][2][4][2], const Unit& u, int wr, int wc, int fr, int fq, PG8_LAS unsigned char* lds, int wid, int lane) const {
        typedef float f32x2v __attribute__((ext_vector_type(2)));
        PG8_LAS f32x2v* P = (PG8_LAS f32x2v*)lds;
        PG8_LAS f32x2v* S = (PG8_LAS f32x2v*)(lds + 8192);
        PG8_LAS unsigned* flag = (PG8_LAS unsigned*)(lds + 8192 + 2048);
#pragma unroll
        for (int ai = 0; ai < 2; ++ai)
#pragma unroll
            for (int m = 0; m < 4; ++m) {
                float s = 0.f;
#pragma unroll
                for (int bj = 0; bj < 2; ++bj)
#pragma unroll
                    for (int n = 0; n < 2; ++n) { const f32x4 x = v[ai][bj][m][n]; s += (x[0] + x[1]) + (x[2] + x[3]); }
                s += __shfl_xor(s, 16); s += __shfl_xor(s, 32);
                const float mw = s * (1.0f / 64.0f); float q = 0.f;
#pragma unroll
                for (int bj = 0; bj < 2; ++bj)
#pragma unroll
                    for (int n = 0; n < 2; ++n) { const f32x4 d = v[ai][bj][m][n] - mw; q += (d[0] * d[0] + d[1] * d[1]) + (d[2] * d[2] + d[3] * d[3]); }
                q += __shfl_xor(q, 16); q += __shfl_xor(q, 32);
                if (fq == 0) P[(ai * HALF + wr * 64 + m * 16 + fr) * 4 + wc] = (f32x2v){mw, q};
            }
        asm volatile("s_waitcnt lgkmcnt(0)" ::: "memory"); __builtin_amdgcn_s_barrier(); asm volatile("" ::: "memory");
#if defined(BROKEN_NO_WAIT)
        if (blockIdx.x >= 64) { const long long t0 = clock64(); while (clock64() - t0 < 60000) __builtin_amdgcn_s_sleep(8); }
#endif
        const int row = wid * 32 + (lane & 31);
        if (lane < 32) {
            const f32x2v a = P[row * 4 + 0], b = P[row * 4 + 1], c = P[row * 4 + 2], d = P[row * 4 + 3];
            const float mt = (a.x + b.x + c.x + d.x) * 0.25f;
            const float da = a.x - mt, db = b.x - mt, dc = c.x - mt, dd = d.x - mt;
            const float m2 = (a.y + b.y) + (c.y + d.y) + 64.0f * ((da * da + db * db) + (dc * dc + dd * dd));
            unsigned long long* slot = (unsigned long long*)xbuf + ((size_t)(u.pm * BM + row) * 4 + u.pn);
            __hip_atomic_store(slot, ((unsigned long long)__float_as_uint(m2) << 32) | __float_as_uint(mt), __ATOMIC_RELAXED, __HIP_MEMORY_SCOPE_AGENT);
        }
        asm volatile("s_waitcnt vmcnt(0)" ::: "memory");
        if (lane == 0) __hip_atomic_fetch_add(cnt + 64 * u.pm, 1u, __ATOMIC_RELAXED, __HIP_MEMORY_SCOPE_AGENT);
        if (wid == 0) {
            bool dead = false; const unsigned long long t0 = __builtin_amdgcn_s_memrealtime(); const unsigned want = 8u * (unsigned)ntn;
            for (;;) {
#if defined(BROKEN_NO_WAIT)
                break;
#endif
                if ((unsigned)__builtin_amdgcn_readfirstlane(__hip_atomic_load(cnt + 64 * u.pm, __ATOMIC_RELAXED, __HIP_MEMORY_SCOPE_AGENT)) >= want) break;
                if (__builtin_amdgcn_s_memrealtime() - t0 > 2000000ull) {
                    if (lane == 0) { unsigned expect = 0u; __hip_atomic_compare_exchange_strong(tmo + 1, &expect, code | (unsigned)(u.pm & 0xff), __ATOMIC_RELAXED, __ATOMIC_RELAXED, __HIP_MEMORY_SCOPE_AGENT);
                                     __hip_atomic_store(tmo, 1u, __ATOMIC_RELAXED, __HIP_MEMORY_SCOPE_AGENT); }
                    dead = true; break; }
                __builtin_amdgcn_s_sleep(2);
            }
            __builtin_amdgcn_fence(__ATOMIC_ACQUIRE, "agent");
            if (lane == 0) flag[0] = dead ? 1u : 0u;
        }
        asm volatile("s_waitcnt vmcnt(0) lgkmcnt(0)" ::: "memory"); __builtin_amdgcn_s_barrier(); asm volatile("" ::: "memory");
        const bool bad = flag[0] != 0u;
        if (lane < 32) {
            const unsigned long long* slot = (const unsigned long long*)xbuf + (size_t)(u.pm * BM + row) * 4; float mt[4], m2[4]; float ms = 0.f;
#pragma unroll
            for (int t = 0; t < 4; ++t) { if (t < ntn) { const unsigned long long w = __hip_atomic_load(slot + t, __ATOMIC_RELAXED, __HIP_MEMORY_SCOPE_AGENT); mt[t] = __uint_as_float((unsigned)w); m2[t] = __uint_as_float((unsigned)(w >> 32)); } else { mt[t] = 0.f; m2[t] = 0.f; } ms += mt[t]; }
            const float mean = ms / (float)ntn; float q = 0.f;
#pragma unroll
            for (int t = 0; t < 4; ++t) if (t < ntn) { const float dm = mt[t] - mean; q += m2[t] + 256.0f * dm * dm; }
            S[row] = (f32x2v){mean, 1.0f / sqrtf(q / (256.0f * (float)ntn) + eps)};
        }
        asm volatile("s_waitcnt lgkmcnt(0)" ::: "memory"); __builtin_amdgcn_s_barrier(); asm volatile("" ::: "memory");
        return bad;
    }
};
struct EpiLnRes {
    static constexpr bool PERM = false, AFTER_DRAIN = true;
    const float* base; float* out; int ldc; const float* bias; PanelStats st; unsigned poison;
    __device__ __forceinline__ void refuse(size_t i0, size_t stride, int M, int N) const { const float q = __builtin_nanf(""); for (size_t i = i0; i < (size_t)M * N; i += stride) out[(i / N) * ldc + i % N] = q;
        if (i0 == 0) { unsigned expect = 0u; __hip_atomic_compare_exchange_strong(st.tmo + 1, &expect, 0x7f0u, __ATOMIC_RELAXED, __ATOMIC_RELAXED, __HIP_MEMORY_SCOPE_AGENT); __hip_atomic_store(st.tmo, 1u, __ATOMIC_RELAXED, __HIP_MEMORY_SCOPE_AGENT); } }
    __device__ __forceinline__ void fused(f32x4 (&acc)[2][2][4][2], const Unit& u, int wr, int wc, int fr, int fq, PG8_LAS unsigned char* lds, int wid, int lane) const {
        typedef float f32x2v __attribute__((ext_vector_type(2)));
        const PG8_LAS f32x2v* S = (const PG8_LAS f32x2v*)(lds + 8192);
        const int col0 = u.pn * BM + wc * 32 + 4 * fq;
#pragma unroll
        for (int bj = 0; bj < 2; ++bj)
#pragma unroll
            for (int n = 0; n < 2; ++n) { const f32x4 bv = bias ? *(const f32x4*)(bias + col0 + bj * HALF + n * 16) : (f32x4){0.f, 0.f, 0.f, 0.f};
#pragma unroll
                for (int ai = 0; ai < 2; ++ai)
#pragma unroll
                    for (int m = 0; m < 4; ++m) acc[ai][bj][m][n] += bv; }
        const bool bad = st.run(acc, u, wr, wc, fr, fq, lds, wid, lane) || poison != 0u;
        const float qnan = __builtin_nanf("");
#pragma unroll
        for (int ai = 0; ai < 2; ++ai)
#pragma unroll
            for (int m = 0; m < 4; ++m) { const int r = ai * HALF + wr * 64 + m * 16 + fr; const f32x2v sr = S[r]; const size_t off = (size_t)(u.pm * BM + r) * ldc + col0;
#pragma unroll
                for (int bj = 0; bj < 2; ++bj)
#pragma unroll
                    for (int n = 0; n < 2; ++n) { const f32x4 bs = *(const f32x4*)(base + off + bj * HALF + n * 16); f32x4 o = bs + (acc[ai][bj][m][n] - sr.x) * sr.y;
                        if (bad) o = (f32x4){qnan, qnan, qnan, qnan}; *(f32x4*)(out + off + bj * HALF + n * 16) = o; }
                asm volatile("" ::: "memory"); }
    }
};
struct EpiLnResLn {
    static constexpr bool PERM = false, AFTER_DRAIN = true;
    const float* base; float* out; bf16_t* xn; int ldc; const float* bias; PanelStats st1, st2; unsigned poison;
    __device__ __forceinline__ void refuse(size_t i0, size_t stride, int M, int N) const { const float q = __builtin_nanf(""); for (size_t i = i0; i < (size_t)M * N; i += stride) { const size_t o = (i / N) * ldc + i % N; out[o] = q; xn[o] = (bf16_t)0x7fc0u; }
        if (i0 == 0) { unsigned expect = 0u; __hip_atomic_compare_exchange_strong(st1.tmo + 1, &expect, 0x7f0u, __ATOMIC_RELAXED, __ATOMIC_RELAXED, __HIP_MEMORY_SCOPE_AGENT); __hip_atomic_store(st1.tmo, 1u, __ATOMIC_RELAXED, __HIP_MEMORY_SCOPE_AGENT); } }
    __device__ __forceinline__ void fused(f32x4 (&acc)[2][2][4][2], const Unit& u, int wr, int wc, int fr, int fq, PG8_LAS unsigned char* lds, int wid, int lane) const {
        typedef float f32x2v __attribute__((ext_vector_type(2))); typedef unsigned u32x2v __attribute__((ext_vector_type(2)));
        const PG8_LAS f32x2v* S = (const PG8_LAS f32x2v*)(lds + 8192);
        const int col0 = u.pn * BM + wc * 32 + 4 * fq;
#pragma unroll
        for (int bj = 0; bj < 2; ++bj)
#pragma unroll
            for (int n = 0; n < 2; ++n) { const f32x4 bv = bias ? *(const f32x4*)(bias + col0 + bj * HALF + n * 16) : (f32x4){0.f, 0.f, 0.f, 0.f};
#pragma unroll
                for (int ai = 0; ai < 2; ++ai)
#pragma unroll
                    for (int m = 0; m < 4; ++m) acc[ai][bj][m][n] += bv; }
        bool bad = st1.run(acc, u, wr, wc, fr, fq, lds, wid, lane) || poison != 0u;
        const float qnan = __builtin_nanf("");
#pragma unroll
        for (int ai = 0; ai < 2; ++ai)
#pragma unroll
            for (int m = 0; m < 4; ++m) { const int r = ai * HALF + wr * 64 + m * 16 + fr; const f32x2v sr = S[r]; const size_t off = (size_t)(u.pm * BM + r) * ldc + col0;
#pragma unroll
                for (int bj = 0; bj < 2; ++bj)
#pragma unroll
                    for (int n = 0; n < 2; ++n) { const f32x4 bs = *(const f32x4*)(base + off + bj * HALF + n * 16); acc[ai][bj][m][n] = bs + (acc[ai][bj][m][n] - sr.x) * sr.y; }
                asm volatile("" : "+v"(acc[ai][0][m][0]), "+v"(acc[ai][0][m][1]), "+v"(acc[ai][1][m][0]), "+v"(acc[ai][1][m][1]));
                if (m & 1) asm volatile("" ::: "memory"); }
        const bool bad1 = bad;
        bad = st2.run(acc, u, wr, wc, fr, fq, lds, wid, lane) || bad;
#pragma unroll
        for (int ai = 0; ai < 2; ++ai)
#pragma unroll
            for (int m = 0; m < 4; ++m) { const int r = ai * HALF + wr * 64 + m * 16 + fr; const f32x2v sr = S[r]; const size_t off = (size_t)(u.pm * BM + r) * ldc + col0;
#pragma unroll
                for (int bj = 0; bj < 2; ++bj)
#pragma unroll
                    for (int n = 0; n < 2; ++n) { const f32x4 x1 = acc[ai][bj][m][n]; *(f32x4*)(out + off + bj * HALF + n * 16) = bad1 ? (f32x4){qnan, qnan, qnan, qnan} : x1;
                        const f32x4 o = (x1 - sr.x) * sr.y; u32x2v w; w.x = cvt_pk_bf16(o[0], o[1]); w.y = cvt_pk_bf16(o[2], o[3]);
                        if (bad) { w.x = 0x7fc07fc0u; w.y = 0x7fc07fc0u; } *(u32x2v*)(xn + off + bj * HALF + n * 16) = w; }
                asm volatile("" ::: "memory"); }
    }
};

template <class Epi, class Sched, bool STAMP = false>
__device__ __forceinline__ void gemm_phase(PG8_LAS unsigned char* lds, const Gemm g, const Sched& S, const Epi& E, unsigned long long* stamps) {
    int tid_l = threadIdx.x; asm volatile("" : "+v"(tid_l));
    const int tid = tid_l, wid = __builtin_amdgcn_readfirstlane(tid >> 6), lane = tid & 63, wr = wid >> 2, wc = wid & 3, fr = lane & 15, fq = lane >> 4;
    const int K = g.K, nt = g.kn / BK;
    int ts_lo = 0, ts_hi = 0, nts = 0; const unsigned long long rt_entry = STAMP ? (unsigned long long)wall_clock64() : 0ull;
#define PG8_STAMP() do { if (STAMP && wid == 0 && nts < 64) { const unsigned long long _c = (unsigned long long)clock64(); \
        ts_lo = (lane == nts) ? (int)(unsigned)_c : ts_lo; ts_hi = (lane == nts) ? (int)(unsigned)(_c >> 32) : ts_hi; ++nts; } } while (0)
    PG8_STAMP();
    unsigned voffA[2], voffB[2];
#pragma unroll
    for (int i = 0; i < 2; ++i) { int R, C; stage_rc(tid * 16 + i * 8192, R, C); const int Rb = Epi::PERM ? ((R & ~31) + perm32(R & 31)) : R;
        voffA[i] = (unsigned)(R * K + C) * 2u; voffB[i] = (unsigned)(Rb * K + C) * 2u; }
    const size_t kstep = (size_t)(BK * 2);
    const size_t hstep = (size_t)HALF * K * 2;
    const size_t tstep = 2 * hstep;
    const unsigned ldsw = (unsigned)wid * 1024u;
    const int aoff = lds_byte(wr * 64 + fr, fq * 8), boff = lds_byte(wc * 32 + fr, fq * 8);
#define PG8_SA(b, h) (((b) * 2 + (h)) * HTB)
#define PG8_SB(b, h) ((4 + (b) * 2 + (h)) * HTB)
#define PG8_STAGE(bufoff, gbase, voff) do { _Pragma("unroll") for (int _i = 0; _i < 2; ++_i) \
        __builtin_amdgcn_global_load_lds((const unsigned*)((const char*)(gbase) + (voff)[_i]), (PG8_LAS unsigned*)(lds + (bufoff) + ldsw + _i * 8192), 16, 0, 0); } while (0)
#define PG8_LDA(dst, b, h) do { _Pragma("unroll") for (int m = 0; m < 4; ++m) _Pragma("unroll") for (int k = 0; k < 2; ++k) dst[m][k] = *(const PG8_LAS bf16x8*)(lds + PG8_SA(b, h) + aoff + m * 2048 + k * 1024); } while (0)
#define PG8_LDB(dst, b, h) do { _Pragma("unroll") for (int n = 0; n < 2; ++n) _Pragma("unroll") for (int k = 0; k < 2; ++k) dst[n][k] = *(const PG8_LAS bf16x8*)(lds + PG8_SB(b, h) + boff + n * 2048 + k * 1024); } while (0)
#define PG8_MMA(ai, bj, At, Bt) do { __builtin_amdgcn_s_setprio(1); _Pragma("unroll") for (int m = 0; m < 4; ++m) _Pragma("unroll") for (int n = 0; n < 2; ++n) _Pragma("unroll") for (int k = 0; k < 2; ++k) \
        acc[ai][bj][m][n] = __builtin_amdgcn_mfma_f32_16x16x32_bf16(Bt[n][k], At[m][k], acc[ai][bj][m][n], 0, 0, 0); __builtin_amdgcn_s_setprio(0); } while (0)
#define PG8_WAIT_V(n) asm volatile("s_waitcnt vmcnt(" #n ")" ::: "memory")
#define PG8_WAIT_L(n) asm volatile("s_waitcnt lgkmcnt(" #n ")" ::: "memory")
#define PG8_BAR __builtin_amdgcn_s_barrier()
#define PG8_SCHED __builtin_amdgcn_sched_barrier(0)
    Unit cur, nxt; int ui = 0;
    if (!S.next(0, cur)) return;
    f32x4 acc[2][2][4][2];
#pragma unroll
    for (int a = 0; a < 2; ++a)
#pragma unroll
        for (int b = 0; b < 2; ++b)
#pragma unroll
            for (int m = 0; m < 4; ++m)
#pragma unroll
                for (int n = 0; n < 2; ++n) acc[a][b][m][n] = (f32x4){0.f, 0.f, 0.f, 0.f};
    bf16x8 At[4][2], B0[2][2], B1[2][2];
    const char* cA = (const char*)g.A + (size_t)cur.pm * tstep; const char* cB = (const char*)g.Bt + (size_t)cur.pn * tstep;
    S.a_ready(cur);
    PG8_STAGE(PG8_SB(0, 0), cB, voffB); PG8_STAGE(PG8_SA(0, 0), cA, voffA); PG8_STAGE(PG8_SB(0, 1), cB + hstep, voffB); PG8_STAGE(PG8_SA(0, 1), cA + hstep, voffA);
    if (wr == 1) PG8_BAR;
    PG8_WAIT_V(4); PG8_BAR;
    PG8_STAGE(PG8_SB(1, 0), cB + kstep, voffB); PG8_STAGE(PG8_SA(1, 0), cA + kstep, voffA); PG8_STAGE(PG8_SB(1, 1), cB + hstep + kstep, voffB);
    PG8_WAIT_V(6); PG8_BAR;
    PG8_STAMP();
    for (;;) {
        const bool has_next = S.next(ui + 1, nxt);
        const char* nA = has_next ? (const char*)g.A + (size_t)nxt.pm * tstep : cA; const char* nB = has_next ? (const char*)g.Bt + (size_t)nxt.pn * tstep : cB;
        for (int t = 0; t < nt; t += 2) {
            const bool last = (t == nt - 2);
            const char* a1 = cA + (size_t)(t + 1) * kstep;
            const char* a2 = last ? nA : cA + (size_t)(t + 2) * kstep; const char* b2 = last ? nB : cB + (size_t)(t + 2) * kstep;
            const char* a3 = a2 + kstep; const char* b3 = b2 + kstep;
            if (last && has_next) S.a_ready(nxt);
            PG8_LDB(B0, 0, 0); PG8_SCHED; PG8_LDA(At, 0, 0); PG8_STAGE(PG8_SA(1, 1), a1 + hstep, voffA);
            PG8_WAIT_L(8); PG8_BAR; PG8_WAIT_L(0); PG8_MMA(0, 0, At, B0); PG8_BAR; PG8_SCHED;
            PG8_LDB(B1, 0, 1); PG8_STAGE(PG8_SB(0, 0), b2, voffB);
            PG8_BAR; PG8_WAIT_L(0); PG8_MMA(0, 1, At, B1); PG8_BAR;
            PG8_LDA(At, 0, 1); PG8_STAGE(PG8_SA(0, 0), a2, voffA);
            PG8_BAR; PG8_WAIT_L(0); PG8_MMA(1, 0, At, B0); PG8_BAR; PG8_SCHED;
            PG8_STAGE(PG8_SB(0, 1), b2 + hstep, voffB);
            PG8_WAIT_V(6); PG8_BAR; PG8_MMA(1, 1, At, B1); PG8_BAR;
            PG8_LDB(B0, 1, 0); PG8_SCHED; PG8_LDA(At, 1, 0); PG8_STAGE(PG8_SA(0, 1), a2 + hstep, voffA);
            PG8_WAIT_L(8); PG8_BAR; PG8_WAIT_L(0); PG8_MMA(0, 0, At, B0); PG8_BAR; PG8_SCHED;
            PG8_LDB(B1, 1, 1); PG8_STAGE(PG8_SB(1, 0), b3, voffB);
            PG8_BAR; PG8_WAIT_L(0); PG8_MMA(0, 1, At, B1); PG8_BAR;
            PG8_LDA(At, 1, 1); PG8_STAGE(PG8_SA(1, 0), a3, voffA);
            PG8_BAR; PG8_WAIT_L(0); PG8_MMA(1, 0, At, B0); PG8_BAR; PG8_SCHED;
            PG8_STAGE(PG8_SB(1, 1), b3 + hstep, voffB);
            PG8_WAIT_V(6); PG8_BAR; PG8_MMA(1, 1, At, B1); PG8_BAR;
        }
        PG8_STAMP();
        if constexpr (!Epi::AFTER_DRAIN) { E(acc, cur, wr, wc, fr, fq); S.done(cur); }
        PG8_STAMP();
        if (!has_next) break;
#pragma unroll
        for (int a = 0; a < 2; ++a)
#pragma unroll
            for (int b = 0; b < 2; ++b)
#pragma unroll
                for (int m = 0; m < 4; ++m)
#pragma unroll
                    for (int n = 0; n < 2; ++n) acc[a][b][m][n] = (f32x4){0.f, 0.f, 0.f, 0.f};
        cur = nxt; cA = nA; cB = nB; ++ui;
    }
    PG8_WAIT_V(0);
    if (wr == 0) PG8_BAR;
    PG8_BAR;
    if constexpr (Epi::AFTER_DRAIN) { E.fused(acc, cur, wr, wc, fr, fq, lds, wid, lane); S.done(cur); }
    PG8_STAMP();
    if (STAMP && wid == 0) { stamps[lane] = lane < nts ? (((unsigned long long)(unsigned)ts_hi << 32) | (unsigned)ts_lo) : 0ull;
        if (lane == 62) stamps[62] = rt_entry; if (lane == 63) stamps[63] = (unsigned long long)wall_clock64(); }
#undef PG8_STAMP
#undef PG8_SA
#undef PG8_SB
#undef PG8_STAGE
#undef PG8_LDA
#undef PG8_LDB
#undef PG8_MMA
#undef PG8_WAIT_V
#undef PG8_WAIT_L
#undef PG8_BAR
#undef PG8_SCHED
}
}

#include <hip/hip_cooperative_groups.h>
#include <cstdio>
namespace cg = cooperative_groups;
using namespace pg8;
#define LAS PG8_LAS
typedef float f32x16 __attribute__((ext_vector_type(16)));
typedef unsigned u32x2 __attribute__((ext_vector_type(2)));
typedef float f32x2 __attribute__((ext_vector_type(2)));

constexpr int D = 1024, NB = 8, SEQ = 2048, CTXL = 256, NLAT = NB * SEQ, NCTX = NB * CTXL, NROW = NLAT + NCTX, DFF = 2816;
constexpr float ALPHA_F = 1.41421356237309515f;
constexpr int LDS_BYTES = 135168;
#define PROBE_MASK 0
#define PROBE_REP(bit) for (int rep_ = 0; rep_ < ((PROBE_MASK & (bit)) ? 2 : 1); ++rep_)

constexpr size_t al256(size_t x) { return (x + 255) & ~(size_t)255; }
constexpr size_t WS_MOD = 0;
constexpr size_t WS_KF = al256(WS_MOD + (size_t)2 * 9 * 9216 * 4);
constexpr size_t WS_KFC = al256(WS_KF + (size_t)512 * 4096 * 4);
constexpr size_t WS_XCTX = al256(WS_KFC + (size_t)512 * 512 * 4);
constexpr size_t WS_AGG = al256(WS_XCTX + (size_t)NCTX * D * 4);
constexpr size_t WS_WFI = al256(WS_AGG + (size_t)2 * 8 * 72 * 512 * 2 * 4);
constexpr size_t SZ_WFI = (size_t)5632 * 1024 * 2;
constexpr size_t WS_WFO = al256(WS_WFI + 4 * SZ_WFI);
constexpr size_t SZ_WFO = (size_t)1024 * 2816 * 2;
constexpr size_t WS_WEI = al256(WS_WFO + 4 * SZ_WFO);
constexpr size_t WS_WEO = al256(WS_WEI + (size_t)2560 * 1024 * 2);
constexpr size_t WS_WRG = al256(WS_WEO + (size_t)1024 * 1024 * 2);
constexpr size_t WS_WMI = al256(WS_WRG + (size_t)2048 * 512 * 2);
constexpr size_t WS_WQU = al256(WS_WMI + (size_t)1280 * 1024 * 2);
constexpr size_t WS_WKU = al256(WS_WQU + (size_t)1536 * 768 * 2);
constexpr size_t WS_WVU = al256(WS_WKU + (size_t)1024 * 256 * 2);
constexpr size_t WS_WMO = al256(WS_WVU + (size_t)1024 * 256 * 2);
constexpr size_t WS_H = al256(WS_WMO + (size_t)1024 * 1024 * 2);
constexpr size_t WS_ACT = al256(WS_H + (size_t)NROW * D * 2);
constexpr size_t WS_G = al256(WS_ACT + (size_t)NROW * DFF * 2);
constexpr size_t WS_XC = al256(WS_G + (size_t)NROW * 2048 * 2);
constexpr size_t WS_YT = al256(WS_XC + (size_t)NROW * 512 * 2);
constexpr size_t WS_BAR = al256(WS_YT + (size_t)512 * NROW * 2);
constexpr size_t WS_END = al256(WS_BAR + 16384);
constexpr size_t WS_UT = WS_ACT;
constexpr size_t WS_URG = al256(WS_UT + (size_t)1536 * NROW * 2);
constexpr size_t WS_P = WS_ACT;
constexpr size_t WS_Q = WS_ACT;
constexpr size_t WS_QN = al256(WS_ACT + (size_t)NLAT * 1536 * 2);
constexpr size_t WS_KVN = al256(WS_QN + (size_t)NLAT * 768 * 2);
constexpr size_t WS_KR = al256(WS_KVN + (size_t)NROW * 256 * 2);
static_assert(WS_KR + (size_t)NROW * 32 * 2 <= WS_G, "layer-1 aliases overflow ACT");
static_assert(WS_URG + (size_t)NROW * 1024 * 2 <= WS_G, "layer-0 aliases overflow ACT");
constexpr size_t WS_K = WS_G;
constexpr size_t WS_VT = WS_G + (size_t)NROW * 1024 * 2;

struct Params { const float* in[34]; float* out; unsigned char* ws; };
enum { I_X = 0, I_C, I_CTX, I_CCTX, I_ADAW, I_ADAB, I_LNG, I_LNB, I_FWI, I_FWO, I_EWI, I_EWO, I_HCW, I_HCB, I_HW1, I_HB1, I_HW2, I_HB2, I_HW3, I_HSF, I_HBIAS,
       I_RCW, I_RCB, I_RAW, I_RAB, I_RXW, I_RXB, I_RLAM, I_MWI, I_MQN, I_MKVN, I_MWQ, I_MWKV, I_MWO };

extern __shared__ __attribute__((aligned(16))) unsigned char lds_raw[];
constexpr int TAB_OFF = LDS_BYTES - 16 - 320;
__device__ __forceinline__ unsigned char* tabptr(int i) {
  const volatile LAS unsigned* t = (const volatile LAS unsigned*)((LAS unsigned char*)lds_raw + TAB_OFF) + 2 * i;
  const unsigned lo = __builtin_amdgcn_readfirstlane(t[0]), hi = __builtin_amdgcn_readfirstlane(t[1]);
  return (unsigned char*)(((size_t)hi << 32) | (size_t)lo);
}
#define PIN(i) ((const float*)tabptr(i))
__device__ __forceinline__ int ltid() { int t = threadIdx.x; asm volatile("" : "+v"(t)); return t; }
#define Q8_EMU 0
__device__ __forceinline__ float q8(float x) { unsigned u = __float_as_uint(x); u += 0x7FFFFu + ((u >> 20) & 1u); u &= 0xFFF00000u; return __uint_as_float(u); }
__device__ __forceinline__ float bf2f(unsigned short b) { return __uint_as_float(((unsigned)b) << 16); }
__device__ __forceinline__ float bflo(unsigned w) { return __uint_as_float(w << 16); }
__device__ __forceinline__ float bfhi(unsigned w) { return __uint_as_float(w & 0xffff0000u); }
__device__ __forceinline__ float wave_sum(float v) {
#pragma unroll
  for (int o = 1; o < 64; o <<= 1) v += __shfl_xor(v, o);
  return v;
}
__device__ __forceinline__ float sigmoidf_(float x) { return 1.0f / (1.0f + __expf(-x)); }

struct EpiSwiGLU {
  static constexpr bool PERM = true, AFTER_DRAIN = false;
  bf16_t* O;
  __device__ __forceinline__ void operator()(const f32x4 (&acc)[2][2][4][2], const Unit& u, int wr, int wc, int fr, int fq) const {
    const int row0 = u.pm * BM + wr * 64 + fr, col0 = u.pn * 128 + wc * 32 + 8 * fq;
#pragma unroll
    for (int ai = 0; ai < 2; ++ai)
#pragma unroll
      for (int m = 0; m < 4; ++m) {
        float v[8];
#pragma unroll
        for (int n = 0; n < 2; ++n)
#pragma unroll
          for (int j = 0; j < 4; ++j) { const float a = acc[ai][0][m][n][j], g = acc[ai][1][m][n][j]; const float sg = __builtin_amdgcn_rcpf(1.0f + __expf(-a)); v[4 * n + j] = a * sg * g; }
        u32x4 w; w.x = cvt_pk_bf16(v[0], v[1]); w.y = cvt_pk_bf16(v[2], v[3]); w.z = cvt_pk_bf16(v[4], v[5]); w.w = cvt_pk_bf16(v[6], v[7]);
        *(u32x4*)(O + (size_t)(row0 + ai * HALF + m * 16) * DFF + col0) = w;
      }
  }
};
struct EpiResid {
  static constexpr bool PERM = true, AFTER_DRAIN = false;
  bf16_t* Y2; const float* mod; int gidx; float gs;
  __device__ __forceinline__ void operator()(const f32x4 (&acc)[2][2][4][2], const Unit& u, int wr, int wc, int fr, int fq) const {
    const int rt = u.pm * BM; const int mr = rt / SEQ;
    const int row0 = rt + wr * 64 + fr, col0 = u.pn * BM + wc * 32 + 8 * fq;
    const float* gp = mod + (size_t)(mr * 9 + gidx) * D + col0;
    f32x4 gv[2][2];
#pragma unroll
    for (int bj = 0; bj < 2; ++bj)
#pragma unroll
      for (int n = 0; n < 2; ++n) gv[bj][n] = *(const f32x4*)(gp + bj * HALF + n * 4) * gs;
#pragma unroll
    for (int ai = 0; ai < 2; ++ai)
#pragma unroll
      for (int m = 0; m < 4; ++m) {
        bf16_t* rowp = Y2 + (size_t)(row0 + ai * HALF + m * 16) * D + col0;
#pragma unroll
        for (int bj = 0; bj < 2; ++bj) { const f32x4 v0 = acc[ai][bj][m][0] * gv[bj][0], v1 = acc[ai][bj][m][1] * gv[bj][1];
          u32x4 w; w.x = cvt_pk_bf16(v0[0], v0[1]); w.y = cvt_pk_bf16(v0[2], v0[3]); w.z = cvt_pk_bf16(v1[0], v1[1]); w.w = cvt_pk_bf16(v1[2], v1[3]);
          *(u32x4*)(rowp + bj * HALF) = w; }
      }
  }
};
struct EpiBf16P {
  static constexpr bool PERM = true, AFTER_DRAIN = false;
  bf16_t* O; size_t ldc;
  __device__ __forceinline__ void operator()(const f32x4 (&acc)[2][2][4][2], const Unit& u, int wr, int wc, int fr, int fq) const {
    const int row0 = u.pm * BM + wr * 64 + fr, col0 = u.pn * BM + wc * 32 + 8 * fq;
#pragma unroll
    for (int ai = 0; ai < 2; ++ai)
#pragma unroll
      for (int m = 0; m < 4; ++m) {
        bf16_t* rowp = O + (size_t)(row0 + ai * HALF + m * 16) * ldc + col0;
#pragma unroll
        for (int bj = 0; bj < 2; ++bj) { const f32x4 v0 = acc[ai][bj][m][0], v1 = acc[ai][bj][m][1];
          u32x4 w; w.x = cvt_pk_bf16(v0[0], v0[1]); w.y = cvt_pk_bf16(v0[2], v0[3]); w.z = cvt_pk_bf16(v1[0], v1[1]); w.w = cvt_pk_bf16(v1[2], v1[3]);
          *(u32x4*)(rowp + bj * HALF) = w; }
      }
  }
};
struct EpiGate {
  static constexpr bool PERM = true, AFTER_DRAIN = false;
  bf16_t* O; const float* ab; const float* xb;
  __device__ __forceinline__ void operator()(const f32x4 (&acc)[2][2][4][2], const Unit& u, int wr, int wc, int fr, int fq) const {
    const int row0 = u.pm * BM + wr * 64 + fr, col0 = u.pn * BM + wc * 32 + 8 * fq;
    f32x4 bv[2][2];
#pragma unroll
    for (int bj = 0; bj < 2; ++bj) { const int c = col0 + bj * HALF, g = c >> 9, e = c & 511; const float* bp = ((g & 1) ? xb : ab) + (g >> 1) * 512 + e;
      bv[bj][0] = *(const f32x4*)bp; bv[bj][1] = *(const f32x4*)(bp + 4); }
#pragma unroll
    for (int ai = 0; ai < 2; ++ai)
#pragma unroll
      for (int m = 0; m < 4; ++m) {
        bf16_t* rowp = O + (size_t)(row0 + ai * HALF + m * 16) * 2048 + col0;
#pragma unroll
        for (int bj = 0; bj < 2; ++bj) { f32x4 v0 = acc[ai][bj][m][0] + bv[bj][0], v1 = acc[ai][bj][m][1] + bv[bj][1];
#pragma unroll
          for (int j = 0; j < 4; ++j) { v0[j] = sigmoidf_(v0[j]); v1[j] = sigmoidf_(v1[j]); }
          u32x4 w; w.x = cvt_pk_bf16(v0[0], v0[1]); w.y = cvt_pk_bf16(v0[2], v0[3]); w.z = cvt_pk_bf16(v1[0], v1[1]); w.w = cvt_pk_bf16(v1[2], v1[3]);
          *(u32x4*)(rowp + bj * HALF) = w; }
      }
  }
};
__device__ __forceinline__ float rope_inv_freq(int p) { return exp2f(-(float)p * (13.287712379549449f / 8.0f)); }
struct EpiQ {
  static constexpr bool PERM = true, AFTER_DRAIN = false;
  bf16_t* O;
  __device__ __forceinline__ void operator()(const f32x4 (&acc)[2][2][4][2], const Unit& u, int wr, int wc, int fr, int fq) const {
    const int row0 = u.pm * BM + wr * 64 + fr, col0 = u.pn * BM + wc * 32 + 8 * fq;
#pragma unroll
    for (int bj = 0; bj < 2; ++bj) {
      const int c8 = col0 + bj * HALF; const int f = c8 % 96; const bool rope = f >= 64; const int rp = f - 64; const int a = (rp >> 4) & 1, e = (rp >> 3) & 1;
      float invf[4];
#pragma unroll
      for (int jj = 0; jj < 4; ++jj) invf[jj] = rope_inv_freq(4 * e + jj);
#pragma unroll
      for (int ai = 0; ai < 2; ++ai)
#pragma unroll
        for (int m = 0; m < 4; ++m) {
          const int row = row0 + ai * HALF + m * 16; const int t = row & (SEQ - 1); const float pos = (float)(a == 0 ? (t >> 6) : (t & 63));
          const f32x4 v0 = acc[ai][bj][m][0], v1 = acc[ai][bj][m][1];
          float v[8] = {v0[0], v0[1], v0[2], v0[3], v1[0], v1[1], v1[2], v1[3]};
          if (rope) {
#pragma unroll
            for (int jj = 0; jj < 4; ++jj) { const float ang = pos * invf[jj]; const float cs = __cosf(ang), sn = __sinf(ang); const float x1 = v[2 * jj], x2 = v[2 * jj + 1];
              v[2 * jj] = x1 * cs - x2 * sn; v[2 * jj + 1] = x2 * cs + x1 * sn; }
          }
          u32x4 w; w.x = cvt_pk_bf16(v[0], v[1]); w.y = cvt_pk_bf16(v[2], v[3]); w.z = cvt_pk_bf16(v[4], v[5]); w.w = cvt_pk_bf16(v[6], v[7]);
          *(u32x4*)(O + (size_t)row * 1536 + c8) = w;
        }
    }
  }
};

enum { MAP_ID = 0, MAP_SWIGLU, MAP_MLAIN, MAP_QUP, MAP_KUP, MAP_VUP, MAP_RG };
struct ConvDesc { int kind, K, ld, tile; const float* W; const float* W2; const float* sc; bf16_t* dst; };
__device__ __forceinline__ void conv_load(const ConvDesc& d, int tid, float (&v)[8]) {
  const int nkt = d.K >> 6; const int kt = d.tile % nkt, nt = d.tile / nkt; const int k0 = kt * 64, n0 = nt * 64;
  const int nn = tid & 63, kq = tid >> 6; const int n = n0 + nn; const int kind = d.kind;
  int col = n;
  if (kind == MAP_SWIGLU) { const int t = n >> 8, h = (n >> 7) & 1, j = n & 127; col = h * DFF + t * 128 + j; }
  else if (kind == MAP_MLAIN) { col = n < 1056 ? n : -1; }
  else if (kind == MAP_QUP) { const int hh = n / 96, f = n % 96; if (f >= 64) { const int rp = f - 64, a = rp >> 4, w = rp & 15, pp = w >> 1, hf = w & 1; col = hh * 96 + 64 + a * 16 + hf * 8 + pp; } }
  else if (kind == MAP_KUP) { col = (n >> 6) * 128 + (n & 63); }
  else if (kind == MAP_VUP) { col = (n >> 6) * 128 + 64 + (n & 63); }
#pragma unroll
  for (int i = 0; i < 8; ++i) {
    const int k = k0 + i * 8 + kq; float x;
    if (kind == MAP_RG) { const int g = n >> 9, e = n & 511, nb = e >> 6; x = ((k >> 6) == nb) ? ((g & 1) ? d.W2 : d.W)[((((g >> 1) * 8 + nb) * 64 + (k & 63)) << 6) + (e & 63)] : 0.f; }
    else x = col >= 0 ? d.W[(size_t)k * d.ld + col] : 0.f;
    if (d.sc) x *= d.sc[k];
    if (Q8_EMU && (kind == MAP_SWIGLU || d.K == 2816)) x = q8(x);
    v[i] = x;
  }
}
__device__ __forceinline__ void conv_store(LAS float* scr, const ConvDesc& d, int tid, const float (&v)[8]) {
  const int nkt = d.K >> 6; const int kt = d.tile % nkt, nt = d.tile / nkt; const int k0 = kt * 64, n0 = nt * 64;
  const int nn = tid & 63, kq = tid >> 6;
#pragma unroll
  for (int i = 0; i < 8; ++i) scr[(i * 8 + kq) * 65 + nn] = v[i];
  __syncthreads();
  { const int nl = tid >> 3, c = tid & 7; const LAS float* s = scr + (8 * c) * 65 + nl;
    u32x4 o; o.x = cvt_pk_bf16(s[0], s[65]); o.y = cvt_pk_bf16(s[2 * 65], s[3 * 65]); o.z = cvt_pk_bf16(s[4 * 65], s[5 * 65]); o.w = cvt_pk_bf16(s[6 * 65], s[7 * 65]);
    *(u32x4*)(d.dst + (size_t)(n0 + nl) * d.K + k0 + 8 * c) = o; }
  __syncthreads();
}
__device__ __forceinline__ void convw_load(const ConvDesc& d, int tid, f32x4 (&v)[8]) {
  const int nkt = d.K >> 6; const int kt = d.tile % nkt, nt = d.tile / nkt; const int k0 = kt * 64;
  const int c4 = (tid & 63) * 4, kq = tid >> 6;
  const int col = d.kind == MAP_SWIGLU ? (c4 < 128 ? nt * 128 + c4 : DFF + nt * 128 + (c4 - 128)) : nt * 256 + c4;
#pragma unroll
  for (int i = 0; i < 8; ++i) v[i] = *(const f32x4*)(d.W + (size_t)(k0 + i * 8 + kq) * d.ld + col);
}
__device__ __forceinline__ void convw_store(LAS float* scr, const ConvDesc& d, int tid, const f32x4 (&v)[8]) {
  const int nkt = d.K >> 6; const int kt = d.tile % nkt, nt = d.tile / nkt; const int k0 = kt * 64, n0 = nt * 256;
  const int c4 = (tid & 63) * 4, kq = tid >> 6;
#pragma unroll
  for (int i = 0; i < 8; ++i) *(LAS f32x4*)(scr + (i * 8 + kq) * 260 + c4) = v[i];
  __syncthreads();
  { const int nl = tid >> 1, ch0 = (tid & 1) * 4;
#pragma unroll
    for (int c = 0; c < 4; ++c) { const LAS float* s = scr + (8 * (ch0 + c)) * 260 + nl;
      u32x4 o; o.x = cvt_pk_bf16(s[0], s[260]); o.y = cvt_pk_bf16(s[2 * 260], s[3 * 260]); o.z = cvt_pk_bf16(s[4 * 260], s[5 * 260]); o.w = cvt_pk_bf16(s[6 * 260], s[7 * 260]);
      *(u32x4*)(d.dst + (size_t)(n0 + nl) * d.K + k0 + 8 * (ch0 + c)) = o; } }
  __syncthreads();
}
__device__ __forceinline__ void adaln_job(LAS float* L, const Params& p, int z, float* MOD, int job, bool fill) {
  const int tid = ltid(); const int l = job / 288, col0 = (job % 288) * 32;
  if (fill) { const float* pc = PIN(I_C); const float* pcc = PIN(I_CCTX); for (int i = tid; i < 9 * 1024; i += 512) { const int r = i >> 10, k = i & 1023; const float x = r < 8 ? pc[r * 1024 + k] : pcc[k]; L[i] = x * sigmoidf_(x); }
    __syncthreads(); }
  const int col = tid & 31, kg = tid >> 5;
  const float* W = PIN(I_ADAW) + (size_t)l * 1024 * 9216 + col0 + col + (size_t)(kg * 64) * 9216;
  float acc[9];
#pragma unroll
  for (int r = 0; r < 9; ++r) acc[r] = 0.f;
#pragma unroll 1
  for (int kb = 0; kb < 64; kb += 16) { float w[16];
#pragma unroll
    for (int j = 0; j < 16; ++j) w[j] = W[(size_t)(kb + j) * 9216];
#pragma unroll
    for (int j = 0; j < 16; ++j)
#pragma unroll
      for (int r = 0; r < 9; ++r) acc[r] += L[r * 1024 + kg * 64 + kb + j] * w[j]; }
  LAS float* part = L + 9 * 1024;
#pragma unroll
  for (int r = 0; r < 9; ++r) part[(kg * 9 + r) * 32 + col] = acc[r];
  __syncthreads();
  if (tid < 288) { const int r = tid >> 5, cc = tid & 31; float s = 0.f;
#pragma unroll
    for (int g = 0; g < 16; ++g) s += part[(g * 9 + r) * 32 + cc];
    MOD[(size_t)(l * 9 + r) * 9216 + col0 + cc] = s + PIN(I_ADAB)[l * 9216 + col0 + cc]; }
  __syncthreads();
}
__device__ __forceinline__ void filter_job(LAS float* Ls, const Params& p, int z, float* KF, int L, int job) {
  const int tid = ltid(); const int pos0 = job * 16;
  LAS float* feats = Ls; LAS float* h1 = Ls + 16 * 33; LAS float* h2 = h1 + 1024;
  for (int e = tid; e < 16 * 33; e += 512) { const int pp = e / 33, i = e % 33; const float pos = (float)(pos0 + pp); const float t = pos / (float)L; float v;
    if (i == 0) v = t;
    else { const int j = (i - 1) & 15; const float band = 1e-4f + (float)j * ((15.0f - 1e-4f) / 15.0f); const float rev = t * band;
      v = (i <= 16) ? __builtin_amdgcn_cosf(rev) : -__builtin_amdgcn_sinf(rev); }
    feats[e] = v; }
  __syncthreads();
  { const int j = tid & 63; const float b1 = PIN(I_HB1)[j], f0 = PIN(I_HSF)[j]; float s0 = b1, s1 = b1; const int p0 = tid >> 6, p1 = p0 + 8;
    const float* pw1 = PIN(I_HW1);
#pragma unroll 11
    for (int i = 0; i < 33; ++i) { const float w = pw1[i * 64 + j]; s0 += feats[p0 * 33 + i] * w; s1 += feats[p1 * 33 + i] * w; }
    h1[p0 * 64 + j] = __sinf(f0 * s0); h1[p1 * 64 + j] = __sinf(f0 * s1); }
  __syncthreads();
  { const int j = tid & 63; const float b2 = PIN(I_HB2)[j], f1 = PIN(I_HSF)[64 + j]; float s0 = b2, s1 = b2; const int p0 = tid >> 6, p1 = p0 + 8;
    const float* pw2 = PIN(I_HW2);
#pragma unroll 16
    for (int i = 0; i < 64; ++i) { const float w = pw2[i * 64 + j]; s0 += h1[p0 * 64 + i] * w; s1 += h1[p1 * 64 + i] * w; }
    h2[p0 * 64 + j] = __sinf(f1 * s0); h2[p1 * 64 + j] = __sinf(f1 * s1); }
  __syncthreads();
  const int ch = tid; const float delta = fabsf(-3.0701134573253945f + (float)ch * ((-15.350567286626973f + 3.0701134573253945f) / 511.0f));
#pragma unroll 1
  for (int q = 0; q < 2; ++q) {
    const int n = q * 512 + ch; float acc[16]; const float* pw3 = PIN(I_HW3);
#pragma unroll
    for (int pp = 0; pp < 16; ++pp) acc[pp] = 0.f;
#pragma unroll 1
    for (int ib = 0; ib < 64; ib += 4) { float w[4];
#pragma unroll
      for (int j = 0; j < 4; ++j) w[j] = pw3[(ib + j) * 1024 + n];
#pragma unroll
      for (int j = 0; j < 4; ++j)
#pragma unroll
        for (int pp = 0; pp < 16; ++pp) acc[pp] += h2[pp * 64 + ib + j] * w[j]; }
#pragma unroll
    for (int pp = 0; pp < 16; ++pp) { const int d = pos0 + pp; const float t = (float)d / (float)L; const float val = acc[pp] * (__expf(-t * delta) + 0.05f);
      if (q == 0) KF[(size_t)ch * (2 * L) + L + d] = val; else if (d >= 1) KF[(size_t)ch * (2 * L) + L - d] = val; }
  }
  __syncthreads();
}

__device__ __forceinline__ void row_pass(const float* srcLat, const float* srcCtx, float* dstLat, float* dstCtx, bool do_ln, const float* g, const float* b, bf16_t* H, const float* modn  , int sidx, int nrows, const float* zp, const float* gate8, float gs, const bf16_t* y2) {
  const int lane = ltid() & 63; const int gw = blockIdx.x * 8 + (ltid() >> 6), ngw = gridDim.x * 8;
  constexpr int R = 3;
#pragma unroll 1
  for (int row0 = gw; row0 < nrows; row0 += R * ngw) {
    f32x4 v[R][4]; bool ok[R]; const float* src[R]; float* dst[R]; int rows[R];
#pragma unroll
    for (int r = 0; r < R; ++r) { const int row = row0 + r * ngw; rows[r] = row; ok[r] = row < nrows; const int rr = ok[r] ? row : row0; const bool lat = rr < NLAT;
      src[r] = lat ? srcLat + (size_t)rr * D : srcCtx + (size_t)(rr - NLAT) * D; dst[r] = lat ? dstLat + (size_t)rr * D : dstCtx + (size_t)(rr - NLAT) * D;
#pragma unroll
      for (int j = 0; j < 4; ++j) v[r][j] = *(const f32x4*)(src[r] + lane * 4 + 256 * j);
      if (y2 && lat) { const bf16_t* yr = y2 + (size_t)rr * D + lane * 4;
#pragma unroll
        for (int j = 0; j < 4; ++j) { const u32x2 w = *(const u32x2*)(yr + 256 * j); v[r][j] = v[r][j] * ALPHA_F + (f32x4){bflo(w.x), bfhi(w.x), bflo(w.y), bfhi(w.y)}; } }
      if (zp && !lat) { const float* zr = zp + (size_t)(rr - NLAT) * D + lane * 4;
#pragma unroll
        for (int j = 0; j < 4; ++j) { const f32x4 y = (*(const f32x4*)(zr + 256 * j) + *(const f32x4*)(zr + (size_t)NCTX * D + 256 * j)) + (*(const f32x4*)(zr + (size_t)2 * NCTX * D + 256 * j) + *(const f32x4*)(zr + (size_t)3 * NCTX * D + 256 * j));
          v[r][j] = v[r][j] * ALPHA_F + (*(const f32x4*)(gate8 + lane * 4 + 256 * j) * gs) * y; } } }
    if (do_ln) {
      float s[R], q[R];
#pragma unroll
      for (int r = 0; r < R; ++r) { s[r] = 0.f;
#pragma unroll
        for (int j = 0; j < 4; ++j) s[r] += (v[r][j][0] + v[r][j][1]) + (v[r][j][2] + v[r][j][3]); }
#pragma unroll
      for (int o = 1; o < 64; o <<= 1) {
#pragma unroll
        for (int r = 0; r < R; ++r) s[r] += __shfl_xor(s[r], o); }
#pragma unroll
      for (int r = 0; r < R; ++r) { const float mean = s[r] * (1.0f / D); q[r] = 0.f;
#pragma unroll
        for (int j = 0; j < 4; ++j) { v[r][j] = v[r][j] - mean; q[r] += (v[r][j][0] * v[r][j][0] + v[r][j][1] * v[r][j][1]) + (v[r][j][2] * v[r][j][2] + v[r][j][3] * v[r][j][3]); } }
#pragma unroll
      for (int o = 1; o < 64; o <<= 1) {
#pragma unroll
        for (int r = 0; r < R; ++r) q[r] += __shfl_xor(q[r], o); }
#pragma unroll
      for (int j = 0; j < 4; ++j) { const f32x4 gg = *(const f32x4*)(g + lane * 4 + 256 * j), bb = *(const f32x4*)(b + lane * 4 + 256 * j);
#pragma unroll
        for (int r = 0; r < R; ++r) { const float rstd = 1.0f / sqrtf(q[r] * (1.0f / D) + 1e-6f); v[r][j] = v[r][j] * rstd * gg + bb; } }
    }
#pragma unroll
    for (int r = 0; r < R; ++r) {
      if (!ok[r]) continue;
      if (do_ln || src[r] != dst[r]) {
#pragma unroll
        for (int j = 0; j < 4; ++j) *(f32x4*)(dst[r] + lane * 4 + 256 * j) = v[r][j];
      }
      if (H) {
        const int row = rows[r]; const int mr = row < NLAT ? row / SEQ : 8; const float* sh = modn + (size_t)(mr * 9 + sidx) * D; const float* sc = sh + D;
#pragma unroll
        for (int j = 0; j < 4; ++j) { const f32x4 s1 = *(const f32x4*)(sh + lane * 4 + 256 * j), s2 = *(const f32x4*)(sc + lane * 4 + 256 * j); f32x4 h = v[r][j] * (s2 + 1.0f) + s1; if (Q8_EMU && (sidx == 0 || sidx == 6)) { h[0] = q8(h[0]); h[1] = q8(h[1]); h[2] = q8(h[2]); h[3] = q8(h[3]); }
          u32x2 w; w.x = cvt_pk_bf16(h[0], h[1]); w.y = cvt_pk_bf16(h[2], h[3]); *(u32x2*)(H + (size_t)row * D + lane * 4 + 256 * j) = w; }
      }
    }
  }
}
__device__ __forceinline__ void mla_rownorm(const bf16_t* P, bf16_t* QN, bf16_t* KVN, bf16_t* KR) {
  const int lane = ltid() & 63; const int gw = blockIdx.x * 8 + (ltid() >> 6), ngw = gridDim.x * 8;
  for (int row = gw; row < NROW; row += ngw) {
    const bf16_t* pr = P + (size_t)row * 1280; const bool lat = row < NLAT;
    if (lat) {
      u32x2 w[3]; float ss = 0.f;
#pragma unroll
      for (int j = 0; j < 3; ++j) { w[j] = *(const u32x2*)(pr + lane * 4 + 256 * j); const float a = bflo(w[j].x), b = bfhi(w[j].x), c = bflo(w[j].y), d = bfhi(w[j].y); ss += (a * a + b * b) + (c * c + d * d); }
      const float r = 1.0f / sqrtf(wave_sum(ss) * (1.0f / 768.0f) + 1e-6f);
#pragma unroll
      for (int j = 0; j < 3; ++j) { u32x2 o; o.x = cvt_pk_bf16(bflo(w[j].x) * r, bfhi(w[j].x) * r); o.y = cvt_pk_bf16(bflo(w[j].y) * r, bfhi(w[j].y) * r); *(u32x2*)(QN + (size_t)row * 768 + lane * 4 + 256 * j) = o; }
    }
    { const u32x2 w = *(const u32x2*)(pr + 768 + lane * 4); const float a = bflo(w.x), b = bfhi(w.x), c = bflo(w.y), d = bfhi(w.y);
      const float r = 1.0f / sqrtf(wave_sum((a * a + b * b) + (c * c + d * d)) * (1.0f / 256.0f) + 1e-6f);
      u32x2 o; o.x = cvt_pk_bf16(a * r, b * r); o.y = cvt_pk_bf16(c * r, d * r); *(u32x2*)(KVN + (size_t)row * 256 + lane * 4) = o; }
    if (lane < 16) { const int a = lane >> 3, pp = lane & 7; float x1 = bf2f(pr[1024 + a * 16 + pp]), x2 = bf2f(pr[1024 + a * 16 + 8 + pp]);
      if (lat) { const int t = row & (SEQ - 1); const float pos = (float)(a == 0 ? (t >> 6) : (t & 63)); const float ang = pos * rope_inv_freq(pp); const float cs = __cosf(ang), sn = __sinf(ang);
        const float o1 = x1 * cs - x2 * sn, o2 = x2 * cs + x1 * sn; x1 = o1; x2 = o2; }
      *(unsigned*)(KR + (size_t)row * 32 + a * 16 + 2 * pp) = cvt_pk_bf16(x1, x2); }
  }
}

__device__ __forceinline__ void xc_build(const Params& p, int z, const bf16_t* URG, bf16_t* XC) {
  const float* cw = PIN(I_RCW); const float* cb = PIN(I_RCB);
  for (int it = blockIdx.x * 512 + ltid(); it < NROW * 64; it += gridDim.x * 512) {
    const int row = it >> 6, c8 = (it & 63) * 8; int t, Ls; if (row < NLAT) { t = row & (SEQ - 1); Ls = SEQ; } else { t = (row - NLAT) & (CTXL - 1); Ls = CTXL; }
    float acc[8];
#pragma unroll
    for (int j = 0; j < 8; ++j) acc[j] = cb[c8 + j];
#pragma unroll
    for (int k = 0; k < 4; ++k) { const int tt = t + k - 2; if (tt >= 0 && tt < Ls) { const u32x4 w = *(const u32x4*)(URG + (size_t)(row + k - 2) * 1024 + c8);
        const f32x4 w0 = *(const f32x4*)(cw + k * 512 + c8), w1 = *(const f32x4*)(cw + k * 512 + c8 + 4);
        acc[0] += bflo(w.x) * w0[0]; acc[1] += bfhi(w.x) * w0[1]; acc[2] += bflo(w.y) * w0[2]; acc[3] += bfhi(w.y) * w0[3];
        acc[4] += bflo(w.z) * w1[0]; acc[5] += bfhi(w.z) * w1[1]; acc[6] += bflo(w.w) * w1[2]; acc[7] += bfhi(w.w) * w1[3]; } }
    u32x4 o; o.x = cvt_pk_bf16(acc[0], acc[1]); o.y = cvt_pk_bf16(acc[2], acc[3]); o.z = cvt_pk_bf16(acc[4], acc[5]); o.w = cvt_pk_bf16(acc[6], acc[7]);
    *(u32x4*)(XC + (size_t)row * 512 + c8) = o;
  }
}
constexpr int HY_CSTRIDE = 8224;
__device__ __forceinline__ void hyena_unit(LAS unsigned char* lds, const Params& p, int z, const bf16_t* UT, const float* KFa, bf16_t* YT, int c, int L, int tokbase) {
  const int tid = ltid(), lane = tid & 63, wid = tid >> 6;
  const int OFF = L + 16, NC = 2 * L + 16; const int rstride = L * 2 + 16;
  LAS unsigned char* cp = lds; LAS unsigned char* WT = lds + 8 * HY_CSTRIDE; LAS unsigned char* X0 = WT + 8 * (2048 * 2 + 16);
  { const float bias = PIN(I_HBIAS)[c]; const float* kf = KFa + (size_t)c * (2 * L) + L; const int ngrp = NC >> 3;
#pragma unroll 3
    for (int gidx = tid; gidx < 8 * ngrp; gidx += 512) { const int r = gidx / ngrp, m = gidx - r * ngrp; const int dhi = OFF + r - 8 * m;
      float v[8];
      if (dhi < L && dhi - 7 > -L) { const f32x4 lo = *(const f32x4*)(kf + dhi - 7), hi = *(const f32x4*)(kf + dhi - 3);
        v[0] = hi[3]; v[1] = hi[2]; v[2] = hi[1]; v[3] = hi[0]; v[4] = lo[3]; v[5] = lo[2]; v[6] = lo[1]; v[7] = lo[0]; }
      else {
#pragma unroll
        for (int j = 0; j < 8; ++j) { const int d = dhi - j; v[j] = (d > -L && d < L) ? kf[d] : 0.f; } }
#pragma unroll
      for (int j = 0; j < 8; ++j) if (dhi - j == 0) v[j] += bias;
      u32x4 o; o.x = cvt_pk_bf16(v[0], v[1]); o.y = cvt_pk_bf16(v[2], v[3]); o.z = cvt_pk_bf16(v[4], v[5]); o.w = cvt_pk_bf16(v[6], v[7]);
      *(LAS u32x4*)(cp + r * HY_CSTRIDE + m * 16) = o; } }
  { const float* cw = PIN(I_HCW); const float* cb = PIN(I_HCB);
    float w0[3], w1[3], w2[3], bb[3];
#pragma unroll
    for (int a = 0; a < 3; ++a) { w0[a] = cw[0 * 1536 + a * 512 + c]; w1[a] = cw[1 * 1536 + a * 512 + c]; w2[a] = cw[2 * 1536 + a * 512 + c]; bb[a] = cb[a * 512 + c]; }
    const int cpb = L >> 3;
#pragma unroll 2
    for (int ch = tid; ch < 8 * cpb; ch += 512) { const int b = ch / cpb, t8 = (ch - b * cpb) * 8; float res[3][8];
#pragma unroll
      for (int a = 0; a < 3; ++a) { const bf16_t* rowp = UT + (size_t)(a * 512 + c) * NROW + tokbase + b * L + t8; const u32x4 w = *(const u32x4*)rowp;
        float x[10]; x[0] = t8 > 0 ? bf2f(rowp[-1]) : 0.f; x[9] = t8 + 8 < L ? bf2f(rowp[8]) : 0.f;
        x[1] = bflo(w.x); x[2] = bfhi(w.x); x[3] = bflo(w.y); x[4] = bfhi(w.y); x[5] = bflo(w.z); x[6] = bfhi(w.z); x[7] = bflo(w.w); x[8] = bfhi(w.w);
#pragma unroll
        for (int j = 0; j < 8; ++j) res[a][j] = x[j] * w0[a] + x[j + 1] * w1[a] + x[j + 2] * w2[a] + bb[a]; }
      u32x4 ow, ox;
      ow.x = cvt_pk_bf16(res[2][0] * res[1][0], res[2][1] * res[1][1]); ow.y = cvt_pk_bf16(res[2][2] * res[1][2], res[2][3] * res[1][3]);
      ow.z = cvt_pk_bf16(res[2][4] * res[1][4], res[2][5] * res[1][5]); ow.w = cvt_pk_bf16(res[2][6] * res[1][6], res[2][7] * res[1][7]);
      ox.x = cvt_pk_bf16(res[0][0], res[0][1]); ox.y = cvt_pk_bf16(res[0][2], res[0][3]); ox.z = cvt_pk_bf16(res[0][4], res[0][5]); ox.w = cvt_pk_bf16(res[0][6], res[0][7]);
      *(LAS u32x4*)(WT + b * rstride + t8 * 2) = ow; *(LAS u32x4*)(X0 + b * rstride + t8 * 2) = ox; }
  }
  __syncthreads();
  { const int n = lane & 15, g = lane >> 4, bq = n & 7; const int i = lane & 15, q = i >> 3, r = i & 7;
    const int ngroups = L >> 6;
    const LAS unsigned char* bbase = WT + bq * rstride + g * 16;
    const LAS unsigned char* abase = cp + r * HY_CSTRIDE + (8 * g - 8 * q + OFF) * 2;
    for (int grp = wid; grp < ngroups; grp += 8) {
      f32x4 acc[4];
#pragma unroll
      for (int ii = 0; ii < 4; ++ii) acc[ii] = (f32x4){0.f, 0.f, 0.f, 0.f};
      const int t0 = grp * 64;
      for (int J = 0; J < (L >> 5); ++J) {
        const bf16x8 bf = *(const LAS bf16x8*)(bbase + J * 64);
#pragma unroll
        for (int ii = 0; ii < 4; ++ii) { const bf16x8 af = *(const LAS bf16x8*)(abase + (32 * J - t0 - 16 * ii) * 2);
          acc[ii] = __builtin_amdgcn_mfma_f32_16x16x32_bf16(af, bf, acc[ii], 0, 0, 0); }
      }
      if (n < 8) {
#pragma unroll
        for (int ii = 0; ii < 4; ++ii) { const int t = t0 + 16 * ii + 4 * g; const u32x2 xw = *(const LAS u32x2*)(X0 + n * rstride + t * 2);
          u32x2 o; o.x = cvt_pk_bf16(acc[ii][0] * bflo(xw.x), acc[ii][1] * bfhi(xw.x)); o.y = cvt_pk_bf16(acc[ii][2] * bflo(xw.y), acc[ii][3] * bfhi(xw.y));
          *(u32x2*)(YT + (size_t)c * NROW + tokbase + n * L + t) = o; }
      }
    }
  }
  __syncthreads();
}
__device__ __forceinline__ void yt_transpose(LAS unsigned char* lds, const bf16_t* YT, bf16_t* Y, int job) {
  const int tid = ltid(); const int ct = job & 7, tt = job >> 3; const int c0 = ct * 64, tok0 = tt * 64;
  LAS unsigned short* T = (LAS unsigned short*)lds;
  { const int i = tid >> 3, ch = tid & 7; const u32x4 w = *(const u32x4*)(YT + (size_t)(c0 + i) * NROW + tok0 + ch * 8); *(LAS u32x4*)(T + i * 72 + ch * 8) = w; }
  __syncthreads();
  { const int t = tid >> 3, cc = (tid & 7) * 8; unsigned short v[8];
#pragma unroll
    for (int j = 0; j < 8; ++j) v[j] = T[(cc + j) * 72 + t];
    u32x4 o; o.x = v[0] | ((unsigned)v[1] << 16); o.y = v[2] | ((unsigned)v[3] << 16); o.z = v[4] | ((unsigned)v[5] << 16); o.w = v[6] | ((unsigned)v[7] << 16);
    *(u32x4*)(Y + (size_t)(tok0 + t) * 1024 + c0 + cc) = o; }
  __syncthreads();
}
constexpr int SC_CL = 32, SC_NC = 72, SC_NCTX = 8;
__device__ __forceinline__ int scan_row0(int b, int chunk) { return chunk < SC_NCTX ? NLAT + b * CTXL + chunk * SC_CL : b * SEQ + (chunk - SC_NCTX) * SC_CL; }
__device__ __forceinline__ void rg_coef(float r, float ig, float xc, float cl, float& a, float& bb) {
  const float la = r * cl; a = __builtin_amdgcn_exp2f(la * 1.4426950408889634f); const float x = 2.0f * la;
  float om = -x * (1.0f + x * (0.5f + x * (0.16666667f + x * (0.041666668f + x * (0.0083333338f + x * 0.0013888889f)))));
  om = (x < -0.5f) ? 1.0f - a * a : om;
  bb = __builtin_amdgcn_sqrtf(fmaxf(om, 0.f)) * (ig * xc);
}
__device__ __forceinline__ float scan_cl(const Params& p, int z, int dir, int ch) { const float lam = PIN(I_RLAM)[dir * 512 + ch]; return -8.0f * log1pf(__expf(-lam)); }
constexpr int SC_XROW = 1040;
__device__ __forceinline__ void scan_xc_load(const bf16_t* XC, int job, int tid, u32x4 (&xr)[4]) {
  const int b = job / SC_NC, chunk = job % SC_NC; const int row0 = scan_row0(b, chunk);
#pragma unroll
  for (int it = 0; it < 4; ++it) { const int id = it * 512 + tid; const int r = id >> 6, c8 = (id & 63) * 8; xr[it] = *(const u32x4*)(XC + (size_t)(row0 + r) * 512 + c8); }
}
__device__ __forceinline__ void scan_pass_a(LAS unsigned char* lds, const Params& p, int z, const bf16_t* XC, const bf16_t* WRG, unsigned* COEF, float* AGG, int job, int tid, const u32x4 (&xr)[4]) {
  const int lane = tid & 63, w = tid >> 6; const int b = job / SC_NC, chunk = job % SC_NC; const int row0 = scan_row0(b, chunk);
  LAS unsigned* coef = (LAS unsigned*)lds;
  LAS unsigned char* xcl = lds + 65536;
#pragma unroll
  for (int it = 0; it < 4; ++it) { const int id = it * 512 + tid; const int r = id >> 6, c8 = (id & 63) * 8; *(LAS u32x4*)(xcl + r * SC_XROW + c8 * 2) = xr[it]; }
  const int n = lane & 15, g = lane >> 4;
  __syncthreads();
  bf16x8 af[2][2];
#pragma unroll
  for (int mb = 0; mb < 2; ++mb)
#pragma unroll
    for (int ks = 0; ks < 2; ++ks) af[mb][ks] = *(const LAS bf16x8*)(xcl + (16 * mb + n) * SC_XROW + (64 * w + 32 * ks + 8 * g) * 2);
#pragma unroll 1
  for (int dir = 0; dir < 2; ++dir) {
    bf16x8 wf[4][2][2];
#pragma unroll
    for (int nblk = 0; nblk < 4; ++nblk)
#pragma unroll
      for (int ty = 0; ty < 2; ++ty) { const bf16_t* wp = WRG + (size_t)((dir * 2 + ty) * 512 + 64 * w + 16 * nblk + n) * 512 + 64 * w + 8 * g; wf[nblk][ty][0] = *(const bf16x8*)wp; wf[nblk][ty][1] = *(const bf16x8*)(wp + 32); }
#pragma unroll
    for (int nblk = 0; nblk < 4; ++nblk) {
      const int ch = 64 * w + 16 * nblk + n;
      f32x4 ar[2], ai[2];
#pragma unroll
      for (int mb = 0; mb < 2; ++mb) { ar[mb] = (f32x4){0.f, 0.f, 0.f, 0.f}; ai[mb] = (f32x4){0.f, 0.f, 0.f, 0.f};
        ar[mb] = __builtin_amdgcn_mfma_f32_16x16x32_bf16(af[mb][0], wf[nblk][0][0], ar[mb], 0, 0, 0); ar[mb] = __builtin_amdgcn_mfma_f32_16x16x32_bf16(af[mb][1], wf[nblk][0][1], ar[mb], 0, 0, 0);
        ai[mb] = __builtin_amdgcn_mfma_f32_16x16x32_bf16(af[mb][0], wf[nblk][1][0], ai[mb], 0, 0, 0); ai[mb] = __builtin_amdgcn_mfma_f32_16x16x32_bf16(af[mb][1], wf[nblk][1][1], ai[mb], 0, 0, 0); }
      const float biasr = PIN(I_RAB)[dir * 512 + ch], biasi = PIN(I_RXB)[dir * 512 + ch]; const float cl = scan_cl(p, z, dir, ch);
#pragma unroll
      for (int mb = 0; mb < 2; ++mb)
#pragma unroll
        for (int jj = 0; jj < 4; ++jj) { const int row = 16 * mb + 4 * g + jj;
          const float r = __fdividef(1.0f, 1.0f + __expf(-(ar[mb][jj] + biasr))), ig = __fdividef(1.0f, 1.0f + __expf(-(ai[mb][jj] + biasi))); const float xc = bf2f(*(const LAS unsigned short*)(xcl + row * SC_XROW + ch * 2));
          const float rq = bflo(cvt_pk_bf16(r, 0.f)), iq = bflo(cvt_pk_bf16(ig, 0.f));
          const float la = rq * cl; const float a = __builtin_amdgcn_exp2f(la * 1.4426950408889634f); const float x = 2.0f * la;
          float om = -x * (1.0f + x * (0.5f + x * (0.16666667f + x * (0.041666668f + x * (0.0083333338f + x * 0.0013888889f)))));
          om = (x < -0.5f) ? 1.0f - a * a : om;
          const float bb = __builtin_amdgcn_sqrtf(fmaxf(om, 0.f)) * (iq * xc);
          coef[row * 512 + ch] = cvt_pk_bf16(la, bb); }
    }
    __syncthreads();
    { const int ch = tid; float A = 1.f, B = 0.f; unsigned* cg_ = COEF + (size_t)row0 * 1024 + dir * 512 + ch;
#pragma unroll 8
      for (int tt = 0; tt < SC_CL; ++tt) { const int t = dir ? SC_CL - 1 - tt : tt; const unsigned c = coef[t * 512 + ch]; cg_[(size_t)t * 1024] = c;
        const float a = __builtin_amdgcn_exp2f(bflo(c) * 1.4426950408889634f); A *= a; B = B * a + bfhi(c); }
      float* ag = AGG + ((size_t)((dir * 8 + b) * SC_NC + chunk) * 512 + ch) * 2; ag[0] = A; ag[1] = B; }
    __syncthreads();
  }
}
__device__ __forceinline__ float scan_carry(const float* AGG, int dir, int b, int chunk, int ch) {
  const int pos = dir == 0 ? chunk : (chunk < SC_NCTX ? SC_NCTX - 1 - chunk : (SC_NC + SC_NCTX - 1) - chunk);
  float h = 0.f;
#pragma unroll 1
  for (int ob = 0; ob < pos; ob += 24) { float aa[24], bb[24];
#pragma unroll
    for (int j = 0; j < 24; ++j) { const int o = ob + j; const int oo = o < pos ? o : 0; const int cj = dir == 0 ? oo : (oo < SC_NCTX ? SC_NCTX - 1 - oo : (SC_NC + SC_NCTX - 1) - oo);
      const f32x2 v = *(const f32x2*)(AGG + ((size_t)((dir * 8 + b) * SC_NC + cj) * 512 + ch) * 2); aa[j] = o < pos ? v.x : 1.f; bb[j] = o < pos ? v.y : 0.f; }
#pragma unroll
    for (int j = 0; j < 24; ++j) h = aa[j] * h + bb[j]; }
  return h;
}
__device__ __forceinline__ void scan_pass_b(LAS unsigned char* lds, const unsigned* COEF, const bf16_t* URG, const float* AGG, bf16_t* Y, int job) {
  const int ch = ltid(); const int b = job / SC_NC, chunk = job % SC_NC; const int row0 = scan_row0(b, chunk);
  LAS float* hf = (LAS float*)lds;
  const unsigned* c0 = COEF + (size_t)row0 * 1024 + ch;
  { float h = scan_carry(AGG, 0, b, chunk, ch);
#pragma unroll 1
    for (int tb = 0; tb < SC_CL; tb += 16) { unsigned cc[16];
#pragma unroll
      for (int j = 0; j < 16; ++j) cc[j] = c0[(size_t)(tb + j) * 1024];
#pragma unroll
      for (int j = 0; j < 16; ++j) { const float a = __builtin_amdgcn_exp2f(bflo(cc[j]) * 1.4426950408889634f); h = a * h + bfhi(cc[j]); hf[(tb + j) * 512 + ch] = h; } } }
  { float h = scan_carry(AGG, 1, b, chunk, ch);
#pragma unroll 1
    for (int tb = 0; tb < SC_CL; tb += 16) { unsigned cc[16]; float gg[16];
#pragma unroll
      for (int j = 0; j < 16; ++j) { const int t = SC_CL - 1 - (tb + j); cc[j] = c0[(size_t)t * 1024 + 512]; gg[j] = bf2f(URG[(size_t)(row0 + t) * 1024 + 512 + ch]); }
#pragma unroll
      for (int j = 0; j < 16; ++j) { const int t = SC_CL - 1 - (tb + j); const float a = __builtin_amdgcn_exp2f(bflo(cc[j]) * 1.4426950408889634f); h = a * h + bfhi(cc[j]);
        const float gt = gg[j]; const float zz = 0.7978845608028654f * (gt + 0.044715f * gt * gt * gt);
        const float th = 1.0f - 2.0f * __builtin_amdgcn_rcpf(1.0f + __expf(2.0f * zz)); const float ge = 0.5f * gt * (1.0f + th);
        Y[(size_t)(row0 + t) * 1024 + 512 + ch] = (unsigned short)(cvt_pk_bf16((h + hf[t * 512 + ch]) * ge, 0.f) & 0xffffu); } } }
}

__device__ __forceinline__ void attn_phase(LAS unsigned char* lds, const bf16_t* Q, const bf16_t* Kb, const bf16_t* KR, const bf16_t* VT, bf16_t* O) {
  const int tid = ltid(), wid = tid >> 6, lane = tid & 63, l32 = lane & 31, hf = lane >> 5;
  constexpr int KROW = 208, KBUF = 64 * KROW, VROW = 136, VBUF = 64 * VROW;
  LAS unsigned char* Kl = lds; LAS unsigned char* Vl = lds + 2 * KBUF;
  const int G = gridDim.x; const float cs = 0.10206207261596575f * 1.4426950408889634f;
  const int kkey = tid >> 3, kpart = tid & 7, rkey = (tid >> 2) & 63, rpart = tid & 3, vdv = tid >> 3, vpart = tid & 7;
  for (int u = blockIdx.x; u < 1024; u += G) {
    int bh, qb;
    if (G == 256) { const int xcd = blockIdx.x & 7, within = blockIdx.x >> 3, r = u >> 8; bh = xcd * 16 + r * 4 + (within >> 3); qb = within & 7; } else { bh = u >> 3; qb = u & 7; }
    const int b = bh >> 4, h = bh & 15;
    const int q = qb * 256 + wid * 32 + l32;
    const bf16_t* qp = Q + (size_t)(b * SEQ + q) * 1536 + h * 96 + hf * 8;
    bf16x8 qf[6];
#pragma unroll
    for (int ks = 0; ks < 6; ++ks) qf[ks] = *(const bf16x8*)(qp + ks * 16);
    f32x16 o0, o1;
#pragma unroll
    for (int i = 0; i < 16; ++i) { o0[i] = 0.f; o1[i] = 0.f; }
    float mrun = -1e30f, lsum = 0.f;
    u32x4 kreg, rreg, vreg;
#define ATT_LOAD(j) do { const int tb_ = (j) < 32 ? b * SEQ + (j) * 64 : NLAT + b * CTXL + ((j) - 32) * 64; \
      kreg = *(const u32x4*)(Kb + (size_t)(tb_ + kkey) * 1024 + h * 64 + kpart * 8); \
      if (tid < 256) rreg = *(const u32x4*)(KR + (size_t)(tb_ + rkey) * 32 + rpart * 8); \
      vreg = *(const u32x4*)(VT + (size_t)(h * 64 + vdv) * NROW + tb_ + vpart * 8); } while (0)
#define ATT_STORE(buf) do { *(LAS u32x4*)(Kl + (buf) * KBUF + kkey * KROW + kpart * 16) = kreg; \
      if (tid < 256) *(LAS u32x4*)(Kl + (buf) * KBUF + rkey * KROW + 128 + rpart * 16) = rreg; \
      *(LAS u32x2*)(Vl + (buf) * VBUF + vdv * VROW + vpart * 16) = (u32x2){vreg.x, vreg.y}; *(LAS u32x2*)(Vl + (buf) * VBUF + vdv * VROW + vpart * 16 + 8) = (u32x2){vreg.z, vreg.w}; } while (0)
    ATT_LOAD(0); ATT_STORE(0); __syncthreads();
    for (int j = 0; j < 36; ++j) {
      if (j + 1 < 36) ATT_LOAD(j + 1);
      const int cur = j & 1;
      f32x16 s0, s1;
#pragma unroll
      for (int i = 0; i < 16; ++i) { s0[i] = 0.f; s1[i] = 0.f; }
      const LAS unsigned char* kb0 = Kl + cur * KBUF + l32 * KROW + hf * 16;
#pragma unroll
      for (int ks = 0; ks < 6; ++ks) { const bf16x8 a0 = *(const LAS bf16x8*)(kb0 + ks * 32), a1 = *(const LAS bf16x8*)(kb0 + 32 * KROW + ks * 32);
        s0 = __builtin_amdgcn_mfma_f32_32x32x16_bf16(a0, qf[ks], s0, 0, 0, 0); s1 = __builtin_amdgcn_mfma_f32_32x32x16_bf16(a1, qf[ks], s1, 0, 0, 0); }
      float tmax = s0[0];
#pragma unroll
      for (int i = 1; i < 16; ++i) tmax = fmaxf(tmax, s0[i]);
#pragma unroll
      for (int i = 0; i < 16; ++i) tmax = fmaxf(tmax, s1[i]);
      tmax = fmaxf(tmax, __shfl_xor(tmax, 32));
      const float mnew = fmaxf(mrun, tmax * cs); const float alpha = __builtin_amdgcn_exp2f(mrun - mnew); mrun = mnew;
      float psum = 0.f;
#pragma unroll
      for (int i = 0; i < 16; ++i) { s0[i] = __builtin_amdgcn_exp2f(s0[i] * cs - mnew); s1[i] = __builtin_amdgcn_exp2f(s1[i] * cs - mnew); psum += s0[i] + s1[i]; }
      lsum = lsum * alpha + psum;
#pragma unroll
      for (int i = 0; i < 16; ++i) { o0[i] *= alpha; o1[i] *= alpha; }
      const LAS unsigned char* vb0 = Vl + cur * VBUF + l32 * VROW + hf * 8;
#pragma unroll
      for (int kb = 0; kb < 2; ++kb)
#pragma unroll
        for (int k2 = 0; k2 < 2; ++k2) {
          bf16x8 pf; { unsigned w0, w1, w2, w3;
            if (kb == 0) { w0 = cvt_pk_bf16(s0[8 * k2 + 0], s0[8 * k2 + 1]); w1 = cvt_pk_bf16(s0[8 * k2 + 2], s0[8 * k2 + 3]); w2 = cvt_pk_bf16(s0[8 * k2 + 4], s0[8 * k2 + 5]); w3 = cvt_pk_bf16(s0[8 * k2 + 6], s0[8 * k2 + 7]); }
            else { w0 = cvt_pk_bf16(s1[8 * k2 + 0], s1[8 * k2 + 1]); w1 = cvt_pk_bf16(s1[8 * k2 + 2], s1[8 * k2 + 3]); w2 = cvt_pk_bf16(s1[8 * k2 + 4], s1[8 * k2 + 5]); w3 = cvt_pk_bf16(s1[8 * k2 + 6], s1[8 * k2 + 7]); }
            const u32x4 pw = {w0, w1, w2, w3}; pf = __builtin_bit_cast(bf16x8, pw); }
          const int koff = (32 * kb + 16 * k2) * 2;
          { const u32x2 va = *(const LAS u32x2*)(vb0 + koff), vb = *(const LAS u32x2*)(vb0 + koff + 16); const u32x4 vw = {va.x, va.y, vb.x, vb.y};
            o0 = __builtin_amdgcn_mfma_f32_32x32x16_bf16(__builtin_bit_cast(bf16x8, vw), pf, o0, 0, 0, 0); }
          { const u32x2 va = *(const LAS u32x2*)(vb0 + 32 * VROW + koff), vb = *(const LAS u32x2*)(vb0 + 32 * VROW + koff + 16); const u32x4 vw = {va.x, va.y, vb.x, vb.y};
            o1 = __builtin_amdgcn_mfma_f32_32x32x16_bf16(__builtin_bit_cast(bf16x8, vw), pf, o1, 0, 0, 0); }
        }
      if (j + 1 < 36) ATT_STORE(cur ^ 1);
      __syncthreads();
    }
#undef ATT_LOAD
#undef ATT_STORE
    const float inv = 1.0f / (lsum + __shfl_xor(lsum, 32));
    bf16_t* op = O + (size_t)(b * SEQ + q) * 1024 + h * 64 + 4 * hf;
#pragma unroll
    for (int i = 0; i < 4; ++i) {
      u32x2 w; w.x = cvt_pk_bf16(o0[4 * i] * inv, o0[4 * i + 1] * inv); w.y = cvt_pk_bf16(o0[4 * i + 2] * inv, o0[4 * i + 3] * inv); *(u32x2*)(op + 8 * i) = w;
      w.x = cvt_pk_bf16(o1[4 * i] * inv, o1[4 * i + 1] * inv); w.y = cvt_pk_bf16(o1[4 * i + 2] * inv, o1[4 * i + 3] * inv); *(u32x2*)(op + 32 + 8 * i) = w;
    }
  }
}

__device__ __forceinline__ int wide_count(int sel) { return sel == 0 ? 752 : (sel == 3 ? 64 : 528); }
__device__ __forceinline__ ConvDesc wide_desc(const Params& p, int z, unsigned char* ws, int sel, int it) {
  ConvDesc d; int r = it; d.W2 = nullptr; d.sc = nullptr; d.kind = MAP_ID;
  if (sel == 3) { d.W = PIN(I_MWO); d.K = 1024; d.ld = 1024; d.dst = (bf16_t*)(ws + WS_WMO); }
  else { const int m = sel == 4 ? 3 : sel;
    if (r < 352) { d.kind = MAP_SWIGLU; d.W = PIN(I_FWI) + (size_t)m * 1024 * 5632; d.K = 1024; d.ld = 5632; d.dst = (bf16_t*)(ws + WS_WFI + m * SZ_WFI); }
    else if ((r -= 352) < 176) { d.W = PIN(I_FWO) + (size_t)m * 2816 * 1024; d.K = 2816; d.ld = 1024; d.dst = (bf16_t*)(ws + WS_WFO + m * SZ_WFO); }
    else if ((r -= 176) < 160) { d.W = PIN(I_EWI); d.K = 1024; d.ld = 2560; d.dst = (bf16_t*)(ws + WS_WEI); }
    else { r -= 160; d.W = PIN(I_EWO); d.K = 1024; d.ld = 1024; d.dst = (bf16_t*)(ws + WS_WEO); } }
  d.tile = r; return d;
}
__device__ __forceinline__ void conv_wide_list(LAS float* L, const Params& p, int z, unsigned char* ws, int sel, int t0, int tstride) {
  const int total = wide_count(sel); const int tid = ltid(); f32x4 cur[8], nxt[8];
  if (t0 < total) convw_load(wide_desc(p, z, ws, sel, t0), tid, cur);
#pragma unroll 1
  for (int it = t0; it < total; it += tstride) {
    const bool has = it + tstride < total;
    if (has) convw_load(wide_desc(p, z, ws, sel, it + tstride), tid, nxt);
    convw_store(L, wide_desc(p, z, ws, sel, it), tid, cur);
#pragma unroll
    for (int i = 0; i < 8; ++i) cur[i] = nxt[i];
  }
}
__device__ __forceinline__ int small_count(int sel) { return sel == 0 ? 256 : 736; }
__device__ __forceinline__ ConvDesc small_desc(const Params& p, int z, unsigned char* ws, int sel, int it) {
  ConvDesc d; int r = it; d.W2 = nullptr; d.sc = nullptr;
  if (sel == 0) { d.kind = MAP_RG; d.W = PIN(I_RAW); d.W2 = PIN(I_RXW); d.K = 512; d.ld = 0; d.dst = (bf16_t*)(ws + WS_WRG); }
  else if (r < 320) { d.kind = MAP_MLAIN; d.W = PIN(I_MWI); d.K = 1024; d.ld = 1056; d.dst = (bf16_t*)(ws + WS_WMI); }
  else if ((r -= 320) < 288) { d.kind = MAP_QUP; d.W = PIN(I_MWQ); d.sc = PIN(I_MQN); d.K = 768; d.ld = 1536; d.dst = (bf16_t*)(ws + WS_WQU); }
  else if ((r -= 288) < 64) { d.kind = MAP_KUP; d.W = PIN(I_MWKV); d.sc = PIN(I_MKVN); d.K = 256; d.ld = 2048; d.dst = (bf16_t*)(ws + WS_WKU); }
  else { r -= 64; d.kind = MAP_VUP; d.W = PIN(I_MWKV); d.sc = PIN(I_MKVN); d.K = 256; d.ld = 2048; d.dst = (bf16_t*)(ws + WS_WVU); }
  d.tile = r; return d;
}
__device__ __forceinline__ void conv_small_list(LAS float* L, const Params& p, int z, unsigned char* ws, int sel, int t0, int tstride) {
  const int total = small_count(sel); const int tid = ltid(); float cur[8], nxt[8];
  if (t0 < total) conv_load(small_desc(p, z, ws, sel, t0), tid, cur);
#pragma unroll 1
  for (int it = t0; it < total; it += tstride) {
    const bool has = it + tstride < total;
    if (has) conv_load(small_desc(p, z, ws, sel, it + tstride), tid, nxt);
    conv_store(L, small_desc(p, z, ws, sel, it), tid, cur);
#pragma unroll
    for (int i = 0; i < 8; ++i) cur[i] = nxt[i];
  }
}

#define XB_TMO      128
#define XB_XCNT(j)  (256  + 64 * (j))
#define XB_XSUB(j)  (1280 + 64 * (j))
#define XB_XGEN(j)  (2304 + 64 * (j))
#define XB_TOP      3328
#define XB_TOPGEN   3392
#define XCD_BAR_WORDS 3456
#define XB_SPIN_CAP (1u << 18)

__device__ __forceinline__ unsigned xb_ld(unsigned* p)              { return __hip_atomic_load(p, __ATOMIC_RELAXED, __HIP_MEMORY_SCOPE_AGENT); }
__device__ __forceinline__ unsigned xb_add(unsigned* p, unsigned v) { return __hip_atomic_fetch_add(p, v, __ATOMIC_RELAXED, __HIP_MEMORY_SCOPE_AGENT); }
__device__ __forceinline__ unsigned xb_xcc_id() { return (unsigned)__builtin_amdgcn_s_getreg((3 << 11) | 20) & 0xFu; }
#define XB_SPIN(cond, bar) do { unsigned _sp = 0; while (cond) { __builtin_amdgcn_s_sleep(1); \
    if ((++_sp & 255u) == 0u) { if (xb_ld(&(bar)[XB_TMO])) break; if (_sp > XB_SPIN_CAP) { atomicAdd(&(bar)[XB_TMO], 1u); break; } } } } while (0)

struct XcdBarrier {
    unsigned* bar; unsigned x;
    volatile LAS unsigned* st;
};

__device__ __forceinline__ XcdBarrier xcd_barrier_post(unsigned* bar, volatile LAS unsigned* st) {
    XcdBarrier b; b.bar = bar; b.x = xb_xcc_id(); b.st = st;
    if (threadIdx.x == 0) (void)xb_add(&bar[XB_XCNT(b.x)], 1u);
    return b;
}
__device__ __forceinline__ void xcd_barrier_complete(unsigned* bar, unsigned x, unsigned& nloc, unsigned& nx) {
    const unsigned G = gridDim.x * gridDim.y * gridDim.z;
    unsigned sum, cnt, mine, sp = 0u;
    for (;;) {
        sum = 0u; cnt = 0u; mine = 0u;
#pragma unroll
        for (unsigned j = 0; j < 16; ++j) { const unsigned c = xb_ld(&bar[XB_XCNT(j)]); sum += c; cnt += (c > 0u) ? 1u : 0u; mine = (j == x) ? c : mine; }
        if (sum == G) break;
        __builtin_amdgcn_s_sleep(1);
        if ((++sp & 255u) == 0u) { if (xb_ld(&bar[XB_TMO])) break; if (sp > XB_SPIN_CAP) { atomicAdd(&bar[XB_TMO], 1u); break; } }
    }
    nloc = mine > 0u ? mine : 1u; nx = cnt > 0u ? cnt : 1u;
}

__device__ __forceinline__ void xcd_barrier(const XcdBarrier& b) {
    asm volatile("s_waitcnt vmcnt(0)" ::: "memory");
    __syncthreads();
    if (threadIdx.x == 0) {
        unsigned* bar = b.bar;
        __builtin_amdgcn_s_waitcnt(0);
        unsigned nloc = b.st[0], nx = b.st[1];
        if (nloc == 0u) { xcd_barrier_complete(bar, b.x, nloc, nx); b.st[0] = nloc; b.st[1] = nx; }
        const unsigned old = xb_add(&bar[XB_XSUB(b.x)], 1u);
        const unsigned gen = old / nloc;
        if (old + 1u == (gen + 1u) * nloc) {
            __builtin_amdgcn_fence(__ATOMIC_RELEASE, "agent");
            asm volatile("s_waitcnt vmcnt(0)" ::: "memory");
            const unsigned og = xb_add(&bar[XB_TOP], 1u);
            const unsigned tg = og / nx;
            if (og + 1u == (tg + 1u) * nx) xb_add(&bar[XB_TOPGEN], 1u);
            else XB_SPIN(xb_ld(&bar[XB_TOPGEN]) == tg, bar);
            __builtin_amdgcn_fence(__ATOMIC_ACQUIRE, "agent");
            xb_add(&bar[XB_XGEN(b.x)], 1u);
            asm volatile("s_waitcnt vmcnt(0)" ::: "memory");
        } else {
            XB_SPIN(xb_ld(&bar[XB_XGEN(b.x)]) == gen, bar);
            __builtin_amdgcn_fence(__ATOMIC_ACQUIRE, "agent");
            asm volatile("s_waitcnt vmcnt(0)" ::: "memory");
        }
    }
    __syncthreads();
}


__device__ __forceinline__ unsigned char* launder_ptr(const void* q) { unsigned lo = (unsigned)(size_t)q, hi = (unsigned)((size_t)q >> 32); asm volatile("" : "+v"(lo), "+v"(hi));
  lo = __builtin_amdgcn_readfirstlane(lo); hi = __builtin_amdgcn_readfirstlane(hi); return (unsigned char*)(((size_t)hi << 32) | (size_t)lo); }
#define PHASE_BEGIN const int z = 0; unsigned char* ws = tabptr(35); float* xout = (float*)tabptr(34); (void)ws; (void)xout; (void)z
#define P_MOD ((float*)(ws + WS_MOD))
#define P_KF ((float*)(ws + WS_KF))
#define P_KFC ((float*)(ws + WS_KFC))
#define P_XCTX ((float*)(ws + WS_XCTX))
#define P_AGG ((float*)(ws + WS_AGG))
#define P_H ((bf16_t*)(ws + WS_H))
#define P_ACT ((bf16_t*)(ws + WS_ACT))
#define P_G ((bf16_t*)(ws + WS_G))
#define P_XC ((bf16_t*)(ws + WS_XC))
#define P_YT ((bf16_t*)(ws + WS_YT))
#define P_UT ((bf16_t*)(ws + WS_UT))
#define P_URG ((bf16_t*)(ws + WS_URG))
#define P_P ((bf16_t*)(ws + WS_P))
#define P_Q ((bf16_t*)(ws + WS_Q))
#define P_QN ((bf16_t*)(ws + WS_QN))
#define P_KVN ((bf16_t*)(ws + WS_KVN))
#define P_KR ((bf16_t*)(ws + WS_KR))
#define P_K ((bf16_t*)(ws + WS_K))
#define P_VT ((bf16_t*)(ws + WS_VT))
__global__ void __launch_bounds__(512) mk_fwd(Params p) {
  LAS unsigned char* lds = (LAS unsigned char*)lds_raw;
  const int G = gridDim.x, bid = blockIdx.x;
  if (threadIdx.x == 0) { LAS unsigned long long* tab = (LAS unsigned long long*)(lds + TAB_OFF);
#pragma unroll
    for (int i = 0; i < 34; ++i) tab[i] = (unsigned long long)(size_t)p.in[i];
    tab[34] = (unsigned long long)(size_t)p.out; tab[35] = (unsigned long long)(size_t)p.ws; }
  volatile LAS unsigned* bst = (volatile LAS unsigned*)(lds + LDS_BYTES - 16);
  if (threadIdx.x == 0) { bst[0] = 0u; bst[1] = 0u; }
  __syncthreads();
  if (p.ws == nullptr) cg::this_grid().sync();
  (void)xcd_barrier_post((unsigned*)(tabptr(35) + WS_BAR), bst);
#define GSYNC() do { XcdBarrier b_; b_.bar = (unsigned*)(tabptr(35) + WS_BAR); b_.x = xb_xcc_id(); b_.st = (volatile LAS unsigned*)(lds + LDS_BYTES - 16); xcd_barrier(b_); } while (0)

  PROBE_REP(1) {
    PHASE_BEGIN;
    LAS float* L = (LAS float*)lds;
    { bool first = true; for (int job = bid; job < 576; job += G) { adaln_job(L, p, z, P_MOD, job, first); first = false; } }
    for (int job = bid; job < 144; job += G) { if (job < 128) filter_job(L, p, z, P_KF, SEQ, job); else filter_job(L, p, z, P_KFC, CTXL, job - 128); }
    conv_wide_list(L, p, z, ws, 0, bid, G);
    conv_small_list(L, p, z, ws, 0, bid, G);
  }
  GSYNC();
  PROBE_REP(1) { PHASE_BEGIN; row_pass(PIN(I_X), PIN(I_CTX), const_cast<float*>(PIN(I_X)), const_cast<float*>(PIN(I_CTX)), false, nullptr, nullptr, P_H, P_MOD, 0, NROW, nullptr, nullptr, 0.f, nullptr); }
  GSYNC();

  if (PROBE_MASK & 16) { for (int i = 0; i < 20; ++i) GSYNC(); }
#pragma unroll 1
  for (int st = 0; st < 6; ++st) {
    const int l = st / 3, k = st % 3;
    const int Mrows = (st >= 4) ? NLAT : NROW;
    int rsel;
    if (k != 1) {
      PROBE_REP(64) { PHASE_BEGIN; const int wi = l * 2 + (k == 0 ? 0 : 1);
        Gemm g; g.A = P_H; g.Bt = (const bf16_t*)(ws + WS_WFI + wi * SZ_WFI); g.M = Mrows; g.N = 5632; g.K = 1024; g.kn = 1024;
        StaticOrder S; S.init(g.M, g.N, G, bid); EpiSwiGLU E; E.O = P_ACT; gemm_phase<EpiSwiGLU, StaticOrder, false>(lds, g, S, E, nullptr);
        { PHASE_BEGIN; int wsel = -1, ssel = -1; if (st == 0) wsel = 1; else if (st == 2) wsel = 2; else if (st == 3) { wsel = 3; ssel = 1; }
          const int t0 = G == 256 ? bid - 48 : bid, ts = G == 256 ? 208 : G; LAS float* L = (LAS float*)lds;
          if (rep_ == 0 && t0 >= 0) { if (ssel >= 0) conv_small_list(L, p, z, ws, ssel, t0, ts); if (wsel >= 0) conv_wide_list(L, p, z, ws, wsel, t0, ts); } } }
      GSYNC();
      rsel = 0;
    } else if (l == 0) {
      PROBE_REP(128)
#pragma unroll 1
      for (int gi = 0; gi < 2; ++gi) {
        PHASE_BEGIN; Gemm g; EpiBf16P E; int c;
        if (gi == 0) { g.A = (const bf16_t*)(ws + WS_WEI); g.Bt = P_H; g.M = 1536; g.N = NROW; g.K = 1024; g.kn = 1024; E.O = P_UT; E.ldc = NROW; c = bid; }
        else { g.A = P_H; g.Bt = (const bf16_t*)(ws + WS_WEI) + (size_t)1536 * 1024; g.M = NROW; g.N = 1024; g.K = 1024; g.kn = 1024; E.O = P_URG; E.ldc = 1024; c = (bid + G - (432 % G)) % G; }
        StaticOrder S; S.init(g.M, g.N, G, c); gemm_phase<EpiBf16P, StaticOrder, false>(lds, g, S, E, nullptr);
      }
      GSYNC();
      PROBE_REP(2) { PHASE_BEGIN; xc_build(p, z, P_URG, P_XC);
#pragma unroll 1
        for (int u = bid; u < 1024; u += G) { const bool lat = u < 512; hyena_unit(lds, p, z, P_UT, lat ? P_KF : P_KFC, P_YT, lat ? u : u - 512, lat ? SEQ : CTXL, lat ? 0 : NLAT); } }
      GSYNC();
      PROBE_REP(4) { PHASE_BEGIN;
        for (int job = bid; job < 8 * SC_NC; job += G) { const int tid = ltid(); u32x4 xr[4]; scan_xc_load(P_XC, job, tid, xr); scan_pass_a(lds, p, z, P_XC, (const bf16_t*)(ws + WS_WRG), (unsigned*)P_G, P_AGG, job, tid, xr); }
        for (int job = bid; job < 8 * (NROW / 64); job += G) yt_transpose(lds, P_YT, P_H, job); }
      GSYNC();
      PROBE_REP(4) { PHASE_BEGIN; for (int job = bid; job < 8 * SC_NC; job += G) scan_pass_b(lds, (const unsigned*)P_G, P_URG, P_AGG, P_H, job); }
      GSYNC();
      rsel = 1;
    } else {
      PROBE_REP(256) { PHASE_BEGIN; Gemm g; g.A = P_H; g.Bt = (const bf16_t*)(ws + WS_WMI); g.M = NROW; g.N = 1280; g.K = 1024; g.kn = 1024; EpiBf16P E; E.O = P_P; E.ldc = 1280;
        StaticOrder S; S.init(g.M, g.N, G, bid); gemm_phase<EpiBf16P, StaticOrder, false>(lds, g, S, E, nullptr);
        { PHASE_BEGIN; const int t0 = G == 256 ? bid - 104 : bid, ts = G == 256 ? 152 : G; if (rep_ == 0 && t0 >= 0) conv_wide_list((LAS float*)lds, p, z, ws, 4, t0, ts); } }
      GSYNC();
      { PHASE_BEGIN; mla_rownorm(P_P, P_QN, P_KVN, P_KR); }
      GSYNC();
      PROBE_REP(256) { PHASE_BEGIN; Gemm g; g.A = P_QN; g.Bt = (const bf16_t*)(ws + WS_WQU); g.M = NLAT; g.N = 1536; g.K = 768; g.kn = 768; EpiQ E; E.O = P_Q;
        StaticOrder S; S.init(g.M, g.N, G, bid); gemm_phase<EpiQ, StaticOrder, false>(lds, g, S, E, nullptr); }
      PROBE_REP(256)
#pragma unroll 1
      for (int gi = 0; gi < 2; ++gi) {
        PHASE_BEGIN; Gemm g; EpiBf16P E; int c;
        if (gi == 0) { g.A = P_KVN; g.Bt = (const bf16_t*)(ws + WS_WKU); g.M = NROW; g.N = 1024; g.K = 256; g.kn = 256; E.O = P_K; E.ldc = 1024; c = (bid + G - (384 % G)) % G; }
        else { g.A = (const bf16_t*)(ws + WS_WVU); g.Bt = P_KVN; g.M = 1024; g.N = NROW; g.K = 256; g.kn = 256; E.O = P_VT; E.ldc = NROW; c = (bid + G - ((384 + 288) % G)) % G; }
        StaticOrder S; S.init(g.M, g.N, G, c); gemm_phase<EpiBf16P, StaticOrder, false>(lds, g, S, E, nullptr);
      }
      GSYNC();
      PROBE_REP(8) { PHASE_BEGIN; attn_phase(lds, P_Q, P_K, P_KR, P_VT, P_H); }
      GSYNC();
      rsel = 2;
    }
    PROBE_REP(512) { PHASE_BEGIN; Gemm g; EpiResid E; g.M = NLAT; g.N = 1024; E.Y2 = P_XC; E.mod = P_MOD + (size_t)l * 9 * 9216;
      if (rsel == 0) { g.A = P_ACT; g.Bt = (const bf16_t*)(ws + WS_WFO + (l * 2 + (k == 0 ? 0 : 1)) * SZ_WFO); g.K = 2816; g.kn = 2816; E.gidx = k == 0 ? 2 : 8; E.gs = 0.5f; }
      else if (rsel == 1) { g.A = P_H; g.Bt = (const bf16_t*)(ws + WS_WEO); g.K = 1024; g.kn = 1024; E.gidx = 5; E.gs = 1.0f; }
      else { g.A = P_H; g.Bt = (const bf16_t*)(ws + WS_WMO); g.K = 1024; g.kn = 1024; E.gidx = 5; E.gs = 1.0f; }
      StaticOrder S; S.init(g.M, g.N, G, bid); gemm_phase<EpiResid, StaticOrder, false>(lds, g, S, E, nullptr); }
    if (Mrows == NROW) {
#pragma unroll 1
      for (int s = 0; s < 4; ++s) { PHASE_BEGIN; Gemm g; EpiF32 E; int kt0, ktn; const bf16_t* A; const bf16_t* B;
        if (rsel == 0) { kt0 = s < 2 ? 12 * s : 24 + 10 * (s - 2); ktn = s < 2 ? 12 : 10; A = P_ACT; B = (const bf16_t*)(ws + WS_WFO + (l * 2 + (k == 0 ? 0 : 1)) * SZ_WFO); g.K = 2816; }
        else { kt0 = 4 * s; ktn = 4; A = P_H; B = (const bf16_t*)(ws + WS_WEO); g.K = 1024; }
        g.A = A + (size_t)NLAT * g.K + kt0 * 64; g.Bt = B + kt0 * 64; g.M = NCTX; g.N = 1024; g.kn = ktn * 64;
        E.C = (float*)(ws + WS_G) + (size_t)s * NCTX * D; E.ldc = D; E.bias = nullptr;
        StaticOrder S; S.init(g.M, g.N, G, (bid + G - ((128 + 32 * s) % G)) % G); gemm_phase<EpiF32, StaticOrder, false>(lds, g, S, E, nullptr); }
    }
    GSYNC();
    { PHASE_BEGIN; const float* lg = PIN(I_LNG) + (size_t)(l * 3 + k) * D; const float* lb = PIN(I_LNB) + (size_t)(l * 3 + k) * D;
      const bool hw = st < 5; const float* modn = P_MOD + (size_t)((k < 2) ? l : l + 1) * 9 * 9216; const int sidx = (k < 2) ? 3 * k + 3 : 0;
      const int gidx = k == 0 ? 2 : (k == 1 ? 5 : 8); const float* gate8 = P_MOD + (size_t)l * 9 * 9216 + (size_t)(8 * 9 + gidx) * D;
      row_pass(st == 0 ? PIN(I_X) : xout, st == 0 ? PIN(I_CTX) : P_XCTX, xout, P_XCTX, true, lg, lb, hw ? P_H : nullptr, modn, sidx, Mrows, Mrows == NROW ? (const float*)(ws + WS_G) : nullptr, gate8, k == 1 ? 1.0f : 0.5f, P_XC); }
    if (st < 5) GSYNC();
  }
}

extern "C" void kernel_launch(void* const* d_in, const int* in_sizes, int n_in, void* d_out, int out_size, void* d_ws, size_t ws_size, hipStream_t stream) {
  static int grid_blocks = 0;
  if (!grid_blocks) {
    int dev = 0, cus = 0, per_cu = 0;
    if (n_in != 34 || out_size != NLAT * D || ws_size < WS_END) { fprintf(stderr, "kernel_launch: unexpected problem (n_in %d out %d ws %zu need %zu)\n", n_in, out_size, ws_size, (size_t)WS_END); grid_blocks = -1; return; }
    (void)hipGetDevice(&dev);
    (void)hipDeviceGetAttribute(&cus, hipDeviceAttributeMultiprocessorCount, dev);
    (void)hipFuncSetAttribute((const void*)mk_fwd, hipFuncAttributeMaxDynamicSharedMemorySize, LDS_BYTES);
    (void)hipOccupancyMaxActiveBlocksPerMultiprocessor(&per_cu, (const void*)mk_fwd, 512, LDS_BYTES);
    if (per_cu < 1 || cus < 1) { fprintf(stderr, "kernel_launch: occupancy %d cus %d\n", per_cu, cus); grid_blocks = -1; return; }
    grid_blocks = cus;
  }
  if (grid_blocks < 0) return;
  Params p{};
  for (int i = 0; i < 34; ++i) p.in[i] = (const float*)d_in[i];
  p.out = (float*)d_out; p.ws = (unsigned char*)d_ws;
  if (hipMemsetAsync((unsigned char*)d_ws + WS_BAR, 0, 16384, stream) != hipSuccess) { fprintf(stderr, "kernel_launch: memset of the barrier words failed\n"); return; }
  void* args[] = {&p};
  hipError_t e = hipLaunchCooperativeKernel((const void*)mk_fwd, dim3(grid_blocks), dim3(512), args, LDS_BYTES, stream);
  if (e != hipSuccess) fprintf(stderr, "cooperative launch failed: %s (grid %d)\n", hipGetErrorString(e), grid_blocks);
}
```

```cpp
#include <hip/hip_runtime.h>
namespace pg8 {
#define PG8_LAS __attribute__((address_space(3)))
typedef unsigned short bf16_t;
typedef short bf16x8 __attribute__((ext_vector_type(8)));
typedef float f32x4 __attribute__((ext_vector_type(4)));
typedef unsigned u32x4 __attribute__((ext_vector_type(4)));
constexpr int BM = 256, BK = 64, HALF = 128, HTB = HALF * BK * 2  , STAGE_BYTES = 8 * HTB, NXCD = 8, WGM = 8;

__host__ __device__ __forceinline__ int lds_byte(int r, int c) { const int st = (r >> 4) * 2 + (c >> 5), rr = r & 15, cc = c & 31, ob = rr * 64 + cc * 2; return st * 1024 + (ob ^ (((ob >> 9) & 1) << 5)); }
__host__ __device__ __forceinline__ void stage_rc(int b, int& R, int& C) { const int st = b / 1024, sb = b % 1024, swz = sb ^ (((sb >> 9) & 1) << 5); R = (st >> 1) * 16 + swz / 64; C = (st & 1) * 32 + (swz % 64) / 2; }
__host__ __device__ __forceinline__ int perm32(int rho) { const int n = rho >> 4, i = rho & 15; return 8 * (i >> 2) + 4 * n + (i & 3); }

struct Unit { int pm, pn; };
struct Gemm { const bf16_t* A; const bf16_t* Bt; int M, N, K, kn; };

struct StaticOrder {
    int nM, nN, nwg, G, c;
    __host__ __device__ void init(int M, int N, int G_, int c_) { nM = M / BM; nN = N / BM; nwg = nM * nN; G = G_; c = c_; }
    __host__ __device__ bool next(int i, Unit& u) const {
        const long L = (long)i * G + c; if (L >= nwg) return false;
        int wgid = (int)L; { const int q = nwg / NXCD, r = nwg % NXCD, xcd = wgid % NXCD, off = wgid / NXCD; wgid = (xcd < r ? xcd * (q + 1) : r * (q + 1) + (xcd - r) * q) + off; }
        const int nig = WGM * nN, gid = wgid / nig, fm = gid * WGM, gsz = (nM - fm) < WGM ? (nM - fm) : WGM;
        u.pm = fm + ((wgid % nig) % gsz); u.pn = (wgid % nig) / gsz; return true;
    }
    __device__ __forceinline__ void a_ready(const Unit&) const {}
    __device__ __forceinline__ void done(const Unit&) const {}
};
struct CountedOrder : StaticOrder {
    const unsigned* ready; unsigned need; unsigned* tmo;
    __device__ __forceinline__ void a_ready(const Unit& u) const {
        if (threadIdx.x < 64) {
            const unsigned long long t0 = __builtin_amdgcn_s_memrealtime(); unsigned polls = 0;
            while ((unsigned)__builtin_amdgcn_readfirstlane(__hip_atomic_load(ready + 64 * u.pm, __ATOMIC_RELAXED, __HIP_MEMORY_SCOPE_AGENT)) < need) {
                if ((++polls & 255u) == 0u && __builtin_amdgcn_readfirstlane(__hip_atomic_load(tmo, __ATOMIC_RELAXED, __HIP_MEMORY_SCOPE_AGENT)) != 0u) break;
                if (__builtin_amdgcn_s_memrealtime() - t0 > 2000000ull) {
                    if (threadIdx.x == 0) { unsigned expect = 0u; __hip_atomic_compare_exchange_strong(tmo + 1, &expect, 0x600u | (unsigned)(u.pm & 0xff), __ATOMIC_RELAXED, __ATOMIC_RELAXED, __HIP_MEMORY_SCOPE_AGENT); __hip_atomic_store(tmo, 1u, __ATOMIC_RELAXED, __HIP_MEMORY_SCOPE_AGENT); }
                    break; }
                __builtin_amdgcn_s_sleep(2); }
            __builtin_amdgcn_fence(__ATOMIC_ACQUIRE, "agent");
            asm volatile("s_waitcnt vmcnt(0)" ::: "memory");
        }
#if !defined(BROKEN_HOOK_NO_BARRIER)
        asm volatile("" ::: "memory"); __builtin_amdgcn_s_barrier(); asm volatile("" ::: "memory");
#endif
    }
};

__device__ __forceinline__ unsigned cvt_pk_bf16(float lo, float hi) { unsigned r; asm volatile("v_cvt_pk_bf16_f32 %0, %1, %2" : "=v"(r) : "v"(lo), "v"(hi)); return r; }
typedef float f32x2 __attribute__((ext_vector_type(2)));
__device__ __forceinline__ f32x2 gelu_pk(f32x2 v) {
    const f32x2 av = __builtin_elementwise_abs(v), d = av * 0.2316418882f + 1.0f;
    f32x2 t; t.x = __builtin_amdgcn_rcpf(d.x); t.y = __builtin_amdgcn_rcpf(d.y);
    f32x2 q = t * 0.5307027145f + (-0.7265760135f); q = q * t + 0.7107068705f; q = q * t + (-0.142248368f); q = q * t + 0.127414796f; q = q * t;
    const f32x2 s = (v * v) * (-0.72134752044f);
    f32x2 e; e.x = __builtin_amdgcn_exp2f(s.x); e.y = __builtin_amdgcn_exp2f(s.y);
    const f32x2 m = v * (q * e), r = v - m;
    f32x2 o; o.x = v.x < 0.f ? m.x : r.x; o.y = v.y < 0.f ? m.y : r.y; return o;
}

struct EpiF32 {
    static constexpr bool PERM = false, AFTER_DRAIN = false;
    float* C; int ldc; const float* bias;
    __device__ __forceinline__ void operator()(const f32x4 (&acc)[2][2][4][2], const Unit& u, int wr, int wc, int fr, int fq) const {
        const int row0 = u.pm * BM + wr * 64 + fr, col0 = u.pn * BM + wc * 32 + 4 * fq;
        f32x4 bv[2][2];
#pragma unroll
        for (int bj = 0; bj < 2; ++bj)
#pragma unroll
            for (int n = 0; n < 2; ++n) bv[bj][n] = bias ? *(const f32x4*)(bias + col0 + bj * HALF + n * 16) : (f32x4){0.f, 0.f, 0.f, 0.f};
#pragma unroll
        for (int ai = 0; ai < 2; ++ai)
#pragma unroll
            for (int m = 0; m < 4; ++m) { float* rowp = C + (size_t)(row0 + ai * HALF + m * 16) * ldc + col0;
#pragma unroll
                for (int bj = 0; bj < 2; ++bj)
#pragma unroll
                    for (int n = 0; n < 2; ++n) *(f32x4*)(rowp + bj * HALF + n * 16) = acc[ai][bj][m][n] + bv[bj][n]; }
    }
};
template <int ACT  > struct EpiBf16 {
    static constexpr bool PERM = true, AFTER_DRAIN = false;
    bf16_t* O; int ldc; const float* bias; int split_cols; size_t split_stride;
    __device__ __forceinline__ void operator()(const f32x4 (&acc)[2][2][4][2], const Unit& u, int wr, int wc, int fr, int fq) const {
        const int row0 = u.pm * BM + wr * 64 + fr; int colt = u.pn * BM; bf16_t* base = O;
        if (split_cols) { const int t = colt / split_cols; base += (size_t)t * split_stride; colt -= t * split_cols; }
        const int col0 = colt + wc * 32 + 8 * fq, bcol0 = u.pn * BM + wc * 32 + 8 * fq;
        f32x4 bv[2][2];
#pragma unroll
        for (int bj = 0; bj < 2; ++bj)
#pragma unroll
            for (int n = 0; n < 2; ++n) bv[bj][n] = bias ? *(const f32x4*)(bias + bcol0 + bj * HALF + 4 * n) : (f32x4){0.f, 0.f, 0.f, 0.f};
#pragma unroll
        for (int ai = 0; ai < 2; ++ai)
#pragma unroll
            for (int m = 0; m < 4; ++m) { bf16_t* rowp = base + (size_t)(row0 + ai * HALF + m * 16) * ldc + col0;
#pragma unroll
                for (int bj = 0; bj < 2; ++bj) { f32x4 v0 = acc[ai][bj][m][0] + bv[bj][0], v1 = acc[ai][bj][m][1] + bv[bj][1];
                    if (ACT == 1) { f32x2 a = gelu_pk((f32x2){v0[0], v0[1]}), b = gelu_pk((f32x2){v0[2], v0[3]}), c = gelu_pk((f32x2){v1[0], v1[1]}), d = gelu_pk((f32x2){v1[2], v1[3]});
                        v0 = (f32x4){a.x, a.y, b.x, b.y}; v1 = (f32x4){c.x, c.y, d.x, d.y}; }
                    if (ACT == 2) {
#pragma unroll
                        for (int j = 0; j < 4; ++j) { v0[j] = 0.5f * v0[j] * (1.0f + erff(v0[j] * 0.70710678f)); v1[j] = 0.5f * v1[j] * (1.0f + erff(v1[j] * 0.70710678f)); } }
                    u32x4 w; w.x = cvt_pk_bf16(v0[0], v0[1]); w.y = cvt_pk_bf16(v0[2], v0[3]); w.z = cvt_pk_bf16(v1[0], v1[1]); w.w = cvt_pk_bf16(v1[2], v1[3]);
                    *(u32x4*)(rowp + bj * HALF) = w; } }
    }
};

struct PanelStats {
    unsigned* xbuf;
    unsigned* cnt;
    unsigned* tmo;
    int ntn; float eps;
    unsigned code;
    __device__ __forceinline__ bool run(const f32x4 (&v)[2][2][4][2], const Unit& u, int wr, int wc, int fr, int fq, PG8_LAS unsigned char* lds, int wid, int lane) const {
        typedef float f32x2v __attribute__((ext_vector_type(2)));
        PG8_LAS f32x2v* P = (PG8_LAS f32x2v*)lds;
        PG8_LAS f32x2v* S = (PG8_LAS f32x2v*)(lds + 8192);
        PG8_LAS unsigned* flag = (PG8_LAS unsigned*)(lds + 8192 + 2048);
#pragma unroll
        for (int ai = 0; ai < 2; ++ai)
#pragma unroll
            for (int m = 0; m < 4; ++m) {
                float s = 0.f;
#pragma unroll
                for (int bj = 0; bj < 2; ++bj)
#pragma unroll
                    for (int n = 0; n < 2; ++n) { const f32x4 x = v[ai][bj][m][n]; s += (x[0] + x[1]) + (x[2] + x[3]); }
                s += __shfl_xor(s, 16); s += __shfl_xor(s, 32);
                const float mw = s * (1.0f / 64.0f); float q = 0.f;
#pragma unroll
                for (int bj = 0; bj < 2; ++bj)
#pragma unroll
                    for (int n = 0; n < 2; ++n) { const f32x4 d = v[ai][bj][m][n] - mw; q += (d[0] * d[0] + d[1] * d[1]) + (d[2] * d[2] + d[3] * d[3]); }
                q += __shfl_xor(q, 16); q += __shfl_xor(q, 32);
                if (fq == 0) P[(ai * HALF + wr * 64 + m * 16 + fr) * 4 + wc] = (f32x2v){mw, q};
            }
        asm volatile("s_waitcnt lgkmcnt(0)" ::: "memory"); __builtin_amdgcn_s_barrier(); asm volatile("" ::: "memory");
#if defined(BROKEN_NO_WAIT)
        if (blockIdx.x >= 64) { const long long t0 = clock64(); while (clock64() - t0 < 60000) __builtin_amdgcn_s_sleep(8); }
#endif
        const int row = wid * 32 + (lane & 31);
        if (lane < 32) {
            const f32x2v a = P[row * 4 + 0], b = P[row * 4 + 1], c = P[row * 4 + 2], d = P[row * 4 + 3];
            const float mt = (a.x + b.x + c.x + d.x) * 0.25f;
            const float da = a.x - mt, db = b.x - mt, dc = c.x - mt, dd = d.x - mt;
            const float m2 = (a.y + b.y) + (c.y + d.y) + 64.0f * ((da * da + db * db) + (dc * dc + dd * dd));
            unsigned long long* slot = (unsigned long long*)xbuf + ((size_t)(u.pm * BM + row) * 4 + u.pn);
            __hip_atomic_store(slot, ((unsigned long long)__float_as_uint(m2) << 32) | __float_as_uint(mt), __ATOMIC_RELAXED, __HIP_MEMORY_SCOPE_AGENT);
        }
        asm volatile("s_waitcnt vmcnt(0)" ::: "memory");
        if (lane == 0) __hip_atomic_fetch_add(cnt + 64 * u.pm, 1u, __ATOMIC_RELAXED, __HIP_MEMORY_SCOPE_AGENT);
        if (wid == 0) {
            bool dead = false; const unsigned long long t0 = __builtin_amdgcn_s_memrealtime(); const unsigned want = 8u * (unsigned)ntn;
            for (;;) {
#if defined(BROKEN_NO_WAIT)
                break;
#endif
                if ((unsigned)__builtin_amdgcn_readfirstlane(__hip_atomic_load(cnt + 64 * u.pm, __ATOMIC_RELAXED, __HIP_MEMORY_SCOPE_AGENT)) >= want) break;
                if (__builtin_amdgcn_s_memrealtime() - t0 > 2000000ull) {
                    if (lane == 0) { unsigned expect = 0u; __hip_atomic_compare_exchange_strong(tmo + 1, &expect, code | (unsigned)(u.pm & 0xff), __ATOMIC_RELAXED, __ATOMIC_RELAXED, __HIP_MEMORY_SCOPE_AGENT);
                                     __hip_atomic_store(tmo, 1u, __ATOMIC_RELAXED, __HIP_MEMORY_SCOPE_AGENT); }
                    dead = true; break; }
                __builtin_amdgcn_s_sleep(2);
            }
            __builtin_amdgcn_fence(__ATOMIC_ACQUIRE, "agent");
            if (lane == 0) flag[0] = dead ? 1u : 0u;
        }
        asm volatile("s_waitcnt vmcnt(0) lgkmcnt(0)" ::: "memory"); __builtin_amdgcn_s_barrier(); asm volatile("" ::: "memory");
        const bool bad = flag[0] != 0u;
        if (lane < 32) {
            const unsigned long long* slot = (const unsigned long long*)xbuf + (size_t)(u.pm * BM + row) * 4; float mt[4], m2[4]; float ms = 0.f;
#pragma unroll
            for (int t = 0; t < 4; ++t) { if (t < ntn) { const unsigned long long w = __hip_atomic_load(slot + t, __ATOMIC_RELAXED, __HIP_MEMORY_SCOPE_AGENT); mt[t] = __uint_as_float((unsigned)w); m2[t] = __uint_as_float((unsigned)(w >> 32)); } else { mt[t] = 0.f; m2[t] = 0.f; } ms += mt[t]; }
            const float mean = ms / (float)ntn; float q = 0.f;
#pragma unroll
            for (int t = 0; t < 4; ++t) if (t < ntn) { const float dm = mt[t] - mean; q += m2[t] + 256.0f * dm * dm; }
            S[row] = (f32x2v){mean, 1.0f / sqrtf(q / (256.0f * (float)ntn) + eps)};
        }
        asm volatile("s_waitcnt lgkmcnt(0)" ::: "memory"); __builtin_amdgcn_s_barrier(); asm volatile("" ::: "memory");
        return bad;
    }
};
struct EpiLnRes {
    static constexpr bool PERM = false, AFTER_DRAIN = true;
    const float* base; float* out; int ldc; const float* bias; PanelStats st; unsigned poison;
    __device__ __forceinline__ void refuse(size_t i0, size_t stride, int M, int N) const { const float q = __builtin_nanf(""); for (size_t i = i0; i < (size_t)M * N; i += stride) out[(i / N) * ldc + i % N] = q;
        if (i0 == 0) { unsigned expect = 0u; __hip_atomic_compare_exchange_strong(st.tmo + 1, &expect, 0x7f0u, __ATOMIC_RELAXED, __ATOMIC_RELAXED, __HIP_MEMORY_SCOPE_AGENT); __hip_atomic_store(st.tmo, 1u, __ATOMIC_RELAXED, __HIP_MEMORY_SCOPE_AGENT); } }
    __device__ __forceinline__ void fused(f32x4 (&acc)[2][2][4][2], const Unit& u, int wr, int wc, int fr, int fq, PG8_LAS unsigned char* lds, int wid, int lane) const {
        typedef float f32x2v __attribute__((ext_vector_type(2)));
        const PG8_LAS f32x2v* S = (const PG8_LAS f32x2v*)(lds + 8192);
        const int col0 = u.pn * BM + wc * 32 + 4 * fq;
#pragma unroll
        for (int bj = 0; bj < 2; ++bj)
#pragma unroll
            for (int n = 0; n < 2; ++n) { const f32x4 bv = bias ? *(const f32x4*)(bias + col0 + bj * HALF + n * 16) : (f32x4){0.f, 0.f, 0.f, 0.f};
#pragma unroll
                for (int ai = 0; ai < 2; ++ai)
#pragma unroll
                    for (int m = 0; m < 4; ++m) acc[ai][bj][m][n] += bv; }
        const bool bad = st.run(acc, u, wr, wc, fr, fq, lds, wid, lane) || poison != 0u;
        const float qnan = __builtin_nanf("");
#pragma unroll
        for (int ai = 0; ai < 2; ++ai)
#pragma unroll
            for (int m = 0; m < 4; ++m) { const int r = ai * HALF + wr * 64 + m * 16 + fr; const f32x2v sr = S[r]; const size_t off = (size_t)(u.pm * BM + r) * ldc + col0;
#pragma unroll
                for (int bj = 0; bj < 2; ++bj)
#pragma unroll
                    for (int n = 0; n < 2; ++n) { const f32x4 bs = *(const f32x4*)(base + off + bj * HALF + n * 16); f32x4 o = bs + (acc[ai][bj][m][n] - sr.x) * sr.y;
                        if (bad) o = (f32x4){qnan, qnan, qnan, qnan}; *(f32x4*)(out + off + bj * HALF + n * 16) = o; }
                asm volatile("" ::: "memory"); }
    }
};
struct EpiLnResLn {
    static constexpr bool PERM = false, AFTER_DRAIN = true;
    const float* base; float* out; bf16_t* xn; int ldc; const float* bias; PanelStats st1, st2; unsigned poison;
    __device__ __forceinline__ void refuse(size_t i0, size_t stride, int M, int N) const { const float q = __builtin_nanf(""); for (size_t i = i0; i < (size_t)M * N; i += stride) { const size_t o = (i / N) * ldc + i % N; out[o] = q; xn[o] = (bf16_t)0x7fc0u; }
        if (i0 == 0) { unsigned expect = 0u; __hip_atomic_compare_exchange_strong(st1.tmo + 1, &expect, 0x7f0u, __ATOMIC_RELAXED, __ATOMIC_RELAXED, __HIP_MEMORY_SCOPE_AGENT); __hip_atomic_store(st1.tmo, 1u, __ATOMIC_RELAXED, __HIP_MEMORY_SCOPE_AGENT); } }
    __device__ __forceinline__ void fused(f32x4 (&acc)[2][2][4][2], const Unit& u, int wr, int wc, int fr, int fq, PG8_LAS unsigned char* lds, int wid, int lane) const {
        typedef float f32x2v __attribute__((ext_vector_type(2))); typedef unsigned u32x2v __attribute__((ext_vector_type(2)));
        const PG8_LAS f32x2v* S = (const PG8_LAS f32x2v*)(lds + 8192);
        const int col0 = u.pn * BM + wc * 32 + 4 * fq;
#pragma unroll
        for (int bj = 0; bj < 2; ++bj)
#pragma unroll
            for (int n = 0; n < 2; ++n) { const f32x4 bv = bias ? *(const f32x4*)(bias + col0 + bj * HALF + n * 16) : (f32x4){0.f, 0.f, 0.f, 0.f};
#pragma unroll
                for (int ai = 0; ai < 2; ++ai)
#pragma unroll
                    for (int m = 0; m < 4; ++m) acc[ai][bj][m][n] += bv; }
        bool bad = st1.run(acc, u, wr, wc, fr, fq, lds, wid, lane) || poison != 0u;
        const float qnan = __builtin_nanf("");
#pragma unroll
        for (int ai = 0; ai < 2; ++ai)
#pragma unroll
            for (int m = 0; m < 4; ++m) { const int r = ai * HALF + wr * 64 + m * 16 + fr; const f32x2v sr = S[r]; const size_t off = (size_t)(u.pm * BM + r) * ldc + col0;
#pragma unroll
                for (int bj = 0; bj < 2; ++bj)
#pragma unroll
                    for (int n = 0; n < 2; ++n) { const f32x4 bs = *(const f32x4*)(base + off + bj * HALF + n * 16); acc[ai][bj][m][n] = bs + (acc[ai][bj][m][n] - sr.x) * sr.y; }
                asm volatile("" : "+v"(acc[ai][0][m][0]), "+v"(acc[ai][0][m][1]), "+v"(acc[ai][1][m][0]), "+v"(acc[ai][1][m][1]));
                if (m & 1) asm volatile("" ::: "memory"); }
        const bool bad1 = bad;
        bad = st2.run(acc, u, wr, wc, fr, fq, lds, wid, lane) || bad;
#pragma unroll
        for (int ai = 0; ai < 2; ++ai)
#pragma unroll
            for (int m = 0; m < 4; ++m) { const int r = ai * HALF + wr * 64 + m * 16 + fr; const f32x2v sr = S[r]; const size_t off = (size_t)(u.pm * BM + r) * ldc + col0;
#pragma unroll
                for (int bj = 0; bj < 2; ++bj)
#pragma unroll
                    for (int n = 0; n < 2; ++n) { const f32x4 x1 = acc[ai][bj][m][n]; *(f32x4*)(out + off + bj * HALF + n * 16) = bad1 ? (f32x4){qnan, qnan, qnan, qnan} : x1;
                        const f32x4 o = (x1 - sr.x) * sr.y; u32x2v w; w.x = cvt_pk_bf16(o[0], o[1]); w.y = cvt_pk_bf16(o[2], o[3]);
                        if (bad) { w.x = 0x7fc07fc0u; w.y = 0x7fc07fc0u; } *(u32x2v*)(xn + off + bj * HALF + n * 16) = w; }
                asm volatile("" ::: "memory"); }
    }
};

template <class Epi, class Sched, bool STAMP = false>
__device__ __forceinline__ void gemm_phase(PG8_LAS unsigned char* lds, const Gemm g, const Sched& S, const Epi& E, unsigned long long* stamps) {
    int tid_l = threadIdx.x; asm volatile("" : "+v"(tid_l));
    const int tid = tid_l, wid = __builtin_amdgcn_readfirstlane(tid >> 6), lane = tid & 63, wr = wid >> 2, wc = wid & 3, fr = lane & 15, fq = lane >> 4;
    const int K = g.K, nt = g.kn / BK;
    int ts_lo = 0, ts_hi = 0, nts = 0; const unsigned long long rt_entry = STAMP ? (unsigned long long)wall_clock64() : 0ull;
#define PG8_STAMP() do { if (STAMP && wid == 0 && nts < 64) { const unsigned long long _c = (unsigned long long)clock64(); \
        ts_lo = (lane == nts) ? (int)(unsigned)_c : ts_lo; ts_hi = (lane == nts) ? (int)(unsigned)(_c >> 32) : ts_hi; ++nts; } } while (0)
    PG8_STAMP();
    unsigned voffA[2], voffB[2];
#pragma unroll
    for (int i = 0; i < 2; ++i) { int R, C; stage_rc(tid * 16 + i * 8192, R, C); const int Rb = Epi::PERM ? ((R & ~31) + perm32(R & 31)) : R;
        voffA[i] = (unsigned)(R * K + C) * 2u; voffB[i] = (unsigned)(Rb * K + C) * 2u; }
    const size_t kstep = (size_t)(BK * 2);
    const size_t hstep = (size_t)HALF * K * 2;
    const size_t tstep = 2 * hstep;
    const unsigned ldsw = (unsigned)wid * 1024u;
    const int aoff = lds_byte(wr * 64 + fr, fq * 8), boff = lds_byte(wc * 32 + fr, fq * 8);
#define PG8_SA(b, h) (((b) * 2 + (h)) * HTB)
#define PG8_SB(b, h) ((4 + (b) * 2 + (h)) * HTB)
#define PG8_STAGE(bufoff, gbase, voff) do { _Pragma("unroll") for (int _i = 0; _i < 2; ++_i) \
        __builtin_amdgcn_global_load_lds((const unsigned*)((const char*)(gbase) + (voff)[_i]), (PG8_LAS unsigned*)(lds + (bufoff) + ldsw + _i * 8192), 16, 0, 0); } while (0)
#define PG8_LDA(dst, b, h) do { _Pragma("unroll") for (int m = 0; m < 4; ++m) _Pragma("unroll") for (int k = 0; k < 2; ++k) dst[m][k] = *(const PG8_LAS bf16x8*)(lds + PG8_SA(b, h) + aoff + m * 2048 + k * 1024); } while (0)
#define PG8_LDB(dst, b, h) do { _Pragma("unroll") for (int n = 0; n < 2; ++n) _Pragma("unroll") for (int k = 0; k < 2; ++k) dst[n][k] = *(const PG8_LAS bf16x8*)(lds + PG8_SB(b, h) + boff + n * 2048 + k * 1024); } while (0)
#define PG8_MMA(ai, bj, At, Bt) do { __builtin_amdgcn_s_setprio(1); _Pragma("unroll") for (int m = 0; m < 4; ++m) _Pragma("unroll") for (int n = 0; n < 2; ++n) _Pragma("unroll") for (int k = 0; k < 2; ++k) \
        acc[ai][bj][m][n] = __builtin_amdgcn_mfma_f32_16x16x32_bf16(Bt[n][k], At[m][k], acc[ai][bj][m][n], 0, 0, 0); __builtin_amdgcn_s_setprio(0); } while (0)
#define PG8_WAIT_V(n) asm volatile("s_waitcnt vmcnt(" #n ")" ::: "memory")
#define PG8_WAIT_L(n) asm volatile("s_waitcnt lgkmcnt(" #n ")" ::: "memory")
#define PG8_BAR __builtin_amdgcn_s_barrier()
#define PG8_SCHED __builtin_amdgcn_sched_barrier(0)
    Unit cur, nxt; int ui = 0;
    if (!S.next(0, cur)) return;
    f32x4 acc[2][2][4][2];
#pragma unroll
    for (int a = 0; a < 2; ++a)
#pragma unroll
        for (int b = 0; b < 2; ++b)
#pragma unroll
            for (int m = 0; m < 4; ++m)
#pragma unroll
                for (int n = 0; n < 2; ++n) acc[a][b][m][n] = (f32x4){0.f, 0.f, 0.f, 0.f};
    bf16x8 At[4][2], B0[2][2], B1[2][2];
    const char* cA = (const char*)g.A + (size_t)cur.pm * tstep; const char* cB = (const char*)g.Bt + (size_t)cur.pn * tstep;
    S.a_ready(cur);
    PG8_STAGE(PG8_SB(0, 0), cB, voffB); PG8_STAGE(PG8_SA(0, 0), cA, voffA); PG8_STAGE(PG8_SB(0, 1), cB + hstep, voffB); PG8_STAGE(PG8_SA(0, 1), cA + hstep, voffA);
    if (wr == 1) PG8_BAR;
    PG8_WAIT_V(4); PG8_BAR;
    PG8_STAGE(PG8_SB(1, 0), cB + kstep, voffB); PG8_STAGE(PG8_SA(1, 0), cA + kstep, voffA); PG8_STAGE(PG8_SB(1, 1), cB + hstep + kstep, voffB);
    PG8_WAIT_V(6); PG8_BAR;
    PG8_STAMP();
    for (;;) {
        const bool has_next = S.next(ui + 1, nxt);
        const char* nA = has_next ? (const char*)g.A + (size_t)nxt.pm * tstep : cA; const char* nB = has_next ? (const char*)g.Bt + (size_t)nxt.pn * tstep : cB;
        for (int t = 0; t < nt; t += 2) {
            const bool last = (t == nt - 2);
            const char* a1 = cA + (size_t)(t + 1) * kstep;
            const char* a2 = last ? nA : cA + (size_t)(t + 2) * kstep; const char* b2 = last ? nB : cB + (size_t)(t + 2) * kstep;
            const char* a3 = a2 + kstep; const char* b3 = b2 + kstep;
            if (last && has_next) S.a_ready(nxt);
            PG8_LDB(B0, 0, 0); PG8_SCHED; PG8_LDA(At, 0, 0); PG8_STAGE(PG8_SA(1, 1), a1 + hstep, voffA);
            PG8_WAIT_L(8); PG8_BAR; PG8_WAIT_L(0); PG8_MMA(0, 0, At, B0); PG8_BAR; PG8_SCHED;
            PG8_LDB(B1, 0, 1); PG8_STAGE(PG8_SB(0, 0), b2, voffB);
            PG8_BAR; PG8_WAIT_L(0); PG8_MMA(0, 1, At, B1); PG8_BAR;
            PG8_LDA(At, 0, 1); PG8_STAGE(PG8_SA(0, 0), a2, voffA);
            PG8_BAR; PG8_WAIT_L(0); PG8_MMA(1, 0, At, B0); PG8_BAR; PG8_SCHED;
            PG8_STAGE(PG8_SB(0, 1), b2 + hstep, voffB);
            PG8_WAIT_V(6); PG8_BAR; PG8_MMA(1, 1, At, B1); PG8_BAR;
            PG8_LDB(B0, 1, 0); PG8_SCHED; PG8_LDA(At, 1, 0); PG8_STAGE(PG8_SA(0, 1), a2 + hstep, voffA);
            PG8_WAIT_L(8); PG8_BAR; PG8_WAIT_L(0); PG8_MMA(0, 0, At, B0); PG8_BAR; PG8_SCHED;
            PG8_LDB(B1, 1, 1); PG8_STAGE(PG8_SB(1, 0), b3, voffB);
            PG8_BAR; PG8_WAIT_L(0); PG8_MMA(0, 1, At, B1); PG8_BAR;
            PG8_LDA(At, 1, 1); PG8_STAGE(PG8_SA(1, 0), a3, voffA);
            PG8_BAR; PG8_WAIT_L(0); PG8_MMA(1, 0, At, B0); PG8_BAR; PG8_SCHED;
            PG8_STAGE(PG8_SB(1, 1), b3 + hstep, voffB);
            PG8_WAIT_V(6); PG8_BAR; PG8_MMA(1, 1, At, B1); PG8_BAR;
        }
        PG8_STAMP();
        if constexpr (!Epi::AFTER_DRAIN) { E(acc, cur, wr, wc, fr, fq); S.done(cur); }
        PG8_STAMP();
        if (!has_next) break;
#pragma unroll
        for (int a = 0; a < 2; ++a)
#pragma unroll
            for (int b = 0; b < 2; ++b)
#pragma unroll
                for (int m = 0; m < 4; ++m)
#pragma unroll
                    for (int n = 0; n < 2; ++n) acc[a][b][m][n] = (f32x4){0.f, 0.f, 0.f, 0.f};
        cur = nxt; cA = nA; cB = nB; ++ui;
    }
    PG8_WAIT_V(0);
    if (wr == 0) PG8_BAR;
    PG8_BAR;
    if constexpr (Epi::AFTER_DRAIN) { E.fused(acc, cur, wr, wc, fr, fq, lds, wid, lane); S.done(cur); }
    PG8_STAMP();
    if (STAMP && wid == 0) { stamps[lane] = lane < nts ? (((unsigned long long)(unsigned)ts_hi << 32) | (unsigned)ts_lo) : 0ull;
        if (lane == 62) stamps[62] = rt_entry; if (lane == 63) stamps[63] = (unsigned long long)wall_clock64(); }
#undef PG8_STAMP
#undef PG8_SA
#undef PG8_SB
#undef PG8_STAGE
#undef PG8_LDA
#undef PG8_LDB
#undef PG8_MMA
#undef PG8_WAIT_V
#undef PG8_WAIT_L
#undef PG8_BAR
#undef PG8_SCHED
}
}

#include <hip/hip_cooperative_groups.h>
#include <cstdio>
namespace cg = cooperative_groups;
using namespace pg8;
#define LAS PG8_LAS
typedef float f32x16 __attribute__((ext_vector_type(16)));
typedef unsigned u32x2 __attribute__((ext_vector_type(2)));
typedef float f32x2 __attribute__((ext_vector_type(2)));

constexpr int D = 1024, NB = 8, SEQ = 2048, CTXL = 256, NLAT = NB * SEQ, NCTX = NB * CTXL, NROW = NLAT + NCTX, DFF = 2816;
constexpr float ALPHA_F = 1.41421356237309515f;
constexpr int LDS_BYTES = 135168;
#define PROBE_MASK 0
#define PROBE_REP(bit) for (int rep_ = 0; rep_ < ((PROBE_MASK & (bit)) ? 2 : 1); ++rep_)

constexpr size_t al256(size_t x) { return (x + 255) & ~(size_t)255; }
constexpr size_t WS_MOD = 0;
constexpr size_t WS_KF = al256(WS_MOD + (size_t)2 * 9 * 9216 * 4);
constexpr size_t WS_KFC = al256(WS_KF + (size_t)512 * 4096 * 4);
constexpr size_t WS_XCTX = al256(WS_KFC + (size_t)512 * 512 * 4);
constexpr size_t WS_AGG = al256(WS_XCTX + (size_t)NCTX * D * 4);
constexpr size_t WS_WFI = al256(WS_AGG + (size_t)2 * 8 * 72 * 512 * 2 * 4);
constexpr size_t SZ_WFI = (size_t)5632 * 1024 * 2;
constexpr size_t WS_WFO = al256(WS_WFI + 4 * SZ_WFI);
constexpr size_t SZ_WFO = (size_t)1024 * 2816 * 2;
constexpr size_t WS_WEI = al256(WS_WFO + 4 * SZ_WFO);
constexpr size_t WS_WEO = al256(WS_WEI + (size_t)2560 * 1024 * 2);
constexpr size_t WS_WRG = al256(WS_WEO + (size_t)1024 * 1024 * 2);
constexpr size_t WS_WMI = al256(WS_WRG + (size_t)2048 * 512 * 2);
constexpr size_t WS_WQU = al256(WS_WMI + (size_t)1280 * 1024 * 2);
constexpr size_t WS_WKU = al256(WS_WQU + (size_t)1536 * 768 * 2);
constexpr size_t WS_WVU = al256(WS_WKU + (size_t)1024 * 256 * 2);
constexpr size_t WS_WMO = al256(WS_WVU + (size_t)1024 * 256 * 2);
constexpr size_t WS_H = al256(WS_WMO + (size_t)1024 * 1024 * 2);
constexpr size_t WS_ACT = al256(WS_H + (size_t)NROW * D * 2);
constexpr size_t WS_G = al256(WS_ACT + (size_t)NROW * DFF * 2);
constexpr size_t WS_XC = al256(WS_G + (size_t)NROW * 2048 * 2);
constexpr size_t WS_YT = al256(WS_XC + (size_t)NROW * 512 * 2);
constexpr size_t WS_BAR = al256(WS_YT + (size_t)512 * NROW * 2);
constexpr size_t WS_END = al256(WS_BAR + 16384);
constexpr size_t WS_UT = WS_ACT;
constexpr size_t WS_URG = al256(WS_UT + (size_t)1536 * NROW * 2);
constexpr size_t WS_P = WS_ACT;
constexpr size_t WS_Q = WS_ACT;
constexpr size_t WS_QN = al256(WS_ACT + (size_t)NLAT * 1536 * 2);
constexpr size_t WS_KVN = al256(WS_QN + (size_t)NLAT * 768 * 2);
constexpr size_t WS_KR = al256(WS_KVN + (size_t)NROW * 256 * 2);
static_assert(WS_KR + (size_t)NROW * 32 * 2 <= WS_G, "layer-1 aliases overflow ACT");
static_assert(WS_URG + (size_t)NROW * 1024 * 2 <= WS_G, "layer-0 aliases overflow ACT");
constexpr size_t WS_K = WS_G;
constexpr size_t WS_VT = WS_G + (size_t)NROW * 1024 * 2;

struct Params { const float* in[34]; float* out; unsigned char* ws; };
enum { I_X = 0, I_C, I_CTX, I_CCTX, I_ADAW, I_ADAB, I_LNG, I_LNB, I_FWI, I_FWO, I_EWI, I_EWO, I_HCW, I_HCB, I_HW1, I_HB1, I_HW2, I_HB2, I_HW3, I_HSF, I_HBIAS,
       I_RCW, I_RCB, I_RAW, I_RAB, I_RXW, I_RXB, I_RLAM, I_MWI, I_MQN, I_MKVN, I_MWQ, I_MWKV, I_MWO };

extern __shared__ __attribute__((aligned(16))) unsigned char lds_raw[];
constexpr int TAB_OFF = LDS_BYTES - 16 - 320;
__device__ __forceinline__ unsigned char* tabptr(int i) {
  const volatile LAS unsigned* t = (const volatile LAS unsigned*)((LAS unsigned char*)lds_raw + TAB_OFF) + 2 * i;
  const unsigned lo = __builtin_amdgcn_readfirstlane(t[0]), hi = __builtin_amdgcn_readfirstlane(t[1]);
  return (unsigned char*)(((size_t)hi << 32) | (size_t)lo);
}
#define PIN(i) ((const float*)tabptr(i))
__device__ __forceinline__ int ltid() { int t = threadIdx.x; asm volatile("" : "+v"(t)); return t; }
#define Q8_EMU 0
__device__ __forceinline__ float q8(float x) { unsigned u = __float_as_uint(x); u += 0x7FFFFu + ((u >> 20) & 1u); u &= 0xFFF00000u; return __uint_as_float(u); }
__device__ __forceinline__ float bf2f(unsigned short b) { return __uint_as_float(((unsigned)b) << 16); }
__device__ __forceinline__ float bflo(unsigned w) { return __uint_as_float(w << 16); }
__device__ __forceinline__ float bfhi(unsigned w) { return __uint_as_float(w & 0xffff0000u); }
__device__ __forceinline__ float wave_sum(float v) {
#pragma unroll
  for (int o = 1; o < 64; o <<= 1) v += __shfl_xor(v, o);
  return v;
}
__device__ __forceinline__ float sigmoidf_(float x) { return 1.0f / (1.0f + __expf(-x)); }

struct EpiSwiGLU {
  static constexpr bool PERM = true, AFTER_DRAIN = false;
  bf16_t* O;
  __device__ __forceinline__ void operator()(const f32x4 (&acc)[2][2][4][2], const Unit& u, int wr, int wc, int fr, int fq) const {
    const int row0 = u.pm * BM + wr * 64 + fr, col0 = u.pn * 128 + wc * 32 + 8 * fq;
#pragma unroll
    for (int ai = 0; ai < 2; ++ai)
#pragma unroll
      for (int m = 0; m < 4; ++m) {
        float v[8];
#pragma unroll
        for (int n = 0; n < 2; ++n)
#pragma unroll
          for (int j = 0; j < 4; ++j) { const float a = acc[ai][0][m][n][j], g = acc[ai][1][m][n][j]; const float sg = __builtin_amdgcn_rcpf(1.0f + __expf(-a)); v[4 * n + j] = a * sg * g; }
        u32x4 w; w.x = cvt_pk_bf16(v[0], v[1]); w.y = cvt_pk_bf16(v[2], v[3]); w.z = cvt_pk_bf16(v[4], v[5]); w.w = cvt_pk_bf16(v[6], v[7]);
        *(u32x4*)(O + (size_t)(row0 + ai * HALF + m * 16) * DFF + col0) = w;
      }
  }
};
struct EpiResid {
  static constexpr bool PERM = true, AFTER_DRAIN = false;
  bf16_t* Y2; const float* mod; int gidx; float gs;
  __device__ __forceinline__ void operator()(const f32x4 (&acc)[2][2][4][2], const Unit& u, int wr, int wc, int fr, int fq) const {
    const int rt = u.pm * BM; const int mr = rt / SEQ;
    const int row0 = rt + wr * 64 + fr, col0 = u.pn * BM + wc * 32 + 8 * fq;
    const float* gp = mod + (size_t)(mr * 9 + gidx) * D + col0;
    f32x4 gv[2][2];
#pragma unroll
    for (int bj = 0; bj < 2; ++bj)
#pragma unroll
      for (int n = 0; n < 2; ++n) gv[bj][n] = *(const f32x4*)(gp + bj * HALF + n * 4) * gs;
#pragma unroll
    for (int ai = 0; ai < 2; ++ai)
#pragma unroll
      for (int m = 0; m < 4; ++m) {
        bf16_t* rowp = Y2 + (size_t)(row0 + ai * HALF + m * 16) * D + col0;
#pragma unroll
        for (int bj = 0; bj < 2; ++bj) { const f32x4 v0 = acc[ai][bj][m][0] * gv[bj][0], v1 = acc[ai][bj][m][1] * gv[bj][1];
          u32x4 w; w.x = cvt_pk_bf16(v0[0], v0[1]); w.y = cvt_pk_bf16(v0[2], v0[3]); w.z = cvt_pk_bf16(v1[0], v1[1]); w.w = cvt_pk_bf16(v1[2], v1[3]);
          *(u32x4*)(rowp + bj * HALF) = w; }
      }
  }
};
struct EpiBf16P {
  static constexpr bool PERM = true, AFTER_DRAIN = false;
  bf16_t* O; size_t ldc;
  __device__ __forceinline__ void operator()(const f32x4 (&acc)[2][2][4][2], const Unit& u, int wr, int wc, int fr, int fq) const {
    const int row0 = u.pm * BM + wr * 64 + fr, col0 = u.pn * BM + wc * 32 + 8 * fq;
#pragma unroll
    for (int ai = 0; ai < 2; ++ai)
#pragma unroll
      for (int m = 0; m < 4; ++m) {
        bf16_t* rowp = O + (size_t)(row0 + ai * HALF + m * 16) * ldc + col0;
#pragma unroll
        for (int bj = 0; bj < 2; ++bj) { const f32x4 v0 = acc[ai][bj][m][0], v1 = acc[ai][bj][m][1];
          u32x4 w; w.x = cvt_pk_bf16(v0[0], v0[1]); w.y = cvt_pk_bf16(v0[2], v0[3]); w.z = cvt_pk_bf16(v1[0], v1[1]); w.w = cvt_pk_bf16(v1[2], v1[3]);
          *(u32x4*)(rowp + bj * HALF) = w; }
      }
  }
};
struct EpiGate {
  static constexpr bool PERM = true, AFTER_DRAIN = false;
  bf16_t* O; const float* ab; const float* xb;
  __device__ __forceinline__ void operator()(const f32x4 (&acc)[2][2][4][2], const Unit& u, int wr, int wc, int fr, int fq) const {
    const int row0 = u.pm * BM + wr * 64 + fr, col0 = u.pn * BM + wc * 32 + 8 * fq;
    f32x4 bv[2][2];
#pragma unroll
    for (int bj = 0; bj < 2; ++bj) { const int c = col0 + bj * HALF, g = c >> 9, e = c & 511; const float* bp = ((g & 1) ? xb : ab) + (g >> 1) * 512 + e;
      bv[bj][0] = *(const f32x4*)bp; bv[bj][1] = *(const f32x4*)(bp + 4); }
#pragma unroll
    for (int ai = 0; ai < 2; ++ai)
#pragma unroll
      for (int m = 0; m < 4; ++m) {
        bf16_t* rowp = O + (size_t)(row0 + ai * HALF + m * 16) * 2048 + col0;
#pragma unroll
        for (int bj = 0; bj < 2; ++bj) { f32x4 v0 = acc[ai][bj][m][0] + bv[bj][0], v1 = acc[ai][bj][m][1] + bv[bj][1];
#pragma unroll
          for (int j = 0; j < 4; ++j) { v0[j] = sigmoidf_(v0[j]); v1[j] = sigmoidf_(v1[j]); }
          u32x4 w; w.x = cvt_pk_bf16(v0[0], v0[1]); w.y = cvt_pk_bf16(v0[2], v0[3]); w.z = cvt_pk_bf16(v1[0], v1[1]); w.w = cvt_pk_bf16(v1[2], v1[3]);
          *(u32x4*)(rowp + bj * HALF) = w; }
      }
  }
};
__device__ __forceinline__ float rope_inv_freq(int p) { return exp2f(-(float)p * (13.287712379549449f / 8.0f)); }
struct EpiQ {
  static constexpr bool PERM = true, AFTER_DRAIN = false;
  bf16_t* O;
  __device__ __forceinline__ void operator()(const f32x4 (&acc)[2][2][4][2], const Unit& u, int wr, int wc, int fr, int fq) const {
    const int row0 = u.pm * BM + wr * 64 + fr, col0 = u.pn * BM + wc * 32 + 8 * fq;
#pragma unroll
    for (int bj = 0; bj < 2; ++bj) {
      const int c8 = col0 + bj * HALF; const int f = c8 % 96; const bool rope = f >= 64; const int rp = f - 64; const int a = (rp >> 4) & 1, e = (rp >> 3) & 1;
      float invf[4];
#pragma unroll
      for (int jj = 0; jj < 4; ++jj) invf[jj] = rope_inv_freq(4 * e + jj);
#pragma unroll
      for (int ai = 0; ai < 2; ++ai)
#pragma unroll
        for (int m = 0; m < 4; ++m) {
          const int row = row0 + ai * HALF + m * 16; const int t = row & (SEQ - 1); const float pos = (float)(a == 0 ? (t >> 6) : (t & 63));
          const f32x4 v0 = acc[ai][bj][m][0], v1 = acc[ai][bj][m][1];
          float v[8] = {v0[0], v0[1], v0[2], v0[3], v1[0], v1[1], v1[2], v1[3]};
          if (rope) {
#pragma unroll
            for (int jj = 0; jj < 4; ++jj) { const float ang = pos * invf[jj]; const float cs = __cosf(ang), sn = __sinf(ang); const float x1 = v[2 * jj], x2 = v[2 * jj + 1];
              v[2 * jj] = x1 * cs - x2 * sn; v[2 * jj + 1] = x2 * cs + x1 * sn; }
          }
          u32x4 w; w.x = cvt_pk_bf16(v[0], v[1]); w.y = cvt_pk_bf16(v[2], v[3]); w.z = cvt_pk_bf16(v[4], v[5]); w.w = cvt_pk_bf16(v[6], v[7]);
          *(u32x4*)(O + (size_t)row * 1536 + c8) = w;
        }
    }
  }
};

enum { MAP_ID = 0, MAP_SWIGLU, MAP_MLAIN, MAP_QUP, MAP_KUP, MAP_VUP, MAP_RG };
struct ConvDesc { int kind, K, ld, tile; const float* W; const float* W2; const float* sc; bf16_t* dst; };
__device__ __forceinline__ void conv_load(const ConvDesc& d, int tid, float (&v)[8]) {
  const int nkt = d.K >> 6; const int kt = d.tile % nkt, nt = d.tile / nkt; const int k0 = kt * 64, n0 = nt * 64;
  const int nn = tid & 63, kq = tid >> 6; const int n = n0 + nn; const int kind = d.kind;
  int col = n;
  if (kind == MAP_SWIGLU) { const int t = n >> 8, h = (n >> 7) & 1, j = n & 127; col = h * DFF + t * 128 + j; }
  else if (kind == MAP_MLAIN) { col = n < 1056 ? n : -1; }
  else if (kind == MAP_QUP) { const int hh = n / 96, f = n % 96; if (f >= 64) { const int rp = f - 64, a = rp >> 4, w = rp & 15, pp = w >> 1, hf = w & 1; col = hh * 96 + 64 + a * 16 + hf * 8 + pp; } }
  else if (kind == MAP_KUP) { col = (n >> 6) * 128 + (n & 63); }
  else if (kind == MAP_VUP) { col = (n >> 6) * 128 + 64 + (n & 63); }
#pragma unroll
  for (int i = 0; i < 8; ++i) {
    const int k = k0 + i * 8 + kq; float x;
    if (kind == MAP_RG) { const int g = n >> 9, e = n & 511, nb = e >> 6; x = ((k >> 6) == nb) ? ((g & 1) ? d.W2 : d.W)[((((g >> 1) * 8 + nb) * 64 + (k & 63)) << 6) + (e & 63)] : 0.f; }
    else x = col >= 0 ? d.W[(size_t)k * d.ld + col] : 0.f;
    if (d.sc) x *= d.sc[k];
    if (Q8_EMU && (kind == MAP_SWIGLU || d.K == 2816)) x = q8(x);
    v[i] = x;
  }
}
__device__ __forceinline__ void conv_store(LAS float* scr, const ConvDesc& d, int tid, const float (&v)[8]) {
  const int nkt = d.K >> 6; const int kt = d.tile % nkt, nt = d.tile / nkt; const int k0 = kt * 64, n0 = nt * 64;
  const int nn = tid & 63, kq = tid >> 6;
#pragma unroll
  for (int i = 0; i < 8; ++i) scr[(i * 8 + kq) * 65 + nn] = v[i];
  __syncthreads();
  { const int nl = tid >> 3, c = tid & 7; const LAS float* s = scr + (8 * c) * 65 + nl;
    u32x4 o; o.x = cvt_pk_bf16(s[0], s[65]); o.y = cvt_pk_bf16(s[2 * 65], s[3 * 65]); o.z = cvt_pk_bf16(s[4 * 65], s[5 * 65]); o.w = cvt_pk_bf16(s[6 * 65], s[7 * 65]);
    *(u32x4*)(d.dst + (size_t)(n0 + nl) * d.K + k0 + 8 * c) = o; }
  __syncthreads();
}
__device__ __forceinline__ void convw_load(const ConvDesc& d, int tid, f32x4 (&v)[8]) {
  const int nkt = d.K >> 6; const int kt = d.tile % nkt, nt = d.tile / nkt; const int k0 = kt * 64;
  const int c4 = (tid & 63) * 4, kq = tid >> 6;
  const int col = d.kind == MAP_SWIGLU ? (c4 < 128 ? nt * 128 + c4 : DFF + nt * 128 + (c4 - 128)) : nt * 256 + c4;
#pragma unroll
  for (int i = 0; i < 8; ++i) v[i] = *(const f32x4*)(d.W + (size_t)(k0 + i * 8 + kq) * d.ld + col);
}
__device__ __forceinline__ void convw_store(LAS float* scr, const ConvDesc& d, int tid, const f32x4 (&v)[8]) {
  const int nkt = d.K >> 6; const int kt = d.tile % nkt, nt = d.tile / nkt; const int k0 = kt * 64, n0 = nt * 256;
  const int c4 = (tid & 63) * 4, kq = tid >> 6;
#pragma unroll
  for (int i = 0; i < 8; ++i) *(LAS f32x4*)(scr + (i * 8 + kq) * 260 + c4) = v[i];
  __syncthreads();
  { const int nl = tid >> 1, ch0 = (tid & 1) * 4;
#pragma unroll
    for (int c = 0; c < 4; ++c) { const LAS float* s = scr + (8 * (ch0 + c)) * 260 + nl;
      u32x4 o; o.x = cvt_pk_bf16(s[0], s[260]); o.y = cvt_pk_bf16(s[2 * 260], s[3 * 260]); o.z = cvt_pk_bf16(s[4 * 260], s[5 * 260]); o.w = cvt_pk_bf16(s[6 * 260], s[7 * 260]);
      *(u32x4*)(d.dst + (size_t)(n0 + nl) * d.K + k0 + 8 * (ch0 + c)) = o; } }
  __syncthreads();
}
__device__ __forceinline__ void adaln_job(LAS float* L, const Params& p, int z, float* MOD, int job, bool fill) {
  const int tid = ltid(); const int l = job / 288, col0 = (job % 288) * 32;
  if (fill) { const float* pc = PIN(I_C); const float* pcc = PIN(I_CCTX); for (int i = tid; i < 9 * 1024; i += 512) { const int r = i >> 10, k = i & 1023; const float x = r < 8 ? pc[r * 1024 + k] : pcc[k]; L[i] = x * sigmoidf_(x); }
    __syncthreads(); }
  const int col = tid & 31, kg = tid >> 5;
  const float* W = PIN(I_ADAW) + (size_t)l * 1024 * 9216 + col0 + col + (size_t)(kg * 64) * 9216;
  float acc[9];
#pragma unroll
  for (int r = 0; r < 9; ++r) acc[r] = 0.f;
#pragma unroll 1
  for (int kb = 0; kb < 64; kb += 16) { float w[16];
#pragma unroll
    for (int j = 0; j < 16; ++j) w[j] = W[(size_t)(kb + j) * 9216];
#pragma unroll
    for (int j = 0; j < 16; ++j)
#pragma unroll
      for (int r = 0; r < 9; ++r) acc[r] += L[r * 1024 + kg * 64 + kb + j] * w[j]; }
  LAS float* part = L + 9 * 1024;
#pragma unroll
  for (int r = 0; r < 9; ++r) part[(kg * 9 + r) * 32 + col] = acc[r];
  __syncthreads();
  if (tid < 288) { const int r = tid >> 5, cc = tid & 31; float s = 0.f;
#pragma unroll
    for (int g = 0; g < 16; ++g) s += part[(g * 9 + r) * 32 + cc];
    MOD[(size_t)(l * 9 + r) * 9216 + col0 + cc] = s + PIN(I_ADAB)[l * 9216 + col0 + cc]; }
  __syncthreads();
}
__device__ __forceinline__ void filter_job(LAS float* Ls, const Params& p, int z, float* KF, int L, int job) {
  const int tid = ltid(); const int pos0 = job * 16;
  LAS float* feats = Ls; LAS float* h1 = Ls + 16 * 33; LAS float* h2 = h1 + 1024;
  for (int e = tid; e < 16 * 33; e += 512) { const int pp = e / 33, i = e % 33; const float pos = (float)(pos0 + pp); const float t = pos / (float)L; float v;
    if (i == 0) v = t;
    else { const int j = (i - 1) & 15; const float band = 1e-4f + (float)j * ((15.0f - 1e-4f) / 15.0f); const float rev = t * band;
      v = (i <= 16) ? __builtin_amdgcn_cosf(rev) : -__builtin_amdgcn_sinf(rev); }
    feats[e] = v; }
  __syncthreads();
  { const int j = tid & 63; const float b1 = PIN(I_HB1)[j], f0 = PIN(I_HSF)[j]; float s0 = b1, s1 = b1; const int p0 = tid >> 6, p1 = p0 + 8;
    const float* pw1 = PIN(I_HW1);
#pragma unroll 11
    for (int i = 0; i < 33; ++i) { const float w = pw1[i * 64 + j]; s0 += feats[p0 * 33 + i] * w; s1 += feats[p1 * 33 + i] * w; }
    h1[p0 * 64 + j] = __sinf(f0 * s0); h1[p1 * 64 + j] = __sinf(f0 * s1); }
  __syncthreads();
  { const int j = tid & 63; const float b2 = PIN(I_HB2)[j], f1 = PIN(I_HSF)[64 + j]; float s0 = b2, s1 = b2; const int p0 = tid >> 6, p1 = p0 + 8;
    const float* pw2 = PIN(I_HW2);
#pragma unroll 16
    for (int i = 0; i < 64; ++i) { const float w = pw2[i * 64 + j]; s0 += h1[p0 * 64 + i] * w; s1 += h1[p1 * 64 + i] * w; }
    h2[p0 * 64 + j] = __sinf(f1 * s0); h2[p1 * 64 + j] = __sinf(f1 * s1); }
  __syncthreads();
  const int ch = tid; const float delta = fabsf(-3.0701134573253945f + (float)ch * ((-15.350567286626973f + 3.0701134573253945f) / 511.0f));
#pragma unroll 1
  for (int q = 0; q < 2; ++q) {
    const int n = q * 512 + ch; float acc[16]; const float* pw3 = PIN(I_HW3);
#pragma unroll
    for (int pp = 0; pp < 16; ++pp) acc[pp] = 0.f;
#pragma unroll 1
    for (int ib = 0; ib < 64; ib += 4) { float w[4];
#pragma unroll
      for (int j = 0; j < 4; ++j) w[j] = pw3[(ib + j) * 1024 + n];
#pragma unroll
      for (int j = 0; j < 4; ++j)
#pragma unroll
        for (int pp = 0; pp < 16; ++pp) acc[pp] += h2[pp * 64 + ib + j] * w[j]; }
#pragma unroll
    for (int pp = 0; pp < 16; ++pp) { const int d = pos0 + pp; const float t = (float)d / (float)L; const float val = acc[pp] * (__expf(-t * delta) + 0.05f);
      if (q == 0) KF[(size_t)ch * (2 * L) + L + d] = val; else if (d >= 1) KF[(size_t)ch * (2 * L) + L - d] = val; }
  }
  __syncthreads();
}

typedef _Float16 f16x4 __attribute__((ext_vector_type(4)));
__device__ __forceinline__ void row_pass(const float* s32lat, const float* s32ctx, const _Float16* s16, _Float16* d16, float* d32, bool do_ln, const float* g, const float* b, bf16_t* H, const float* modn  , int sidx, int nrows, const float* zp, const float* gate8, float gs, const bf16_t* y2) {
  const int lane = ltid() & 63; const int gw = blockIdx.x * 8 + (ltid() >> 6), ngw = gridDim.x * 8;
  constexpr int R = 3;
#pragma unroll 1
  for (int row0 = gw; row0 < nrows; row0 += R * ngw) {
    f32x4 v[R][4]; bool ok[R]; int rows[R];
#pragma unroll
    for (int r = 0; r < R; ++r) { const int row = row0 + r * ngw; ok[r] = row < nrows; const int rr = ok[r] ? row : row0; rows[r] = rr; const bool lat = rr < NLAT;
      if (s16) { const _Float16* sp = s16 + (size_t)rr * D + lane * 4;
#pragma unroll
        for (int j = 0; j < 4; ++j) v[r][j] = __builtin_convertvector(*(const f16x4*)(sp + 256 * j), f32x4); }
      else { const float* sp = (lat ? s32lat + (size_t)rr * D : s32ctx + (size_t)(rr - NLAT) * D) + lane * 4;
#pragma unroll
        for (int j = 0; j < 4; ++j) v[r][j] = *(const f32x4*)(sp + 256 * j); }
      if (y2 && lat) { const bf16_t* yr = y2 + (size_t)rr * D + lane * 4;
#pragma unroll
        for (int j = 0; j < 4; ++j) { const u32x2 w = *(const u32x2*)(yr + 256 * j); v[r][j] = v[r][j] * ALPHA_F + (f32x4){bflo(w.x), bfhi(w.x), bflo(w.y), bfhi(w.y)}; } }
      if (zp && !lat) { const float* zr = zp + (size_t)(rr - NLAT) * D + lane * 4;
#pragma unroll
        for (int j = 0; j < 4; ++j) { const f32x4 y = (*(const f32x4*)(zr + 256 * j) + *(const f32x4*)(zr + (size_t)NCTX * D + 256 * j)) + (*(const f32x4*)(zr + (size_t)2 * NCTX * D + 256 * j) + *(const f32x4*)(zr + (size_t)3 * NCTX * D + 256 * j));
          v[r][j] = v[r][j] * ALPHA_F + (*(const f32x4*)(gate8 + lane * 4 + 256 * j) * gs) * y; } } }
    if (do_ln) {
      float s[R], q[R];
#pragma unroll
      for (int r = 0; r < R; ++r) { s[r] = 0.f;
#pragma unroll
        for (int j = 0; j < 4; ++j) s[r] += (v[r][j][0] + v[r][j][1]) + (v[r][j][2] + v[r][j][3]); }
#pragma unroll
      for (int o = 1; o < 64; o <<= 1) {
#pragma unroll
        for (int r = 0; r < R; ++r) s[r] += __shfl_xor(s[r], o); }
#pragma unroll
      for (int r = 0; r < R; ++r) { const float mean = s[r] * (1.0f / D); q[r] = 0.f;
#pragma unroll
        for (int j = 0; j < 4; ++j) { v[r][j] = v[r][j] - mean; q[r] += (v[r][j][0] * v[r][j][0] + v[r][j][1] * v[r][j][1]) + (v[r][j][2] * v[r][j][2] + v[r][j][3] * v[r][j][3]); } }
#pragma unroll
      for (int o = 1; o < 64; o <<= 1) {
#pragma unroll
        for (int r = 0; r < R; ++r) q[r] += __shfl_xor(q[r], o); }
#pragma unroll
      for (int j = 0; j < 4; ++j) { const f32x4 gg = *(const f32x4*)(g + lane * 4 + 256 * j), bb = *(const f32x4*)(b + lane * 4 + 256 * j);
#pragma unroll
        for (int r = 0; r < R; ++r) { const float rstd = 1.0f / sqrtf(q[r] * (1.0f / D) + 1e-6f); v[r][j] = v[r][j] * rstd * gg + bb; } }
    }
#pragma unroll
    for (int r = 0; r < R; ++r) {
      if (!ok[r]) continue;
      const int row = rows[r];
      if (d16) { _Float16* dp = d16 + (size_t)row * D + lane * 4;
#pragma unroll
        for (int j = 0; j < 4; ++j) *(f16x4*)(dp + 256 * j) = __builtin_convertvector(v[r][j], f16x4); }
      if (d32 && row < NLAT) { float* dp = d32 + (size_t)row * D + lane * 4;
#pragma unroll
        for (int j = 0; j < 4; ++j) *(f32x4*)(dp + 256 * j) = v[r][j]; }
      if (H) {
        const int mr = row < NLAT ? row / SEQ : 8; const float* sh = modn + (size_t)(mr * 9 + sidx) * D; const float* sc = sh + D;
#pragma unroll
        for (int j = 0; j < 4; ++j) { const f32x4 s1 = *(const f32x4*)(sh + lane * 4 + 256 * j), s2 = *(const f32x4*)(sc + lane * 4 + 256 * j); const f32x4 h = v[r][j] * (s2 + 1.0f) + s1;
          u32x2 w; w.x = cvt_pk_bf16(h[0], h[1]); w.y = cvt_pk_bf16(h[2], h[3]); *(u32x2*)(H + (size_t)row * D + lane * 4 + 256 * j) = w; }
      }
    }
  }
}
__device__ __forceinline__ void mla_rownorm(const bf16_t* P, bf16_t* QN, bf16_t* KVN, bf16_t* KR) {
  const int lane = ltid() & 63; const int gw = blockIdx.x * 8 + (ltid() >> 6), ngw = gridDim.x * 8;
  for (int row = gw; row < NROW; row += ngw) {
    const bf16_t* pr = P + (size_t)row * 1280; const bool lat = row < NLAT;
    if (lat) {
      u32x2 w[3]; float ss = 0.f;
#pragma unroll
      for (int j = 0; j < 3; ++j) { w[j] = *(const u32x2*)(pr + lane * 4 + 256 * j); const float a = bflo(w[j].x), b = bfhi(w[j].x), c = bflo(w[j].y), d = bfhi(w[j].y); ss += (a * a + b * b) + (c * c + d * d); }
      const float r = 1.0f / sqrtf(wave_sum(ss) * (1.0f / 768.0f) + 1e-6f);
#pragma unroll
      for (int j = 0; j < 3; ++j) { u32x2 o; o.x = cvt_pk_bf16(bflo(w[j].x) * r, bfhi(w[j].x) * r); o.y = cvt_pk_bf16(bflo(w[j].y) * r, bfhi(w[j].y) * r); *(u32x2*)(QN + (size_t)row * 768 + lane * 4 + 256 * j) = o; }
    }
    { const u32x2 w = *(const u32x2*)(pr + 768 + lane * 4); const float a = bflo(w.x), b = bfhi(w.x), c = bflo(w.y), d = bfhi(w.y);
      const float r = 1.0f / sqrtf(wave_sum((a * a + b * b) + (c * c + d * d)) * (1.0f / 256.0f) + 1e-6f);
      u32x2 o; o.x = cvt_pk_bf16(a * r, b * r); o.y = cvt_pk_bf16(c * r, d * r); *(u32x2*)(KVN + (size_t)row * 256 + lane * 4) = o; }
    if (lane < 16) { const int a = lane >> 3, pp = lane & 7; float x1 = bf2f(pr[1024 + a * 16 + pp]), x2 = bf2f(pr[1024 + a * 16 + 8 + pp]);
      if (lat) { const int t = row & (SEQ - 1); const float pos = (float)(a == 0 ? (t >> 6) : (t & 63)); const float ang = pos * rope_inv_freq(pp); const float cs = __cosf(ang), sn = __sinf(ang);
        const float o1 = x1 * cs - x2 * sn, o2 = x2 * cs + x1 * sn; x1 = o1; x2 = o2; }
      *(unsigned*)(KR + (size_t)row * 32 + a * 16 + 2 * pp) = cvt_pk_bf16(x1, x2); }
  }
}

__device__ __forceinline__ void xc_build(const Params& p, int z, const bf16_t* URG, bf16_t* XC) {
  const float* cw = PIN(I_RCW); const float* cb = PIN(I_RCB);
  for (int it = blockIdx.x * 512 + ltid(); it < NROW * 64; it += gridDim.x * 512) {
    const int row = it >> 6, c8 = (it & 63) * 8; int t, Ls; if (row < NLAT) { t = row & (SEQ - 1); Ls = SEQ; } else { t = (row - NLAT) & (CTXL - 1); Ls = CTXL; }
    float acc[8];
#pragma unroll
    for (int j = 0; j < 8; ++j) acc[j] = cb[c8 + j];
#pragma unroll
    for (int k = 0; k < 4; ++k) { const int tt = t + k - 2; if (tt >= 0 && tt < Ls) { const u32x4 w = *(const u32x4*)(URG + (size_t)(row + k - 2) * 1024 + c8);
        const f32x4 w0 = *(const f32x4*)(cw + k * 512 + c8), w1 = *(const f32x4*)(cw + k * 512 + c8 + 4);
        acc[0] += bflo(w.x) * w0[0]; acc[1] += bfhi(w.x) * w0[1]; acc[2] += bflo(w.y) * w0[2]; acc[3] += bfhi(w.y) * w0[3];
        acc[4] += bflo(w.z) * w1[0]; acc[5] += bfhi(w.z) * w1[1]; acc[6] += bflo(w.w) * w1[2]; acc[7] += bfhi(w.w) * w1[3]; } }
    u32x4 o; o.x = cvt_pk_bf16(acc[0], acc[1]); o.y = cvt_pk_bf16(acc[2], acc[3]); o.z = cvt_pk_bf16(acc[4], acc[5]); o.w = cvt_pk_bf16(acc[6], acc[7]);
    *(u32x4*)(XC + (size_t)row * 512 + c8) = o;
  }
}
constexpr int HY_CSTRIDE = 8224;
__device__ __forceinline__ void hyena_unit(LAS unsigned char* lds, const Params& p, int z, const bf16_t* UT, const float* KFa, bf16_t* YT, int c, int L, int tokbase) {
  const int tid = ltid(), lane = tid & 63, wid = tid >> 6;
  const int OFF = L + 16, NC = 2 * L + 16; const int rstride = L * 2 + 16;
  LAS unsigned char* cp = lds; LAS unsigned char* WT = lds + 8 * HY_CSTRIDE; LAS unsigned char* X0 = WT + 8 * (2048 * 2 + 16);
  { const float bias = PIN(I_HBIAS)[c]; const float* kf = KFa + (size_t)c * (2 * L) + L; const int ngrp = NC >> 3;
#pragma unroll 3
    for (int gidx = tid; gidx < 8 * ngrp; gidx += 512) { const int r = gidx / ngrp, m = gidx - r * ngrp; const int dhi = OFF + r - 8 * m;
      float v[8];
      if (dhi < L && dhi - 7 > -L) { const f32x4 lo = *(const f32x4*)(kf + dhi - 7), hi = *(const f32x4*)(kf + dhi - 3);
        v[0] = hi[3]; v[1] = hi[2]; v[2] = hi[1]; v[3] = hi[0]; v[4] = lo[3]; v[5] = lo[2]; v[6] = lo[1]; v[7] = lo[0]; }
      else {
#pragma unroll
        for (int j = 0; j < 8; ++j) { const int d = dhi - j; v[j] = (d > -L && d < L) ? kf[d] : 0.f; } }
#pragma unroll
      for (int j = 0; j < 8; ++j) if (dhi - j == 0) v[j] += bias;
      u32x4 o; o.x = cvt_pk_bf16(v[0], v[1]); o.y = cvt_pk_bf16(v[2], v[3]); o.z = cvt_pk_bf16(v[4], v[5]); o.w = cvt_pk_bf16(v[6], v[7]);
      *(LAS u32x4*)(cp + r * HY_CSTRIDE + m * 16) = o; } }
  { const float* cw = PIN(I_HCW); const float* cb = PIN(I_HCB);
    float w0[3], w1[3], w2[3], bb[3];
#pragma unroll
    for (int a = 0; a < 3; ++a) { w0[a] = cw[0 * 1536 + a * 512 + c]; w1[a] = cw[1 * 1536 + a * 512 + c]; w2[a] = cw[2 * 1536 + a * 512 + c]; bb[a] = cb[a * 512 + c]; }
    const int cpb = L >> 3;
#pragma unroll 2
    for (int ch = tid; ch < 8 * cpb; ch += 512) { const int b = ch / cpb, t8 = (ch - b * cpb) * 8; float res[3][8];
#pragma unroll
      for (int a = 0; a < 3; ++a) { const bf16_t* rowp = UT + (size_t)(a * 512 + c) * NROW + tokbase + b * L + t8; const u32x4 w = *(const u32x4*)rowp;
        float x[10]; x[0] = t8 > 0 ? bf2f(rowp[-1]) : 0.f; x[9] = t8 + 8 < L ? bf2f(rowp[8]) : 0.f;
        x[1] = bflo(w.x); x[2] = bfhi(w.x); x[3] = bflo(w.y); x[4] = bfhi(w.y); x[5] = bflo(w.z); x[6] = bfhi(w.z); x[7] = bflo(w.w); x[8] = bfhi(w.w);
#pragma unroll
        for (int j = 0; j < 8; ++j) res[a][j] = x[j] * w0[a] + x[j + 1] * w1[a] + x[j + 2] * w2[a] + bb[a]; }
      u32x4 ow, ox;
      ow.x = cvt_pk_bf16(res[2][0] * res[1][0], res[2][1] * res[1][1]); ow.y = cvt_pk_bf16(res[2][2] * res[1][2], res[2][3] * res[1][3]);
      ow.z = cvt_pk_bf16(res[2][4] * res[1][4], res[2][5] * res[1][5]); ow.w = cvt_pk_bf16(res[2][6] * res[1][6], res[2][7] * res[1][7]);
      ox.x = cvt_pk_bf16(res[0][0], res[0][1]); ox.y = cvt_pk_bf16(res[0][2], res[0][3]); ox.z = cvt_pk_bf16(res[0][4], res[0][5]); ox.w = cvt_pk_bf16(res[0][6], res[0][7]);
      *(LAS u32x4*)(WT + b * rstride + t8 * 2) = ow; *(LAS u32x4*)(X0 + b * rstride + t8 * 2) = ox; }
  }
  __syncthreads();
  { const int n = lane & 15, g = lane >> 4, bq = n & 7; const int i = lane & 15, q = i >> 3, r = i & 7;
    const int ngroups = L >> 6;
    const LAS unsigned char* bbase = WT + bq * rstride + g * 16;
    const LAS unsigned char* abase = cp + r * HY_CSTRIDE + (8 * g - 8 * q + OFF) * 2;
    for (int grp = wid; grp < ngroups; grp += 8) {
      f32x4 acc[4];
#pragma unroll
      for (int ii = 0; ii < 4; ++ii) acc[ii] = (f32x4){0.f, 0.f, 0.f, 0.f};
      const int t0 = grp * 64;
      for (int J = 0; J < (L >> 5); ++J) {
        const bf16x8 bf = *(const LAS bf16x8*)(bbase + J * 64);
#pragma unroll
        for (int ii = 0; ii < 4; ++ii) { const bf16x8 af = *(const LAS bf16x8*)(abase + (32 * J - t0 - 16 * ii) * 2);
          acc[ii] = __builtin_amdgcn_mfma_f32_16x16x32_bf16(af, bf, acc[ii], 0, 0, 0); }
      }
      if (n < 8) {
#pragma unroll
        for (int ii = 0; ii < 4; ++ii) { const int t = t0 + 16 * ii + 4 * g; const u32x2 xw = *(const LAS u32x2*)(X0 + n * rstride + t * 2);
          u32x2 o; o.x = cvt_pk_bf16(acc[ii][0] * bflo(xw.x), acc[ii][1] * bfhi(xw.x)); o.y = cvt_pk_bf16(acc[ii][2] * bflo(xw.y), acc[ii][3] * bfhi(xw.y));
          *(u32x2*)(YT + (size_t)c * NROW + tokbase + n * L + t) = o; }
      }
    }
  }
  __syncthreads();
}
__device__ __forceinline__ void yt_transpose(LAS unsigned char* lds, const bf16_t* YT, bf16_t* Y, int job) {
  const int tid = ltid(); const int ct = job & 7, tt = job >> 3; const int c0 = ct * 64, tok0 = tt * 64;
  LAS unsigned short* T = (LAS unsigned short*)lds;
  { const int i = tid >> 3, ch = tid & 7; const u32x4 w = *(const u32x4*)(YT + (size_t)(c0 + i) * NROW + tok0 + ch * 8); *(LAS u32x4*)(T + i * 72 + ch * 8) = w; }
  __syncthreads();
  { const int t = tid >> 3, cc = (tid & 7) * 8; unsigned short v[8];
#pragma unroll
    for (int j = 0; j < 8; ++j) v[j] = T[(cc + j) * 72 + t];
    u32x4 o; o.x = v[0] | ((unsigned)v[1] << 16); o.y = v[2] | ((unsigned)v[3] << 16); o.z = v[4] | ((unsigned)v[5] << 16); o.w = v[6] | ((unsigned)v[7] << 16);
    *(u32x4*)(Y + (size_t)(tok0 + t) * 1024 + c0 + cc) = o; }
  __syncthreads();
}
constexpr int SC_CL = 32, SC_NC = 72, SC_NCTX = 8;
__device__ __forceinline__ int scan_row0(int b, int chunk) { return chunk < SC_NCTX ? NLAT + b * CTXL + chunk * SC_CL : b * SEQ + (chunk - SC_NCTX) * SC_CL; }
__device__ __forceinline__ void rg_coef(float r, float ig, float xc, float cl, float& a, float& bb) {
  const float la = r * cl; a = __builtin_amdgcn_exp2f(la * 1.4426950408889634f); const float x = 2.0f * la;
  float om = -x * (1.0f + x * (0.5f + x * (0.16666667f + x * (0.041666668f + x * (0.0083333338f + x * 0.0013888889f)))));
  om = (x < -0.5f) ? 1.0f - a * a : om;
  bb = __builtin_amdgcn_sqrtf(fmaxf(om, 0.f)) * (ig * xc);
}
__device__ __forceinline__ float scan_cl(const Params& p, int z, int dir, int ch) { const float lam = PIN(I_RLAM)[dir * 512 + ch]; return -8.0f * log1pf(__expf(-lam)); }
constexpr int SC_XROW = 1040;
__device__ __forceinline__ void scan_xc_load(const bf16_t* XC, int job, int tid, u32x4 (&xr)[4]) {
  const int b = job / SC_NC, chunk = job % SC_NC; const int row0 = scan_row0(b, chunk);
#pragma unroll
  for (int it = 0; it < 4; ++it) { const int id = it * 512 + tid; const int r = id >> 6, c8 = (id & 63) * 8; xr[it] = *(const u32x4*)(XC + (size_t)(row0 + r) * 512 + c8); }
}
__device__ __forceinline__ void scan_pass_a(LAS unsigned char* lds, const Params& p, int z, const bf16_t* XC, const bf16_t* WRG, unsigned* COEF, float* AGG, int job, int tid, const u32x4 (&xr)[4]) {
  const int lane = tid & 63, w = tid >> 6; const int b = job / SC_NC, chunk = job % SC_NC; const int row0 = scan_row0(b, chunk);
  LAS unsigned* coef = (LAS unsigned*)lds;
  LAS unsigned char* xcl = lds + 65536;
#pragma unroll
  for (int it = 0; it < 4; ++it) { const int id = it * 512 + tid; const int r = id >> 6, c8 = (id & 63) * 8; *(LAS u32x4*)(xcl + r * SC_XROW + c8 * 2) = xr[it]; }
  const int n = lane & 15, g = lane >> 4;
  __syncthreads();
  bf16x8 af[2][2];
#pragma unroll
  for (int mb = 0; mb < 2; ++mb)
#pragma unroll
    for (int ks = 0; ks < 2; ++ks) af[mb][ks] = *(const LAS bf16x8*)(xcl + (16 * mb + n) * SC_XROW + (64 * w + 32 * ks + 8 * g) * 2);
#pragma unroll 1
  for (int dir = 0; dir < 2; ++dir) {
    bf16x8 wf[4][2][2];
#pragma unroll
    for (int nblk = 0; nblk < 4; ++nblk)
#pragma unroll
      for (int ty = 0; ty < 2; ++ty) { const bf16_t* wp = WRG + (size_t)((dir * 2 + ty) * 512 + 64 * w + 16 * nblk + n) * 512 + 64 * w + 8 * g; wf[nblk][ty][0] = *(const bf16x8*)wp; wf[nblk][ty][1] = *(const bf16x8*)(wp + 32); }
#pragma unroll
    for (int nblk = 0; nblk < 4; ++nblk) {
      const int ch = 64 * w + 16 * nblk + n;
      f32x4 ar[2], ai[2];
#pragma unroll
      for (int mb = 0; mb < 2; ++mb) { ar[mb] = (f32x4){0.f, 0.f, 0.f, 0.f}; ai[mb] = (f32x4){0.f, 0.f, 0.f, 0.f};
        ar[mb] = __builtin_amdgcn_mfma_f32_16x16x32_bf16(af[mb][0], wf[nblk][0][0], ar[mb], 0, 0, 0); ar[mb] = __builtin_amdgcn_mfma_f32_16x16x32_bf16(af[mb][1], wf[nblk][0][1], ar[mb], 0, 0, 0);
        ai[mb] = __builtin_amdgcn_mfma_f32_16x16x32_bf16(af[mb][0], wf[nblk][1][0], ai[mb], 0, 0, 0); ai[mb] = __builtin_amdgcn_mfma_f32_16x16x32_bf16(af[mb][1], wf[nblk][1][1], ai[mb], 0, 0, 0); }
      const float biasr = PIN(I_RAB)[dir * 512 + ch], biasi = PIN(I_RXB)[dir * 512 + ch]; const float cl = scan_cl(p, z, dir, ch);
#pragma unroll
      for (int mb = 0; mb < 2; ++mb)
#pragma unroll
        for (int jj = 0; jj < 4; ++jj) { const int row = 16 * mb + 4 * g + jj;
          const float r = __fdividef(1.0f, 1.0f + __expf(-(ar[mb][jj] + biasr))), ig = __fdividef(1.0f, 1.0f + __expf(-(ai[mb][jj] + biasi))); const float xc = bf2f(*(const LAS unsigned short*)(xcl + row * SC_XROW + ch * 2));
          const float rq = bflo(cvt_pk_bf16(r, 0.f)), iq = bflo(cvt_pk_bf16(ig, 0.f));
          const float la = rq * cl; const float a = __builtin_amdgcn_exp2f(la * 1.4426950408889634f); const float x = 2.0f * la;
          float om = -x * (1.0f + x * (0.5f + x * (0.16666667f + x * (0.041666668f + x * (0.0083333338f + x * 0.0013888889f)))));
          om = (x < -0.5f) ? 1.0f - a * a : om;
          const float bb = __builtin_amdgcn_sqrtf(fmaxf(om, 0.f)) * (iq * xc);
          coef[row * 512 + ch] = cvt_pk_bf16(la, bb); }
    }
    __syncthreads();
    { const int ch = tid; float A = 1.f, B = 0.f; unsigned* cg_ = COEF + (size_t)row0 * 1024 + dir * 512 + ch;
#pragma unroll 8
      for (int tt = 0; tt < SC_CL; ++tt) { const int t = dir ? SC_CL - 1 - tt : tt; const unsigned c = coef[t * 512 + ch]; cg_[(size_t)t * 1024] = c;
        const float a = __builtin_amdgcn_exp2f(bflo(c) * 1.4426950408889634f); A *= a; B = B * a + bfhi(c); }
      float* ag = AGG + ((size_t)((dir * 8 + b) * SC_NC + chunk) * 512 + ch) * 2; ag[0] = A; ag[1] = B; }
    __syncthreads();
  }
}
__device__ __forceinline__ float scan_carry(const float* AGG, int dir, int b, int chunk, int ch) {
  const int pos = dir == 0 ? chunk : (chunk < SC_NCTX ? SC_NCTX - 1 - chunk : (SC_NC + SC_NCTX - 1) - chunk);
  float h = 0.f;
#pragma unroll 1
  for (int ob = 0; ob < pos; ob += 24) { float aa[24], bb[24];
#pragma unroll
    for (int j = 0; j < 24; ++j) { const int o = ob + j; const int oo = o < pos ? o : 0; const int cj = dir == 0 ? oo : (oo < SC_NCTX ? SC_NCTX - 1 - oo : (SC_NC + SC_NCTX - 1) - oo);
      const f32x2 v = *(const f32x2*)(AGG + ((size_t)((dir * 8 + b) * SC_NC + cj) * 512 + ch) * 2); aa[j] = o < pos ? v.x : 1.f; bb[j] = o < pos ? v.y : 0.f; }
#pragma unroll
    for (int j = 0; j < 24; ++j) h = aa[j] * h + bb[j]; }
  return h;
}
__device__ __forceinline__ void scan_pass_b(LAS unsigned char* lds, const unsigned* COEF, const bf16_t* URG, const float* AGG, bf16_t* Y, int job) {
  const int ch = ltid(); const int b = job / SC_NC, chunk = job % SC_NC; const int row0 = scan_row0(b, chunk);
  LAS float* hf = (LAS float*)lds;
  const unsigned* c0 = COEF + (size_t)row0 * 1024 + ch;
  { float h = scan_carry(AGG, 0, b, chunk, ch);
#pragma unroll 1
    for (int tb = 0; tb < SC_CL; tb += 16) { unsigned cc[16];
#pragma unroll
      for (int j = 0; j < 16; ++j) cc[j] = c0[(size_t)(tb + j) * 1024];
#pragma unroll
      for (int j = 0; j < 16; ++j) { const float a = __builtin_amdgcn_exp2f(bflo(cc[j]) * 1.4426950408889634f); h = a * h + bfhi(cc[j]); hf[(tb + j) * 512 + ch] = h; } } }
  { float h = scan_carry(AGG, 1, b, chunk, ch);
#pragma unroll 1
    for (int tb = 0; tb < SC_CL; tb += 16) { unsigned cc[16]; float gg[16];
#pragma unroll
      for (int j = 0; j < 16; ++j) { const int t = SC_CL - 1 - (tb + j); cc[j] = c0[(size_t)t * 1024 + 512]; gg[j] = bf2f(URG[(size_t)(row0 + t) * 1024 + 512 + ch]); }
#pragma unroll
      for (int j = 0; j < 16; ++j) { const int t = SC_CL - 1 - (tb + j); const float a = __builtin_amdgcn_exp2f(bflo(cc[j]) * 1.4426950408889634f); h = a * h + bfhi(cc[j]);
        const float gt = gg[j]; const float zz = 0.7978845608028654f * (gt + 0.044715f * gt * gt * gt);
        const float th = 1.0f - 2.0f * __builtin_amdgcn_rcpf(1.0f + __expf(2.0f * zz)); const float ge = 0.5f * gt * (1.0f + th);
        Y[(size_t)(row0 + t) * 1024 + 512 + ch] = (unsigned short)(cvt_pk_bf16((h + hf[t * 512 + ch]) * ge, 0.f) & 0xffffu); } } }
}

__device__ __forceinline__ void attn_phase(LAS unsigned char* lds, const bf16_t* Q, const bf16_t* Kb, const bf16_t* KR, const bf16_t* VT, bf16_t* O) {
  const int tid = ltid(), wid = tid >> 6, lane = tid & 63, l32 = lane & 31, hf = lane >> 5;
  constexpr int KROW = 208, KBUF = 64 * KROW, VROW = 136, VBUF = 64 * VROW;
  LAS unsigned char* Kl = lds; LAS unsigned char* Vl = lds + 2 * KBUF;
  const int G = gridDim.x; const float cs = 0.10206207261596575f * 1.4426950408889634f;
  const int kkey = tid >> 3, kpart = tid & 7, rkey = (tid >> 2) & 63, rpart = tid & 3, vdv = tid >> 3, vpart = tid & 7;
  for (int u = blockIdx.x; u < 1024; u += G) {
    int bh, qb;
    if (G == 256) { const int xcd = blockIdx.x & 7, within = blockIdx.x >> 3, r = u >> 8; bh = xcd * 16 + r * 4 + (within >> 3); qb = within & 7; } else { bh = u >> 3; qb = u & 7; }
    const int b = bh >> 4, h = bh & 15;
    const int q = qb * 256 + wid * 32 + l32;
    const bf16_t* qp = Q + (size_t)(b * SEQ + q) * 1536 + h * 96 + hf * 8;
    bf16x8 qf[6];
#pragma unroll
    for (int ks = 0; ks < 6; ++ks) qf[ks] = *(const bf16x8*)(qp + ks * 16);
    f32x16 o0, o1;
#pragma unroll
    for (int i = 0; i < 16; ++i) { o0[i] = 0.f; o1[i] = 0.f; }
    float mrun = -1e30f, lsum = 0.f;
    u32x4 kreg, rreg, vreg;
#define ATT_LOAD(j) do { const int tb_ = (j) < 32 ? b * SEQ + (j) * 64 : NLAT + b * CTXL + ((j) - 32) * 64; \
      kreg = *(const u32x4*)(Kb + (size_t)(tb_ + kkey) * 1024 + h * 64 + kpart * 8); \
      if (tid < 256) rreg = *(const u32x4*)(KR + (size_t)(tb_ + rkey) * 32 + rpart * 8); \
      vreg = *(const u32x4*)(VT + (size_t)(h * 64 + vdv) * NROW + tb_ + vpart * 8); } while (0)
#define ATT_STORE(buf) do { *(LAS u32x4*)(Kl + (buf) * KBUF + kkey * KROW + kpart * 16) = kreg; \
      if (tid < 256) *(LAS u32x4*)(Kl + (buf) * KBUF + rkey * KROW + 128 + rpart * 16) = rreg; \
      *(LAS u32x2*)(Vl + (buf) * VBUF + vdv * VROW + vpart * 16) = (u32x2){vreg.x, vreg.y}; *(LAS u32x2*)(Vl + (buf) * VBUF + vdv * VROW + vpart * 16 + 8) = (u32x2){vreg.z, vreg.w}; } while (0)
    ATT_LOAD(0); ATT_STORE(0); __syncthreads();
    for (int j = 0; j < 36; ++j) {
      if (j + 1 < 36) ATT_LOAD(j + 1);
      const int cur = j & 1;
      f32x16 s0, s1;
#pragma unroll
      for (int i = 0; i < 16; ++i) { s0[i] = 0.f; s1[i] = 0.f; }
      const LAS unsigned char* kb0 = Kl + cur * KBUF + l32 * KROW + hf * 16;
#pragma unroll
      for (int ks = 0; ks < 6; ++ks) { const bf16x8 a0 = *(const LAS bf16x8*)(kb0 + ks * 32), a1 = *(const LAS bf16x8*)(kb0 + 32 * KROW + ks * 32);
        s0 = __builtin_amdgcn_mfma_f32_32x32x16_bf16(a0, qf[ks], s0, 0, 0, 0); s1 = __builtin_amdgcn_mfma_f32_32x32x16_bf16(a1, qf[ks], s1, 0, 0, 0); }
      float tmax = s0[0];
#pragma unroll
      for (int i = 1; i < 16; ++i) tmax = fmaxf(tmax, s0[i]);
#pragma unroll
      for (int i = 0; i < 16; ++i) tmax = fmaxf(tmax, s1[i]);
      tmax = fmaxf(tmax, __shfl_xor(tmax, 32));
      const float mnew = fmaxf(mrun, tmax * cs); const float alpha = __builtin_amdgcn_exp2f(mrun - mnew); mrun = mnew;
      float psum = 0.f;
#pragma unroll
      for (int i = 0; i < 16; ++i) { s0[i] = __builtin_amdgcn_exp2f(s0[i] * cs - mnew); s1[i] = __builtin_amdgcn_exp2f(s1[i] * cs - mnew); psum += s0[i] + s1[i]; }
      lsum = lsum * alpha + psum;
#pragma unroll
      for (int i = 0; i < 16; ++i) { o0[i] *= alpha; o1[i] *= alpha; }
      const LAS unsigned char* vb0 = Vl + cur * VBUF + l32 * VROW + hf * 8;
#pragma unroll
      for (int kb = 0; kb < 2; ++kb)
#pragma unroll
        for (int k2 = 0; k2 < 2; ++k2) {
          bf16x8 pf; { unsigned w0, w1, w2, w3;
            if (kb == 0) { w0 = cvt_pk_bf16(s0[8 * k2 + 0], s0[8 * k2 + 1]); w1 = cvt_pk_bf16(s0[8 * k2 + 2], s0[8 * k2 + 3]); w2 = cvt_pk_bf16(s0[8 * k2 + 4], s0[8 * k2 + 5]); w3 = cvt_pk_bf16(s0[8 * k2 + 6], s0[8 * k2 + 7]); }
            else { w0 = cvt_pk_bf16(s1[8 * k2 + 0], s1[8 * k2 + 1]); w1 = cvt_pk_bf16(s1[8 * k2 + 2], s1[8 * k2 + 3]); w2 = cvt_pk_bf16(s1[8 * k2 + 4], s1[8 * k2 + 5]); w3 = cvt_pk_bf16(s1[8 * k2 + 6], s1[8 * k2 + 7]); }
            const u32x4 pw = {w0, w1, w2, w3}; pf = __builtin_bit_cast(bf16x8, pw); }
          const int koff = (32 * kb + 16 * k2) * 2;
          { const u32x2 va = *(const LAS u32x2*)(vb0 + koff), vb = *(const LAS u32x2*)(vb0 + koff + 16); const u32x4 vw = {va.x, va.y, vb.x, vb.y};
            o0 = __builtin_amdgcn_mfma_f32_32x32x16_bf16(__builtin_bit_cast(bf16x8, vw), pf, o0, 0, 0, 0); }
          { const u32x2 va = *(const LAS u32x2*)(vb0 + 32 * VROW + koff), vb = *(const LAS u32x2*)(vb0 + 32 * VROW + koff + 16); const u32x4 vw = {va.x, va.y, vb.x, vb.y};
            o1 = __builtin_amdgcn_mfma_f32_32x32x16_bf16(__builtin_bit_cast(bf16x8, vw), pf, o1, 0, 0, 0); }
        }
      if (j + 1 < 36) ATT_STORE(cur ^ 1);
      __syncthreads();
    }
#undef ATT_LOAD
#undef ATT_STORE
    const float inv = 1.0f / (lsum + __shfl_xor(lsum, 32));
    bf16_t* op = O + (size_t)(b * SEQ + q) * 1024 + h * 64 + 4 * hf;
#pragma unroll
    for (int i = 0; i < 4; ++i) {
      u32x2 w; w.x = cvt_pk_bf16(o0[4 * i] * inv, o0[4 * i + 1] * inv); w.y = cvt_pk_bf16(o0[4 * i + 2] * inv, o0[4 * i + 3] * inv); *(u32x2*)(op + 8 * i) = w;
      w.x = cvt_pk_bf16(o1[4 * i] * inv, o1[4 * i + 1] * inv); w.y = cvt_pk_bf16(o1[4 * i + 2] * inv, o1[4 * i + 3] * inv); *(u32x2*)(op + 32 + 8 * i) = w;
    }
  }
}

__device__ __forceinline__ int wide_count(int sel) { return sel == 0 ? 752 : (sel == 3 ? 64 : 528); }
__device__ __forceinline__ ConvDesc wide_desc(const Params& p, int z, unsigned char* ws, int sel, int it) {
  ConvDesc d; int r = it; d.W2 = nullptr; d.sc = nullptr; d.kind = MAP_ID;
  if (sel == 3) { d.W = PIN(I_MWO); d.K = 1024; d.ld = 1024; d.dst = (bf16_t*)(ws + WS_WMO); }
  else { const int m = sel == 4 ? 3 : sel;
    if (r < 352) { d.kind = MAP_SWIGLU; d.W = PIN(I_FWI) + (size_t)m * 1024 * 5632; d.K = 1024; d.ld = 5632; d.dst = (bf16_t*)(ws + WS_WFI + m * SZ_WFI); }
    else if ((r -= 352) < 176) { d.W = PIN(I_FWO) + (size_t)m * 2816 * 1024; d.K = 2816; d.ld = 1024; d.dst = (bf16_t*)(ws + WS_WFO + m * SZ_WFO); }
    else if ((r -= 176) < 160) { d.W = PIN(I_EWI); d.K = 1024; d.ld = 2560; d.dst = (bf16_t*)(ws + WS_WEI); }
    else { r -= 160; d.W = PIN(I_EWO); d.K = 1024; d.ld = 1024; d.dst = (bf16_t*)(ws + WS_WEO); } }
  d.tile = r; return d;
}
__device__ __forceinline__ void conv_wide_list(LAS float* L, const Params& p, int z, unsigned char* ws, int sel, int t0, int tstride) {
  const int total = wide_count(sel); const int tid = ltid(); f32x4 cur[8], nxt[8];
  if (t0 < total) convw_load(wide_desc(p, z, ws, sel, t0), tid, cur);
#pragma unroll 1
  for (int it = t0; it < total; it += tstride) {
    const bool has = it + tstride < total;
    if (has) convw_load(wide_desc(p, z, ws, sel, it + tstride), tid, nxt);
    convw_store(L, wide_desc(p, z, ws, sel, it), tid, cur);
#pragma unroll
    for (int i = 0; i < 8; ++i) cur[i] = nxt[i];
  }
}
__device__ __forceinline__ int small_count(int sel) { return sel == 0 ? 256 : 736; }
__device__ __forceinline__ ConvDesc small_desc(const Params& p, int z, unsigned char* ws, int sel, int it) {
  ConvDesc d; int r = it; d.W2 = nullptr; d.sc = nullptr;
  if (sel == 0) { d.kind = MAP_RG; d.W = PIN(I_RAW); d.W2 = PIN(I_RXW); d.K = 512; d.ld = 0; d.dst = (bf16_t*)(ws + WS_WRG); }
  else if (r < 320) { d.kind = MAP_MLAIN; d.W = PIN(I_MWI); d.K = 1024; d.ld = 1056; d.dst = (bf16_t*)(ws + WS_WMI); }
  else if ((r -= 320) < 288) { d.kind = MAP_QUP; d.W = PIN(I_MWQ); d.sc = PIN(I_MQN); d.K = 768; d.ld = 1536; d.dst = (bf16_t*)(ws + WS_WQU); }
  else if ((r -= 288) < 64) { d.kind = MAP_KUP; d.W = PIN(I_MWKV); d.sc = PIN(I_MKVN); d.K = 256; d.ld = 2048; d.dst = (bf16_t*)(ws + WS_WKU); }
  else { r -= 64; d.kind = MAP_VUP; d.W = PIN(I_MWKV); d.sc = PIN(I_MKVN); d.K = 256; d.ld = 2048; d.dst = (bf16_t*)(ws + WS_WVU); }
  d.tile = r; return d;
}
__device__ __forceinline__ void conv_small_list(LAS float* L, const Params& p, int z, unsigned char* ws, int sel, int t0, int tstride) {
  const int total = small_count(sel); const int tid = ltid(); float cur[8], nxt[8];
  if (t0 < total) conv_load(small_desc(p, z, ws, sel, t0), tid, cur);
#pragma unroll 1
  for (int it = t0; it < total; it += tstride) {
    const bool has = it + tstride < total;
    if (has) conv_load(small_desc(p, z, ws, sel, it + tstride), tid, nxt);
    conv_store(L, small_desc(p, z, ws, sel, it), tid, cur);
#pragma unroll
    for (int i = 0; i < 8; ++i) cur[i] = nxt[i];
  }
}

#define XB_TMO      128
#define XB_XCNT(j)  (256  + 64 * (j))
#define XB_XSUB(j)  (1280 + 64 * (j))
#define XB_XGEN(j)  (2304 + 64 * (j))
#define XB_TOP      3328
#define XB_TOPGEN   3392
#define XCD_BAR_WORDS 3456
#define XB_SPIN_CAP (1u << 18)

__device__ __forceinline__ unsigned xb_ld(unsigned* p)              { return __hip_atomic_load(p, __ATOMIC_RELAXED, __HIP_MEMORY_SCOPE_AGENT); }
__device__ __forceinline__ unsigned xb_add(unsigned* p, unsigned v) { return __hip_atomic_fetch_add(p, v, __ATOMIC_RELAXED, __HIP_MEMORY_SCOPE_AGENT); }
__device__ __forceinline__ unsigned xb_xcc_id() { return (unsigned)__builtin_amdgcn_s_getreg((3 << 11) | 20) & 0xFu; }
#define XB_SPIN(cond, bar) do { unsigned _sp = 0; while (cond) { __builtin_amdgcn_s_sleep(1); \
    if ((++_sp & 255u) == 0u) { if (xb_ld(&(bar)[XB_TMO])) break; if (_sp > XB_SPIN_CAP) { atomicAdd(&(bar)[XB_TMO], 1u); break; } } } } while (0)

struct XcdBarrier {
    unsigned* bar; unsigned x;
    volatile LAS unsigned* st;
};

__device__ __forceinline__ XcdBarrier xcd_barrier_post(unsigned* bar, volatile LAS unsigned* st) {
    XcdBarrier b; b.bar = bar; b.x = xb_xcc_id(); b.st = st;
    if (threadIdx.x == 0) (void)xb_add(&bar[XB_XCNT(b.x)], 1u);
    return b;
}
__device__ __forceinline__ void xcd_barrier_complete(unsigned* bar, unsigned x, unsigned& nloc, unsigned& nx) {
    const unsigned G = gridDim.x * gridDim.y * gridDim.z;
    unsigned sum, cnt, mine, sp = 0u;
    for (;;) {
        sum = 0u; cnt = 0u; mine = 0u;
#pragma unroll
        for (unsigned j = 0; j < 16; ++j) { const unsigned c = xb_ld(&bar[XB_XCNT(j)]); sum += c; cnt += (c > 0u) ? 1u : 0u; mine = (j == x) ? c : mine; }
        if (sum == G) break;
        __builtin_amdgcn_s_sleep(1);
        if ((++sp & 255u) == 0u) { if (xb_ld(&bar[XB_TMO])) break; if (sp > XB_SPIN_CAP) { atomicAdd(&bar[XB_TMO], 1u); break; } }
    }
    nloc = mine > 0u ? mine : 1u; nx = cnt > 0u ? cnt : 1u;
}

__device__ __forceinline__ void xcd_barrier(const XcdBarrier& b) {
    asm volatile("s_waitcnt vmcnt(0)" ::: "memory");
    __syncthreads();
    if (threadIdx.x == 0) {
        unsigned* bar = b.bar;
        __builtin_amdgcn_s_waitcnt(0);
        unsigned nloc = b.st[0], nx = b.st[1];
        if (nloc == 0u) { xcd_barrier_complete(bar, b.x, nloc, nx); b.st[0] = nloc; b.st[1] = nx; }
        const unsigned old = xb_add(&bar[XB_XSUB(b.x)], 1u);
        const unsigned gen = old / nloc;
        if (old + 1u == (gen + 1u) * nloc) {
            __builtin_amdgcn_fence(__ATOMIC_RELEASE, "agent");
            asm volatile("s_waitcnt vmcnt(0)" ::: "memory");
            const unsigned og = xb_add(&bar[XB_TOP], 1u);
            const unsigned tg = og / nx;
            if (og + 1u == (tg + 1u) * nx) xb_add(&bar[XB_TOPGEN], 1u);
            else XB_SPIN(xb_ld(&bar[XB_TOPGEN]) == tg, bar);
            __builtin_amdgcn_fence(__ATOMIC_ACQUIRE, "agent");
            xb_add(&bar[XB_XGEN(b.x)], 1u);
            asm volatile("s_waitcnt vmcnt(0)" ::: "memory");
        } else {
            XB_SPIN(xb_ld(&bar[XB_XGEN(b.x)]) == gen, bar);
            __builtin_amdgcn_fence(__ATOMIC_ACQUIRE, "agent");
            asm volatile("s_waitcnt vmcnt(0)" ::: "memory");
        }
    }
    __syncthreads();
}


__device__ __forceinline__ unsigned char* launder_ptr(const void* q) { unsigned lo = (unsigned)(size_t)q, hi = (unsigned)((size_t)q >> 32); asm volatile("" : "+v"(lo), "+v"(hi));
  lo = __builtin_amdgcn_readfirstlane(lo); hi = __builtin_amdgcn_readfirstlane(hi); return (unsigned char*)(((size_t)hi << 32) | (size_t)lo); }
#define PHASE_BEGIN const int z = 0; unsigned char* ws = tabptr(35); float* xout = (float*)tabptr(34); (void)ws; (void)xout; (void)z
#define P_MOD ((float*)(ws + WS_MOD))
#define P_KF ((float*)(ws + WS_KF))
#define P_KFC ((float*)(ws + WS_KFC))
#define P_XCTX ((float*)(ws + WS_XCTX))
#define P_AGG ((float*)(ws + WS_AGG))
#define P_H ((bf16_t*)(ws + WS_H))
#define P_ACT ((bf16_t*)(ws + WS_ACT))
#define P_G ((bf16_t*)(ws + WS_G))
#define P_XC ((bf16_t*)(ws + WS_XC))
#define P_YT ((bf16_t*)(ws + WS_YT))
#define P_UT ((bf16_t*)(ws + WS_UT))
#define P_URG ((bf16_t*)(ws + WS_URG))
#define P_P ((bf16_t*)(ws + WS_P))
#define P_Q ((bf16_t*)(ws + WS_Q))
#define P_QN ((bf16_t*)(ws + WS_QN))
#define P_KVN ((bf16_t*)(ws + WS_KVN))
#define P_KR ((bf16_t*)(ws + WS_KR))
#define P_K ((bf16_t*)(ws + WS_K))
#define P_VT ((bf16_t*)(ws + WS_VT))
__global__ void __launch_bounds__(512) mk_fwd(Params p) {
  LAS unsigned char* lds = (LAS unsigned char*)lds_raw;
  const int G = gridDim.x, bid = blockIdx.x;
  if (threadIdx.x == 0) { LAS unsigned long long* tab = (LAS unsigned long long*)(lds + TAB_OFF);
#pragma unroll
    for (int i = 0; i < 34; ++i) tab[i] = (unsigned long long)(size_t)p.in[i];
    tab[34] = (unsigned long long)(size_t)p.out; tab[35] = (unsigned long long)(size_t)p.ws; }
  volatile LAS unsigned* bst = (volatile LAS unsigned*)(lds + LDS_BYTES - 16);
  if (threadIdx.x == 0) { bst[0] = 0u; bst[1] = 0u; }
  __syncthreads();
  if (p.ws == nullptr) cg::this_grid().sync();
  (void)xcd_barrier_post((unsigned*)(tabptr(35) + WS_BAR), bst);
#define GSYNC() do { XcdBarrier b_; b_.bar = (unsigned*)(tabptr(35) + WS_BAR); b_.x = xb_xcc_id(); b_.st = (volatile LAS unsigned*)(lds + LDS_BYTES - 16); xcd_barrier(b_); } while (0)

  PROBE_REP(1) {
    PHASE_BEGIN;
    LAS float* L = (LAS float*)lds;
    { bool first = true; for (int job = bid; job < 576; job += G) { adaln_job(L, p, z, P_MOD, job, first); first = false; } }
    for (int job = bid; job < 144; job += G) { if (job < 128) filter_job(L, p, z, P_KF, SEQ, job); else filter_job(L, p, z, P_KFC, CTXL, job - 128); }
    conv_wide_list(L, p, z, ws, 0, bid, G);
    conv_small_list(L, p, z, ws, 0, bid, G);
  }
  GSYNC();
  PROBE_REP(1) { PHASE_BEGIN; row_pass(PIN(I_X), PIN(I_CTX), nullptr, nullptr, nullptr, false, nullptr, nullptr, P_H, P_MOD, 0, NROW, nullptr, nullptr, 0.f, nullptr); }
  GSYNC();

  if (PROBE_MASK & 16) { for (int i = 0; i < 20; ++i) GSYNC(); }
#pragma unroll 1
  for (int st = 0; st < 6; ++st) {
    const int l = st / 3, k = st % 3;
    const int Mrows = (st >= 4) ? NLAT : NROW;
    int rsel;
    if (k != 1) {
      PROBE_REP(64) { PHASE_BEGIN; const int wi = l * 2 + (k == 0 ? 0 : 1);
        Gemm g; g.A = P_H; g.Bt = (const bf16_t*)(ws + WS_WFI + wi * SZ_WFI); g.M = Mrows; g.N = 5632; g.K = 1024; g.kn = 1024;
        StaticOrder S; S.init(g.M, g.N, G, bid); EpiSwiGLU E; E.O = P_ACT; gemm_phase<EpiSwiGLU, StaticOrder, false>(lds, g, S, E, nullptr);
        { PHASE_BEGIN; int wsel = -1, ssel = -1; if (st == 0) wsel = 1; else if (st == 2) wsel = 2; else if (st == 3) { wsel = 3; ssel = 1; }
          const int t0 = G == 256 ? bid - 48 : bid, ts = G == 256 ? 208 : G; LAS float* L = (LAS float*)lds;
          if (rep_ == 0 && t0 >= 0) { if (ssel >= 0) conv_small_list(L, p, z, ws, ssel, t0, ts); if (wsel >= 0) conv_wide_list(L, p, z, ws, wsel, t0, ts); } } }
      GSYNC();
      rsel = 0;
    } else if (l == 0) {
      PROBE_REP(128)
#pragma unroll 1
      for (int gi = 0; gi < 2; ++gi) {
        PHASE_BEGIN; Gemm g; EpiBf16P E; int c;
        if (gi == 0) { g.A = (const bf16_t*)(ws + WS_WEI); g.Bt = P_H; g.M = 1536; g.N = NROW; g.K = 1024; g.kn = 1024; E.O = P_UT; E.ldc = NROW; c = bid; }
        else { g.A = P_H; g.Bt = (const bf16_t*)(ws + WS_WEI) + (size_t)1536 * 1024; g.M = NROW; g.N = 1024; g.K = 1024; g.kn = 1024; E.O = P_URG; E.ldc = 1024; c = (bid + G - (432 % G)) % G; }
        StaticOrder S; S.init(g.M, g.N, G, c); gemm_phase<EpiBf16P, StaticOrder, false>(lds, g, S, E, nullptr);
      }
      GSYNC();
      PROBE_REP(2) { PHASE_BEGIN; xc_build(p, z, P_URG, P_XC);
#pragma unroll 1
        for (int u = bid; u < 1024; u += G) { const bool lat = u < 512; hyena_unit(lds, p, z, P_UT, lat ? P_KF : P_KFC, P_YT, lat ? u : u - 512, lat ? SEQ : CTXL, lat ? 0 : NLAT); } }
      GSYNC();
      PROBE_REP(4) { PHASE_BEGIN;
        for (int job = bid; job < 8 * SC_NC; job += G) { const int tid = ltid(); u32x4 xr[4]; scan_xc_load(P_XC, job, tid, xr); scan_pass_a(lds, p, z, P_XC, (const bf16_t*)(ws + WS_WRG), (unsigned*)P_G, P_AGG, job, tid, xr); }
        for (int job = bid; job < 8 * (NROW / 64); job += G) yt_transpose(lds, P_YT, P_H, job); }
      GSYNC();
      PROBE_REP(4) { PHASE_BEGIN; for (int job = bid; job < 8 * SC_NC; job += G) scan_pass_b(lds, (const unsigned*)P_G, P_URG, P_AGG, P_H, job); }
      GSYNC();
      rsel = 1;
    } else {
      PROBE_REP(256) { PHASE_BEGIN; Gemm g; g.A = P_H; g.Bt = (const bf16_t*)(ws + WS_WMI); g.M = NROW; g.N = 1280; g.K = 1024; g.kn = 1024; EpiBf16P E; E.O = P_P; E.ldc = 1280;
        StaticOrder S; S.init(g.M, g.N, G, bid); gemm_phase<EpiBf16P, StaticOrder, false>(lds, g, S, E, nullptr);
        { PHASE_BEGIN; const int t0 = G == 256 ? bid - 104 : bid, ts = G == 256 ? 152 : G; if (rep_ == 0 && t0 >= 0) conv_wide_list((LAS float*)lds, p, z, ws, 4, t0, ts); } }
      GSYNC();
      { PHASE_BEGIN; mla_rownorm(P_P, P_QN, P_KVN, P_KR); }
      GSYNC();
      PROBE_REP(256) { PHASE_BEGIN; Gemm g; g.A = P_QN; g.Bt = (const bf16_t*)(ws + WS_WQU); g.M = NLAT; g.N = 1536; g.K = 768; g.kn = 768; EpiQ E; E.O = P_Q;
        StaticOrder S; S.init(g.M, g.N, G, bid); gemm_phase<EpiQ, StaticOrder, false>(lds, g, S, E, nullptr); }
      PROBE_REP(256)
#pragma unroll 1
      for (int gi = 0; gi < 2; ++gi) {
        PHASE_BEGIN; Gemm g; EpiBf16P E; int c;
        if (gi == 0) { g.A = P_KVN; g.Bt = (const bf16_t*)(ws + WS_WKU); g.M = NROW; g.N = 1024; g.K = 256; g.kn = 256; E.O = P_K; E.ldc = 1024; c = (bid + G - (384 % G)) % G; }
        else { g.A = (const bf16_t*)(ws + WS_WVU); g.Bt = P_KVN; g.M = 1024; g.N = NROW; g.K = 256; g.kn = 256; E.O = P_VT; E.ldc = NROW; c = (bid + G - ((384 + 288) % G)) % G; }
        StaticOrder S; S.init(g.M, g.N, G, c); gemm_phase<EpiBf16P, StaticOrder, false>(lds, g, S, E, nullptr);
      }
      GSYNC();
      PROBE_REP(8) { PHASE_BEGIN; attn_phase(lds, P_Q, P_K, P_KR, P_VT, P_H); }
      GSYNC();
      rsel = 2;
    }
    PROBE_REP(512) { PHASE_BEGIN; Gemm g; EpiResid E; g.M = NLAT; g.N = 1024; E.Y2 = P_XC; E.mod = P_MOD + (size_t)l * 9 * 9216;
      if (rsel == 0) { g.A = P_ACT; g.Bt = (const bf16_t*)(ws + WS_WFO + (l * 2 + (k == 0 ? 0 : 1)) * SZ_WFO); g.K = 2816; g.kn = 2816; E.gidx = k == 0 ? 2 : 8; E.gs = 0.5f; }
      else if (rsel == 1) { g.A = P_H; g.Bt = (const bf16_t*)(ws + WS_WEO); g.K = 1024; g.kn = 1024; E.gidx = 5; E.gs = 1.0f; }
      else { g.A = P_H; g.Bt = (const bf16_t*)(ws + WS_WMO); g.K = 1024; g.kn = 1024; E.gidx = 5; E.gs = 1.0f; }
      StaticOrder S; S.init(g.M, g.N, G, bid); gemm_phase<EpiResid, StaticOrder, false>(lds, g, S, E, nullptr); }
    if (Mrows == NROW) {
#pragma unroll 1
      for (int s = 0; s < 4; ++s) { PHASE_BEGIN; Gemm g; EpiF32 E; int kt0, ktn; const bf16_t* A; const bf16_t* B;
        if (rsel == 0) { kt0 = s < 2 ? 12 * s : 24 + 10 * (s - 2); ktn = s < 2 ? 12 : 10; A = P_ACT; B = (const bf16_t*)(ws + WS_WFO + (l * 2 + (k == 0 ? 0 : 1)) * SZ_WFO); g.K = 2816; }
        else { kt0 = 4 * s; ktn = 4; A = P_H; B = (const bf16_t*)(ws + WS_WEO); g.K = 1024; }
        g.A = A + (size_t)NLAT * g.K + kt0 * 64; g.Bt = B + kt0 * 64; g.M = NCTX; g.N = 1024; g.kn = ktn * 64;
        E.C = (float*)(ws + WS_G) + (size_t)s * NCTX * D; E.ldc = D; E.bias = nullptr;
        StaticOrder S; S.init(g.M, g.N, G, (bid + G - ((128 + 32 * s) % G)) % G); gemm_phase<EpiF32, StaticOrder, false>(lds, g, S, E, nullptr); }
    }
    GSYNC();
    { PHASE_BEGIN; const float* lg = PIN(I_LNG) + (size_t)(l * 3 + k) * D; const float* lb = PIN(I_LNB) + (size_t)(l * 3 + k) * D;
      const bool hw = st < 5; const float* modn = P_MOD + (size_t)((k < 2) ? l : l + 1) * 9 * 9216; const int sidx = (k < 2) ? 3 * k + 3 : 0;
      const int gidx = k == 0 ? 2 : (k == 1 ? 5 : 8); const float* gate8 = P_MOD + (size_t)l * 9 * 9216 + (size_t)(8 * 9 + gidx) * D;
      _Float16* x16a = (_Float16*)xout; _Float16* x16b = (_Float16*)(ws + WS_G);
      row_pass(PIN(I_X), PIN(I_CTX), st == 0 ? nullptr : (st == 5 ? x16b : x16a), st < 4 ? x16a : (st == 4 ? x16b : nullptr), st == 5 ? xout : nullptr, true, lg, lb, hw ? P_H : nullptr, modn, sidx, Mrows, Mrows == NROW ? (const float*)(ws + WS_G) : nullptr, gate8, k == 1 ? 1.0f : 0.5f, P_XC); }
    if (st < 5) GSYNC();
  }
}

extern "C" void kernel_launch(void* const* d_in, const int* in_sizes, int n_in, void* d_out, int out_size, void* d_ws, size_t ws_size, hipStream_t stream) {
  static int grid_blocks = 0;
  if (!grid_blocks) {
    int dev = 0, cus = 0, per_cu = 0;
    if (n_in != 34 || out_size != NLAT * D || ws_size < WS_END) { fprintf(stderr, "kernel_launch: unexpected problem (n_in %d out %d ws %zu need %zu)\n", n_in, out_size, ws_size, (size_t)WS_END); grid_blocks = -1; return; }
    (void)hipGetDevice(&dev);
    (void)hipDeviceGetAttribute(&cus, hipDeviceAttributeMultiprocessorCount, dev);
    (void)hipFuncSetAttribute((const void*)mk_fwd, hipFuncAttributeMaxDynamicSharedMemorySize, LDS_BYTES);
    (void)hipOccupancyMaxActiveBlocksPerMultiprocessor(&per_cu, (const void*)mk_fwd, 512, LDS_BYTES);
    if (per_cu < 1 || cus < 1) { fprintf(stderr, "kernel_launch: occupancy %d cus %d\n", per_cu, cus); grid_blocks = -1; return; }
    grid_blocks = cus;
  }
  if (grid_blocks < 0) return;
  Params p{};
  for (int i = 0; i < 34; ++i) p.in[i] = (const float*)d_in[i];
  p.out = (float*)d_out; p.ws = (unsigned char*)d_ws;
  if (hipMemsetAsync((unsigned char*)d_ws + WS_BAR, 0, 16384, stream) != hipSuccess) { fprintf(stderr, "kernel_launch: memset of the barrier words failed\n"); return; }
  void* args[] = {&p};
  hipError_t e = hipLaunchCooperativeKernel((const void*)mk_fwd, dim3(grid_blocks), dim3(512), args, LDS_BYTES, stream);
  if (e != hipSuccess) fprintf(stderr, "cooperative launch failed: %s (grid %d)\n", hipGetErrorString(e), grid_blocks);
}
```

```cpp
#include <hip/hip_runtime.h>
namespace pg8 {
#define PG8_LAS __attribute__((address_space(3)))
typedef unsigned short bf16_t;
typedef short bf16x8 __attribute__((ext_vector_type(8)));
typedef float f32x4 __attribute__((ext_vector_type(4)));
typedef unsigned u32x4 __attribute__((ext_vector_type(4)));
constexpr int BM = 256, BK = 64, HALF = 128, HTB = HALF * BK * 2  , STAGE_BYTES = 8 * HTB, NXCD = 8, WGM = 8;

__host__ __device__ __forceinline__ int lds_byte(int r, int c) { const int st = (r >> 4) * 2 + (c >> 5), rr = r & 15, cc = c & 31, ob = rr * 64 + cc * 2; return st * 1024 + (ob ^ (((ob >> 9) & 1) << 5)); }
__host__ __device__ __forceinline__ void stage_rc(int b, int& R, int& C) { const int st = b / 1024, sb = b % 1024, swz = sb ^ (((sb >> 9) & 1) << 5); R = (st >> 1) * 16 + swz / 64; C = (st & 1) * 32 + (swz % 64) / 2; }
__host__ __device__ __forceinline__ int perm32(int rho) { const int n = rho >> 4, i = rho & 15; return 8 * (i >> 2) + 4 * n + (i & 3); }

struct Unit { int pm, pn; };
struct Gemm { const bf16_t* A; const bf16_t* Bt; int M, N, K, kn; };

struct StaticOrder {
    int nM, nN, nwg, G, c;
    __host__ __device__ void init(int M, int N, int G_, int c_) { nM = M / BM; nN = N / BM; nwg = nM * nN; G = G_; c = c_; }
    __host__ __device__ bool next(int i, Unit& u) const {
        const long L = (long)i * G + c; if (L >= nwg) return false;
        int wgid = (int)L; { const int q = nwg / NXCD, r = nwg % NXCD, xcd = wgid % NXCD, off = wgid / NXCD; wgid = (xcd < r ? xcd * (q + 1) : r * (q + 1) + (xcd - r) * q) + off; }
        const int nig = WGM * nN, gid = wgid / nig, fm = gid * WGM, gsz = (nM - fm) < WGM ? (nM - fm) : WGM;
        u.pm = fm + ((wgid % nig) % gsz); u.pn = (wgid % nig) / gsz; return true;
    }
    __device__ __forceinline__ void a_ready(const Unit&) const {}
    __device__ __forceinline__ void done(const Unit&) const {}
};
struct CountedOrder : StaticOrder {
    const unsigned* ready; unsigned need; unsigned* tmo;
    __device__ __forceinline__ void a_ready(const Unit& u) const {
        if (threadIdx.x < 64) {
            const unsigned long long t0 = __builtin_amdgcn_s_memrealtime(); unsigned polls = 0;
            while ((unsigned)__builtin_amdgcn_readfirstlane(__hip_atomic_load(ready + 64 * u.pm, __ATOMIC_RELAXED, __HIP_MEMORY_SCOPE_AGENT)) < need) {
                if ((++polls & 255u) == 0u && __builtin_amdgcn_readfirstlane(__hip_atomic_load(tmo, __ATOMIC_RELAXED, __HIP_MEMORY_SCOPE_AGENT)) != 0u) break;
                if (__builtin_amdgcn_s_memrealtime() - t0 > 2000000ull) {
                    if (threadIdx.x == 0) { unsigned expect = 0u; __hip_atomic_compare_exchange_strong(tmo + 1, &expect, 0x600u | (unsigned)(u.pm & 0xff), __ATOMIC_RELAXED, __ATOMIC_RELAXED, __HIP_MEMORY_SCOPE_AGENT); __hip_atomic_store(tmo, 1u, __ATOMIC_RELAXED, __HIP_MEMORY_SCOPE_AGENT); }
                    break; }
                __builtin_amdgcn_s_sleep(2); }
            __builtin_amdgcn_fence(__ATOMIC_ACQUIRE, "agent");
            asm volatile("s_waitcnt vmcnt(0)" ::: "memory");
        }
#if !defined(BROKEN_HOOK_NO_BARRIER)
        asm volatile("" ::: "memory"); __builtin_amdgcn_s_barrier(); asm volatile("" ::: "memory");
#endif
    }
};

__device__ __forceinline__ unsigned cvt_pk_bf16(float lo, float hi) { unsigned r; asm volatile("v_cvt_pk_bf16_f32 %0, %1, %2" : "=v"(r) : "v"(lo), "v"(hi)); return r; }
typedef float f32x2 __attribute__((ext_vector_type(2)));
__device__ __forceinline__ f32x2 gelu_pk(f32x2 v) {
    const f32x2 av = __builtin_elementwise_abs(v), d = av * 0.2316418882f + 1.0f;
    f32x2 t; t.x = __builtin_amdgcn_rcpf(d.x); t.y = __builtin_amdgcn_rcpf(d.y);
    f32x2 q = t * 0.5307027145f + (-0.7265760135f); q = q * t + 0.7107068705f; q = q * t + (-0.142248368f); q = q * t + 0.127414796f; q = q * t;
    const f32x2 s = (v * v) * (-0.72134752044f);
    f32x2 e; e.x = __builtin_amdgcn_exp2f(s.x); e.y = __builtin_amdgcn_exp2f(s.y);
    const f32x2 m = v * (q * e), r = v - m;
    f32x2 o; o.x = v.x < 0.f ? m.x : r.x; o.y = v.y < 0.f ? m.y : r.y; return o;
}

struct EpiF32 {
    static constexpr bool PERM = false, AFTER_DRAIN = false;
    float* C; int ldc; const float* bias;
    __device__ __forceinline__ void operator()(const f32x4 (&acc)[2][2][4][2], const Unit& u, int wr, int wc, int fr, int fq) const {
        const int row0 = u.pm * BM + wr * 64 + fr, col0 = u.pn * BM + wc * 32 + 4 * fq;
        f32x4 bv[2][2];
#pragma unroll
        for (int bj = 0; bj < 2; ++bj)
#pragma unroll
            for (int n = 0; n < 2; ++n) bv[bj][n] = bias ? *(const f32x4*)(bias + col0 + bj * HALF + n * 16) : (f32x4){0.f, 0.f, 0.f, 0.f};
#pragma unroll
        for (int ai = 0; ai < 2; ++ai)
#pragma unroll
            for (int m = 0; m < 4; ++m) { float* rowp = C + (size_t)(row0 + ai * HALF + m * 16) * ldc + col0;
#pragma unroll
                for (int bj = 0; bj < 2; ++bj)
#pragma unroll
                    for (int n = 0; n < 2; ++n) *(f32x4*)(rowp + bj * HALF + n * 16) = acc[ai][bj][m][n] + bv[bj][n]; }
    }
};
template <int ACT  > struct EpiBf16 {
    static constexpr bool PERM = true, AFTER_DRAIN = false;
    bf16_t* O; int ldc; const float* bias; int split_cols; size_t split_stride;
    __device__ __forceinline__ void operator()(const f32x4 (&acc)[2][2][4][2], const Unit& u, int wr, int wc, int fr, int fq) const {
        const int row0 = u.pm * BM + wr * 64 + fr; int colt = u.pn * BM; bf16_t* base = O;
        if (split_cols) { const int t = colt / split_cols; base += (size_t)t * split_stride; colt -= t * split_cols; }
        const int col0 = colt + wc * 32 + 8 * fq, bcol0 = u.pn * BM + wc * 32 + 8 * fq;
        f32x4 bv[2][2];
#pragma unroll
        for (int bj = 0; bj < 2; ++bj)
#pragma unroll
            for (int n = 0; n < 2; ++n) bv[bj][n] = bias ? *(const f32x4*)(bias + bcol0 + bj * HALF + 4 * n) : (f32x4){0.f, 0.f, 0.f, 0.f};
#pragma unroll
        for (int ai = 0; ai < 2; ++ai)
#pragma unroll
            for (int m = 0; m < 4; ++m) { bf16_t* rowp = base + (size_t)(row0 + ai * HALF + m * 16) * ldc + col0;
#pragma unroll
                for (int bj = 0; bj < 2; ++bj) { f32x4 v0 = acc[ai][bj][m][0] + bv[bj][0], v1 = acc[ai][bj][m][1] + bv[bj][1];
                    if (ACT == 1) { f32x2 a = gelu_pk((f32x2){v0[0], v0[1]}), b = gelu_pk((f32x2){v0[2], v0[3]}), c = gelu_pk((f32x2){v1[0], v1[1]}), d = gelu_pk((f32x2){v1[2], v1[3]});
                        v0 = (f32x4){a.x, a.y, b.x, b.y}; v1 = (f32x4){c.x, c.y, d.x, d.y}; }
                    if (ACT == 2) {
#pragma unroll
                        for (int j = 0; j < 4; ++j) { v0[j] = 0.5f * v0[j] * (1.0f + erff(v0[j] * 0.70710678f)); v1[j] = 0.5f * v1[j] * (1.0f + erff(v1[j] * 0.70710678f)); } }
                    u32x4 w; w.x = cvt_pk_bf16(v0[0], v0[1]); w.y = cvt_pk_bf16(v0[2], v0[3]); w.z = cvt_pk_bf16(v1[0], v1[1]); w.w = cvt_pk_bf16(v1[2], v1[3]);
                    *(u32x4*)(rowp + bj * HALF) = w; } }
    }
};

struct PanelStats {
    unsigned* xbuf;
    unsigned* cnt;
    unsigned* tmo;
    int ntn; float eps;
    unsigned code;
    __device__ __forceinline__ bool run(const f32x4 (&v)[2][2][4][2], const Unit& u, int wr, int wc, int fr, int fq, PG8_LAS unsigned char* lds, int wid, int lane) const {
        typedef float f32x2v __attribute__((ext_vector_type(2)));
        PG8_LAS f32x2v* P = (PG8_LAS f32x2v*)lds;
        PG8_LAS f32x2v* S = (PG8_LAS f32x2v*)(lds + 8192);
        PG8_LAS unsigned* flag = (PG8_LAS unsigned*)(lds + 8192 + 2048);
#pragma unroll
        for (int ai = 0; ai < 2; ++ai)
#pragma unroll
            for (int m = 0; m < 4; ++m) {
                float s = 0.f;
#pragma unroll
                for (int bj = 0; bj < 2; ++bj)
#pragma unroll
                    for (int n = 0; n < 2; ++n) { const f32x4 x = v[ai][bj][m][n]; s += (x[0] + x[1]) + (x[2] + x[3]); }
                s += __shfl_xor(s, 16); s += __shfl_xor(s, 32);
                const float mw = s * (1.0f / 64.0f); float q = 0.f;
#pragma unroll
                for (int bj = 0; bj < 2; ++bj)
#pragma unroll
                    for (int n = 0; n < 2; ++n) { const f32x4 d = v[ai][bj][m][n] - mw; q += (d[0] * d[0] + d[1] * d[1]) + (d[2] * d[2] + d[3] * d[3]); }
                q += __shfl_xor(q, 16); q += __shfl_xor(q, 32);
                if (fq == 0) P[(ai * HALF + wr * 64 + m * 16 + fr) * 4 + wc] = (f32x2v){mw, q};
            }
        asm volatile("s_waitcnt lgkmcnt(0)" ::: "memory"); __builtin_amdgcn_s_barrier(); asm volatile("" ::: "memory");
#if defined(BROKEN_NO_WAIT)
        if (blockIdx.x >= 64) { const long long t0 = clock64(); while (clock64() - t0 < 60000) __builtin_amdgcn_s_sleep(8); }
#endif
        const int row = wid * 32 + (lane & 31);
        if (lane < 32) {
            const f32x2v a = P[row * 4 + 0], b = P[row * 4 + 1], c = P[row * 4 + 2], d = P[row * 4 + 3];
            const float mt = (a.x + b.x + c.x + d.x) * 0.25f;
            const float da = a.x - mt, db = b.x - mt, dc = c.x - mt, dd = d.x - mt;
            const float m2 = (a.y + b.y) + (c.y + d.y) + 64.0f * ((da * da + db * db) + (dc * dc + dd * dd));
            unsigned long long* slot = (unsigned long long*)xbuf + ((size_t)(u.pm * BM + row) * 4 + u.pn);
            __hip_atomic_store(slot, ((unsigned long long)__float_as_uint(m2) << 32) | __float_as_uint(mt), __ATOMIC_RELAXED, __HIP_MEMORY_SCOPE_AGENT);
        }
        asm volatile("s_waitcnt vmcnt(0)" ::: "memory");
        if (lane == 0) __hip_atomic_fetch_add(cnt + 64 * u.pm, 1u, __ATOMIC_RELAXED, __HIP_MEMORY_SCOPE_AGENT);
        if (wid == 0) {
            bool dead = false; const unsigned long long t0 = __builtin_amdgcn_s_memrealtime(); const unsigned want = 8u * (unsigned)ntn;
            for (;;) {
#if defined(BROKEN_NO_WAIT)
                break;
#endif
                if ((unsigned)__builtin_amdgcn_readfirstlane(__hip_atomic_load(cnt + 64 * u.pm, __ATOMIC_RELAXED, __HIP_MEMORY_SCOPE_AGENT)) >= want) break;
                if (__builtin_amdgcn_s_memrealtime() - t0 > 2000000ull) {
                    if (lane == 0) { unsigned expect = 0u; __hip_atomic_compare_exchange_strong(tmo + 1, &expect, code | (unsigned)(u.pm & 0xff), __ATOMIC_RELAXED, __ATOMIC_RELAXED, __HIP_MEMORY_SCOPE_AGENT);
                                     __hip_atomic_store(tmo, 1u, __ATOMIC_RELAXED, __HIP_MEMORY_SCOPE_AGENT); }
                    dead = true; break; }
                __builtin_amdgcn_s_sleep(2);
            }
            __builtin_amdgcn_fence(__ATOMIC_ACQUIRE, "agent");
            if (lane == 0) flag[0] = dead ? 1u : 0u;
        }
        asm volatile("s_waitcnt vmcnt(0) lgkmcnt(0)" ::: "memory"); __builtin_amdgcn_s_barrier(); asm volatile("" ::: "memory");
        const bool bad = flag[0] != 0u;
        if (lane < 32) {
            const unsigned long long* slot = (const unsigned long long*)xbuf + (size_t)(u.pm * BM + row) * 4; float mt[4], m2[4]; float ms = 0.f;
#pragma unroll
            for (int t = 0; t < 4; ++t) { if (t < ntn) { const unsigned long long w = __hip_atomic_load(slot + t, __ATOMIC_RELAXED, __HIP_MEMORY_SCOPE_AGENT); mt[t] = __uint_as_float((unsigned)w); m2[t] = __uint_as_float((unsigned)(w >> 32)); } else { mt[t] = 0.f; m2[t] = 0.f; } ms += mt[t]; }
            const float mean = ms / (float)ntn; float q = 0.f;
#pragma unroll
            for (int t = 0; t < 4; ++t) if (t < ntn) { const float dm = mt[t] - mean; q += m2[t] + 256.0f * dm * dm; }
            S[row] = (f32x2v){mean, 1.0f / sqrtf(q / (256.0f * (float)ntn) + eps)};
        }
        asm volatile("s_waitcnt lgkmcnt(0)" ::: "memory"); __builtin_amdgcn_s_barrier(); asm volatile("" ::: "memory");
        return bad;
    }
};
struct EpiLnRes {
    static constexpr bool PERM = false, AFTER_DRAIN = true;
    const float* base; float* out; int ldc; const float* bias; PanelStats st; unsigned poison;
    __device__ __forceinline__ void refuse(size_t i0, size_t stride, int M, int N) const { const float q = __builtin_nanf(""); for (size_t i = i0; i < (size_t)M * N; i += stride) out[(i / N) * ldc + i % N] = q;
        if (i0 == 0) { unsigned expect = 0u; __hip_atomic_compare_exchange_strong(st.tmo + 1, &expect, 0x7f0u, __ATOMIC_RELAXED, __ATOMIC_RELAXED, __HIP_MEMORY_SCOPE_AGENT); __hip_atomic_store(st.tmo, 1u, __ATOMIC_RELAXED, __HIP_MEMORY_SCOPE_AGENT); } }
    __device__ __forceinline__ void fused(f32x4 (&acc)[2][2][4][2], const Unit& u, int wr, int wc, int fr, int fq, PG8_LAS unsigned char* lds, int wid, int lane) const {
        typedef float f32x2v __attribute__((ext_vector_type(2)));
        const PG8_LAS f32x2v* S = (const PG8_LAS f32x2v*)(lds + 8192);
        const int col0 = u.pn * BM + wc * 32 + 4 * fq;
#pragma unroll
        for (int bj = 0; bj < 2; ++bj)
#pragma unroll
            for (int n = 0; n < 2; ++n) { const f32x4 bv = bias ? *(const f32x4*)(bias + col0 + bj * HALF + n * 16) : (f32x4){0.f, 0.f, 0.f, 0.f};
#pragma unroll
                for (int ai = 0; ai < 2; ++ai)
#pragma unroll
                    for (int m = 0; m < 4; ++m) acc[ai][bj][m][n] += bv; }
        const bool bad = st.run(acc, u, wr, wc, fr, fq, lds, wid, lane) || poison != 0u;
        const float qnan = __builtin_nanf("");
#pragma unroll
        for (int ai = 0; ai < 2; ++ai)
#pragma unroll
            for (int m = 0; m < 4; ++m) { const int r = ai * HALF + wr * 64 + m * 16 + fr; const f32x2v sr = S[r]; const size_t off = (size_t)(u.pm * BM + r) * ldc + col0;
#pragma unroll
                for (int bj = 0; bj < 2; ++bj)
#pragma unroll
                    for (int n = 0; n < 2; ++n) { const f32x4 bs = *(const f32x4*)(base + off + bj * HALF + n * 16); f32x4 o = bs + (acc[ai][bj][m][n] - sr.x) * sr.y;
                        if (bad) o = (f32x4){qnan, qnan, qnan, qnan}; *(f32x4*)(out + off + bj * HALF + n * 16) = o; }
                asm volatile("" ::: "memory"); }
    }
};
struct EpiLnResLn {
    static constexpr bool PERM = false, AFTER_DRAIN = true;
    const float* base; float* out; bf16_t* xn; int ldc; const float* bias; PanelStats st1, st2; unsigned poison;
    __device__ __forceinline__ void refuse(size_t i0, size_t stride, int M, int N) const { const float q = __builtin_nanf(""); for (size_t i = i0; i < (size_t)M * N; i += stride) { const size_t o = (i / N) * ldc + i % N; out[o] = q; xn[o] = (bf16_t)0x7fc0u; }
        if (i0 == 0) { unsigned expect = 0u; __hip_atomic_compare_exchange_strong(st1.tmo + 1, &expect, 0x7f0u, __ATOMIC_RELAXED, __ATOMIC_RELAXED, __HIP_MEMORY_SCOPE_AGENT); __hip_atomic_store(st1.tmo, 1u, __ATOMIC_RELAXED, __HIP_MEMORY_SCOPE_AGENT); } }
    __device__ __forceinline__ void fused(f32x4 (&acc)[2][2][4][2], const Unit& u, int wr, int wc, int fr, int fq, PG8_LAS unsigned char* lds, int wid, int lane) const {
        typedef float f32x2v __attribute__((ext_vector_type(2))); typedef unsigned u32x2v __attribute__((ext_vector_type(2)));
        const PG8_LAS f32x2v* S = (const PG8_LAS f32x2v*)(lds + 8192);
        const int col0 = u.pn * BM + wc * 32 + 4 * fq;
#pragma unroll
        for (int bj = 0; bj < 2; ++bj)
#pragma unroll
            for (int n = 0; n < 2; ++n) { const f32x4 bv = bias ? *(const f32x4*)(bias + col0 + bj * HALF + n * 16) : (f32x4){0.f, 0.f, 0.f, 0.f};
#pragma unroll
                for (int ai = 0; ai < 2; ++ai)
#pragma unroll
                    for (int m = 0; m < 4; ++m) acc[ai][bj][m][n] += bv; }
        bool bad = st1.run(acc, u, wr, wc, fr, fq, lds, wid, lane) || poison != 0u;
        const float qnan = __builtin_nanf("");
#pragma unroll
        for (int ai = 0; ai < 2; ++ai)
#pragma unroll
            for (int m = 0; m < 4; ++m) { const int r = ai * HALF + wr * 64 + m * 16 + fr; const f32x2v sr = S[r]; const size_t off = (size_t)(u.pm * BM + r) * ldc + col0;
#pragma unroll
                for (int bj = 0; bj < 2; ++bj)
#pragma unroll
                    for (int n = 0; n < 2; ++n) { const f32x4 bs = *(const f32x4*)(base + off + bj * HALF + n * 16); acc[ai][bj][m][n] = bs + (acc[ai][bj][m][n] - sr.x) * sr.y; }
                asm volatile("" : "+v"(acc[ai][0][m][0]), "+v"(acc[ai][0][m][1]), "+v"(acc[ai][1][m][0]), "+v"(acc[ai][1][m][1]));
                if (m & 1) asm volatile("" ::: "memory"); }
        const bool bad1 = bad;
        bad = st2.run(acc, u, wr, wc, fr, fq, lds, wid, lane) || bad;
#pragma unroll
        for (int ai = 0; ai < 2; ++ai)
#pragma unroll
            for (int m = 0; m < 4; ++m) { const int r = ai * HALF + wr * 64 + m * 16 + fr; const f32x2v sr = S[r]; const size_t off = (size_t)(u.pm * BM + r) * ldc + col0;
#pragma unroll
                for (int bj = 0; bj < 2; ++bj)
#pragma unroll
                    for (int n = 0; n < 2; ++n) { const f32x4 x1 = acc[ai][bj][m][n]; *(f32x4*)(out + off + bj * HALF + n * 16) = bad1 ? (f32x4){qnan, qnan, qnan, qnan} : x1;
                        const f32x4 o = (x1 - sr.x) * sr.y; u32x2v w; w.x = cvt_pk_bf16(o[0], o[1]); w.y = cvt_pk_bf16(o[2], o[3]);
                        if (bad) { w.x = 0x7fc07fc0u; w.y = 0x7fc07fc0u; } *(u32x2v*)(xn + off + bj * HALF + n * 16) = w; }
                asm volatile("" ::: "memory"); }
    }
};

template <class Epi, class Sched, bool STAMP = false>
__device__ __forceinline__ void gemm_phase(PG8_LAS unsigned char* lds, const Gemm g, const Sched& S, const Epi& E, unsigned long long* stamps) {
    int tid_l = threadIdx.x; asm volatile("" : "+v"(tid_l));
    const int tid = tid_l, wid = __builtin_amdgcn_readfirstlane(tid >> 6), lane = tid & 63, wr = wid >> 2, wc = wid & 3, fr = lane & 15, fq = lane >> 4;
    const int K = g.K, nt = g.kn / BK;
    int ts_lo = 0, ts_hi = 0, nts = 0; const unsigned long long rt_entry = STAMP ? (unsigned long long)wall_clock64() : 0ull;
#define PG8_STAMP() do { if (STAMP && wid == 0 && nts < 64) { const unsigned long long _c = (unsigned long long)clock64(); \
        ts_lo = (lane == nts) ? (int)(unsigned)_c : ts_lo; ts_hi = (lane == nts) ? (int)(unsigned)(_c >> 32) : ts_hi; ++nts; } } while (0)
    PG8_STAMP();
    unsigned voffA[2], voffB[2];
#pragma unroll
    for (int i = 0; i < 2; ++i) { int R, C; stage_rc(tid * 16 + i * 8192, R, C); const int Rb = Epi::PERM ? ((R & ~31) + perm32(R & 31)) : R;
        voffA[i] = (unsigned)(R * K + C) * 2u; voffB[i] = (unsigned)(Rb * K + C) * 2u; }
    const size_t kstep = (size_t)(BK * 2);
    const size_t hstep = (size_t)HALF * K * 2;
    const size_t tstep = 2 * hstep;
    const unsigned ldsw = (unsigned)wid * 1024u;
    const int aoff = lds_byte(wr * 64 + fr, fq * 8), boff = lds_byte(wc * 32 + fr, fq * 8);
#define PG8_SA(b, h) (((b) * 2 + (h)) * HTB)
#define PG8_SB(b, h) ((4 + (b) * 2 + (h)) * HTB)
#define PG8_STAGE(bufoff, gbase, voff) do { _Pragma("unroll") for (int _i = 0; _i < 2; ++_i) \
        __builtin_amdgcn_global_load_lds((const unsigned*)((const char*)(gbase) + (voff)[_i]), (PG8_LAS unsigned*)(lds + (bufoff) + ldsw + _i * 8192), 16, 0, 0); } while (0)
#define PG8_LDA(dst, b, h) do { _Pragma("unroll") for (int m = 0; m < 4; ++m) _Pragma("unroll") for (int k = 0; k < 2; ++k) dst[m][k] = *(const PG8_LAS bf16x8*)(lds + PG8_SA(b, h) + aoff + m * 2048 + k * 1024); } while (0)
#define PG8_LDB(dst, b, h) do { _Pragma("unroll") for (int n = 0; n < 2; ++n) _Pragma("unroll") for (int k = 0; k < 2; ++k) dst[n][k] = *(const PG8_LAS bf16x8*)(lds + PG8_SB(b, h) + boff + n * 2048 + k * 1024); } while (0)
#define PG8_MMA(ai, bj, At, Bt) do { __builtin_amdgcn_s_setprio(1); _Pragma("unroll") for (int m = 0; m < 4; ++m) _Pragma("unroll") for (int n = 0; n < 2; ++n) _Pragma("unroll") for (int k = 0; k < 2; ++k) \
        acc[ai][bj][m][n] = __builtin_amdgcn_mfma_f32_16x16x32_bf16(Bt[n][k], At[m][k], acc[ai][bj][m][n], 0, 0, 0); __builtin_amdgcn_s_setprio(0); } while (0)
#define PG8_WAIT_V(n) asm volatile("s_waitcnt vmcnt(" #n ")" ::: "memory")
#define PG8_WAIT_L(n) asm volatile("s_waitcnt lgkmcnt(" #n ")" ::: "memory")
#define PG8_BAR __builtin_amdgcn_s_barrier()
#define PG8_SCHED __builtin_amdgcn_sched_barrier(0)
    Unit cur, nxt; int ui = 0;
    if (!S.next(0, cur)) return;
    f32x4 acc[2][2][4][2];
#pragma unroll
    for (int a = 0; a < 2; ++a)
#pragma unroll
        for (int b = 0; b < 2; ++b)
#pragma unroll
            for (int m = 0; m < 4; ++m)
#pragma unroll
                for (int n = 0; n < 2; ++n) acc[a][b][m][n] = (f32x4){0.f, 0.f, 0.f, 0.f};
    bf16x8 At[4][2], B0[2][2], B1[2][2];
    const char* cA = (const char*)g.A + (size_t)cur.pm * tstep; const char* cB = (const char*)g.Bt + (size_t)cur.pn * tstep;
    S.a_ready(cur);
    PG8_STAGE(PG8_SB(0, 0), cB, voffB); PG8_STAGE(PG8_SA(0, 0), cA, voffA); PG8_STAGE(PG8_SB(0, 1), cB + hstep, voffB); PG8_STAGE(PG8_SA(0, 1), cA + hstep, voffA);
    if (wr == 1) PG8_BAR;
    PG8_WAIT_V(4); PG8_BAR;
    PG8_STAGE(PG8_SB(1, 0), cB + kstep, voffB); PG8_STAGE(PG8_SA(1, 0), cA + kstep, voffA); PG8_STAGE(PG8_SB(1, 1), cB + hstep + kstep, voffB);
    PG8_WAIT_V(6); PG8_BAR;
    PG8_STAMP();
    for (;;) {
        const bool has_next = S.next(ui + 1, nxt);
        const char* nA = has_next ? (const char*)g.A + (size_t)nxt.pm * tstep : cA; const char* nB = has_next ? (const char*)g.Bt + (size_t)nxt.pn * tstep : cB;
        for (int t = 0; t < nt; t += 2) {
            const bool last = (t == nt - 2);
            const char* a1 = cA + (size_t)(t + 1) * kstep;
            const char* a2 = last ? nA : cA + (size_t)(t + 2) * kstep; const char* b2 = last ? nB : cB + (size_t)(t + 2) * kstep;
            const char* a3 = a2 + kstep; const char* b3 = b2 + kstep;
            if (last && has_next) S.a_ready(nxt);
            PG8_LDB(B0, 0, 0); PG8_SCHED; PG8_LDA(At, 0, 0); PG8_STAGE(PG8_SA(1, 1), a1 + hstep, voffA);
            PG8_WAIT_L(8); PG8_BAR; PG8_WAIT_L(0); PG8_MMA(0, 0, At, B0); PG8_BAR; PG8_SCHED;
            PG8_LDB(B1, 0, 1); PG8_STAGE(PG8_SB(0, 0), b2, voffB);
            PG8_BAR; PG8_WAIT_L(0); PG8_MMA(0, 1, At, B1); PG8_BAR;
            PG8_LDA(At, 0, 1); PG8_STAGE(PG8_SA(0, 0), a2, voffA);
            PG8_BAR; PG8_WAIT_L(0); PG8_MMA(1, 0, At, B0); PG8_BAR; PG8_SCHED;
            PG8_STAGE(PG8_SB(0, 1), b2 + hstep, voffB);
            PG8_WAIT_V(6); PG8_BAR; PG8_MMA(1, 1, At, B1); PG8_BAR;
            PG8_LDB(B0, 1, 0); PG8_SCHED; PG8_LDA(At, 1, 0); PG8_STAGE(PG8_SA(0, 1), a2 + hstep, voffA);
            PG8_WAIT_L(8); PG8_BAR; PG8_WAIT_L(0); PG8_MMA(0, 0, At, B0); PG8_BAR; PG8_SCHED;
            PG8_LDB(B1, 1, 1); PG8_STAGE(PG8_SB(1, 0), b3, voffB);
            PG8_BAR; PG8_WAIT_L(0); PG8_MMA(0, 1, At, B1); PG8_BAR;
            PG8_LDA(At, 1, 1); PG8_STAGE(PG8_SA(1, 0), a3, voffA);
            PG8_BAR; PG8_WAIT_L(0); PG8_MMA(1, 0, At, B0); PG8_BAR; PG8_SCHED;
            PG8_STAGE(PG8_SB(1, 1), b3 + hstep, voffB);
            PG8_WAIT_V(6); PG8_BAR; PG8_MMA(1, 1, At, B1); PG8_BAR;
        }
        PG8_STAMP();
        if constexpr (!Epi::AFTER_DRAIN) { E(acc, cur, wr, wc, fr, fq); S.done(cur); }
        PG8_STAMP();
        if (!has_next) break;
#pragma unroll
        for (int a = 0; a < 2; ++a)
#pragma unroll
            for (int b = 0; b < 2; ++b)
#pragma unroll
                for (int m = 0; m < 4; ++m)
#pragma unroll
                    for (int n = 0; n < 2; ++n) acc[a][b][m][n] = (f32x4){0.f, 0.f, 0.f, 0.f};
        cur = nxt; cA = nA; cB = nB; ++ui;
    }
    PG8_WAIT_V(0);
    if (wr == 0) PG8_BAR;
    PG8_BAR;
    if constexpr (Epi::AFTER_DRAIN) { E.fused(acc, cur, wr, wc, fr, fq, lds, wid, lane); S.done(cur); }
    PG8_STAMP();
    if (STAMP && wid == 0) { stamps[lane] = lane < nts ? (((unsigned long long)(unsigned)ts_hi << 32) | (unsigned)ts_lo) : 0ull;
        if (lane == 62) stamps[62] = rt_entry; if (lane == 63) stamps[63] = (unsigned long long)wall_clock64(); }
#undef PG8_STAMP
#undef PG8_SA
#undef PG8_SB
#undef PG8_STAGE
#undef PG8_LDA
#undef PG8_LDB
#undef PG8_MMA
#undef PG8_WAIT_V
#undef PG8_WAIT_L
#undef PG8_BAR
#undef PG8_SCHED
}
}

#include <hip/hip_cooperative_groups.h>
#include <cstdio>
namespace cg = cooperative_groups;
using namespace pg8;
#define LAS PG8_LAS
typedef float f32x16 __attribute__((ext_vector_type(16)));
typedef unsigned u32x2 __attribute__((ext_vector_type(2)));
typedef float f32x2 __attribute__((ext_vector_type(2)));

constexpr int D = 1024, NB = 8, SEQ = 2048, CTXL = 256, NLAT = NB * SEQ, NCTX = NB * CTXL, NROW = NLAT + NCTX, DFF = 2816;
constexpr float ALPHA_F = 1.41421356237309515f;
constexpr int LDS_BYTES = 135168;
#define PROBE_MASK 0
#define PROBE_REP(bit) for (int rep_ = 0; rep_ < ((PROBE_MASK & (bit)) ? 2 : 1); ++rep_)

constexpr size_t al256(size_t x) { return (x + 255) & ~(size_t)255; }
constexpr size_t WS_MOD = 0;
constexpr size_t WS_KF = al256(WS_MOD + (size_t)2 * 9 * 9216 * 4);
constexpr size_t WS_KFC = al256(WS_KF + (size_t)512 * 4096 * 4);
constexpr size_t WS_XCTX = al256(WS_KFC + (size_t)512 * 512 * 4);
constexpr size_t WS_AGG = al256(WS_XCTX + (size_t)NCTX * D * 4);
constexpr size_t WS_WFI = al256(WS_AGG + (size_t)2 * 8 * 72 * 512 * 2 * 4);
constexpr size_t SZ_WFI = (size_t)5632 * 1024 * 2;
constexpr size_t WS_WFO = al256(WS_WFI + 4 * SZ_WFI);
constexpr size_t SZ_WFO = (size_t)1024 * 2816 * 2;
constexpr size_t WS_WEI = al256(WS_WFO + 4 * SZ_WFO);
constexpr size_t WS_WEO = al256(WS_WEI + (size_t)2560 * 1024 * 2);
constexpr size_t WS_WRG = al256(WS_WEO + (size_t)1024 * 1024 * 2);
constexpr size_t WS_WMI = al256(WS_WRG + (size_t)2048 * 512 * 2);
constexpr size_t WS_WQU = al256(WS_WMI + (size_t)1280 * 1024 * 2);
constexpr size_t WS_WKU = al256(WS_WQU + (size_t)1536 * 768 * 2);
constexpr size_t WS_WVU = al256(WS_WKU + (size_t)1024 * 256 * 2);
constexpr size_t WS_WMO = al256(WS_WVU + (size_t)1024 * 256 * 2);
constexpr size_t WS_H = al256(WS_WMO + (size_t)1024 * 1024 * 2);
constexpr size_t WS_ACT = al256(WS_H + (size_t)NROW * D * 2);
constexpr size_t WS_G = al256(WS_ACT + (size_t)NROW * DFF * 2);
constexpr size_t WS_XC = al256(WS_G + (size_t)NROW * 2048 * 2);
constexpr size_t WS_YT = al256(WS_XC + (size_t)NROW * 512 * 2);
constexpr size_t WS_BAR = al256(WS_YT + (size_t)512 * NROW * 2);
constexpr size_t WS_END = al256(WS_BAR + 16384);
constexpr size_t WS_UT = WS_ACT;
constexpr size_t WS_URG = al256(WS_UT + (size_t)1536 * NROW * 2);
constexpr size_t WS_P = WS_ACT;
constexpr size_t WS_Q = WS_ACT;
constexpr size_t WS_QN = al256(WS_ACT + (size_t)NLAT * 1536 * 2);
constexpr size_t WS_KVN = al256(WS_QN + (size_t)NLAT * 768 * 2);
constexpr size_t WS_KR = al256(WS_KVN + (size_t)NROW * 256 * 2);
static_assert(WS_KR + (size_t)NROW * 32 * 2 <= WS_G, "layer-1 aliases overflow ACT");
static_assert(WS_URG + (size_t)NROW * 1024 * 2 <= WS_G, "layer-0 aliases overflow ACT");
constexpr size_t WS_K = WS_G;
constexpr size_t WS_VT = WS_G + (size_t)NROW * 1024 * 2;

struct Params { const float* in[34]; float* out; unsigned char* ws; };
enum { I_X = 0, I_C, I_CTX, I_CCTX, I_ADAW, I_ADAB, I_LNG, I_LNB, I_FWI, I_FWO, I_EWI, I_EWO, I_HCW, I_HCB, I_HW1, I_HB1, I_HW2, I_HB2, I_HW3, I_HSF, I_HBIAS,
       I_RCW, I_RCB, I_RAW, I_RAB, I_RXW, I_RXB, I_RLAM, I_MWI, I_MQN, I_MKVN, I_MWQ, I_MWKV, I_MWO };

extern __shared__ __attribute__((aligned(16))) unsigned char lds_raw[];
constexpr int TAB_OFF = LDS_BYTES - 16 - 320;
__device__ __forceinline__ unsigned char* tabptr(int i) {
  const volatile LAS unsigned* t = (const volatile LAS unsigned*)((LAS unsigned char*)lds_raw + TAB_OFF) + 2 * i;
  const unsigned lo = __builtin_amdgcn_readfirstlane(t[0]), hi = __builtin_amdgcn_readfirstlane(t[1]);
  return (unsigned char*)(((size_t)hi << 32) | (size_t)lo);
}
#define PIN(i) ((const float*)tabptr(i))
__device__ __forceinline__ int ltid() { int t = threadIdx.x; asm volatile("" : "+v"(t)); return t; }
#define Q8_EMU 0
__device__ __forceinline__ float q8(float x) { unsigned u = __float_as_uint(x); u += 0x7FFFFu + ((u >> 20) & 1u); u &= 0xFFF00000u; return __uint_as_float(u); }
__device__ __forceinline__ float bf2f(unsigned short b) { return __uint_as_float(((unsigned)b) << 16); }
__device__ __forceinline__ float bflo(unsigned w) { return __uint_as_float(w << 16); }
__device__ __forceinline__ float bfhi(unsigned w) { return __uint_as_float(w & 0xffff0000u); }
__device__ __forceinline__ float wave_sum(float v) {
#pragma unroll
  for (int o = 1; o < 64; o <<= 1) v += __shfl_xor(v, o);
  return v;
}
__device__ __forceinline__ float sigmoidf_(float x) { return 1.0f / (1.0f + __expf(-x)); }

struct EpiSwiGLU {
  static constexpr bool PERM = true, AFTER_DRAIN = false;
  bf16_t* O;
  __device__ __forceinline__ void operator()(const f32x4 (&acc)[2][2][4][2], const Unit& u, int wr, int wc, int fr, int fq) const {
    const int row0 = u.pm * BM + wr * 64 + fr, col0 = u.pn * 128 + wc * 32 + 8 * fq;
#pragma unroll
    for (int ai = 0; ai < 2; ++ai)
#pragma unroll
      for (int m = 0; m < 4; ++m) {
        float v[8];
#pragma unroll
        for (int n = 0; n < 2; ++n)
#pragma unroll
          for (int j = 0; j < 4; ++j) { const float a = acc[ai][0][m][n][j], g = acc[ai][1][m][n][j]; const float sg = __builtin_amdgcn_rcpf(1.0f + __expf(-a)); v[4 * n + j] = a * sg * g; }
        u32x4 w; w.x = cvt_pk_bf16(v[0], v[1]); w.y = cvt_pk_bf16(v[2], v[3]); w.z = cvt_pk_bf16(v[4], v[5]); w.w = cvt_pk_bf16(v[6], v[7]);
        *(u32x4*)(O + (size_t)(row0 + ai * HALF + m * 16) * DFF + col0) = w;
      }
  }
};
struct EpiResid {
  static constexpr bool PERM = true, AFTER_DRAIN = false;
  bf16_t* Y2; const float* mod; int gidx; float gs;
  __device__ __forceinline__ void operator()(const f32x4 (&acc)[2][2][4][2], const Unit& u, int wr, int wc, int fr, int fq) const {
    const int rt = u.pm * BM; const int mr = rt / SEQ;
    const int row0 = rt + wr * 64 + fr, col0 = u.pn * BM + wc * 32 + 8 * fq;
    const float* gp = mod + (size_t)(mr * 9 + gidx) * D + col0;
    f32x4 gv[2][2];
#pragma unroll
    for (int bj = 0; bj < 2; ++bj)
#pragma unroll
      for (int n = 0; n < 2; ++n) gv[bj][n] = *(const f32x4*)(gp + bj * HALF + n * 4) * gs;
#pragma unroll
    for (int ai = 0; ai < 2; ++ai)
#pragma unroll
      for (int m = 0; m < 4; ++m) {
        bf16_t* rowp = Y2 + (size_t)(row0 + ai * HALF + m * 16) * D + col0;
#pragma unroll
        for (int bj = 0; bj < 2; ++bj) { const f32x4 v0 = acc[ai][bj][m][0] * gv[bj][0], v1 = acc[ai][bj][m][1] * gv[bj][1];
          u32x4 w; w.x = cvt_pk_bf16(v0[0], v0[1]); w.y = cvt_pk_bf16(v0[2], v0[3]); w.z = cvt_pk_bf16(v1[0], v1[1]); w.w = cvt_pk_bf16(v1[2], v1[3]);
          *(u32x4*)(rowp + bj * HALF) = w; }
      }
  }
};
struct EpiBf16P {
  static constexpr bool PERM = true, AFTER_DRAIN = false;
  bf16_t* O; size_t ldc;
  __device__ __forceinline__ void operator()(const f32x4 (&acc)[2][2][4][2], const Unit& u, int wr, int wc, int fr, int fq) const {
    const int row0 = u.pm * BM + wr * 64 + fr, col0 = u.pn * BM + wc * 32 + 8 * fq;
#pragma unroll
    for (int ai = 0; ai < 2; ++ai)
#pragma unroll
      for (int m = 0; m < 4; ++m) {
        bf16_t* rowp = O + (size_t)(row0 + ai * HALF + m * 16) * ldc + col0;
#pragma unroll
        for (int bj = 0; bj < 2; ++bj) { const f32x4 v0 = acc[ai][bj][m][0], v1 = acc[ai][bj][m][1];
          u32x4 w; w.x = cvt_pk_bf16(v0[0], v0[1]); w.y = cvt_pk_bf16(v0[2], v0[3]); w.z = cvt_pk_bf16(v1[0], v1[1]); w.w = cvt_pk_bf16(v1[2], v1[3]);
          *(u32x4*)(rowp + bj * HALF) = w; }
      }
  }
};
struct EpiGate {
  static constexpr bool PERM = true, AFTER_DRAIN = false;
  bf16_t* O; const float* ab; const float* xb;
  __device__ __forceinline__ void operator()(const f32x4 (&acc)[2][2][4][2], const Unit& u, int wr, int wc, int fr, int fq) const {
    const int row0 = u.pm * BM + wr * 64 + fr, col0 = u.pn * BM + wc * 32 + 8 * fq;
    f32x4 bv[2][2];
#pragma unroll
    for (int bj = 0; bj < 2; ++bj) { const int c = col0 + bj * HALF, g = c >> 9, e = c & 511; const float* bp = ((g & 1) ? xb : ab) + (g >> 1) * 512 + e;
      bv[bj][0] = *(const f32x4*)bp; bv[bj][1] = *(const f32x4*)(bp + 4); }
#pragma unroll
    for (int ai = 0; ai < 2; ++ai)
#pragma unroll
      for (int m = 0; m < 4; ++m) {
        bf16_t* rowp = O + (size_t)(row0 + ai * HALF + m * 16) * 2048 + col0;
#pragma unroll
        for (int bj = 0; bj < 2; ++bj) { f32x4 v0 = acc[ai][bj][m][0] + bv[bj][0], v1 = acc[ai][bj][m][1] + bv[bj][1];
#pragma unroll
          for (int j = 0; j < 4; ++j) { v0[j] = sigmoidf_(v0[j]); v1[j] = sigmoidf_(v1[j]); }
          u32x4 w; w.x = cvt_pk_bf16(v0[0], v0[1]); w.y = cvt_pk_bf16(v0[2], v0[3]); w.z = cvt_pk_bf16(v1[0], v1[1]); w.w = cvt_pk_bf16(v1[2], v1[3]);
          *(u32x4*)(rowp + bj * HALF) = w; }
      }
  }
};
__device__ __forceinline__ float rope_inv_freq(int p) { return exp2f(-(float)p * (13.287712379549449f / 8.0f)); }
struct EpiQ {
  static constexpr bool PERM = true, AFTER_DRAIN = false;
  bf16_t* O;
  __device__ __forceinline__ void operator()(const f32x4 (&acc)[2][2][4][2], const Unit& u, int wr, int wc, int fr, int fq) const {
    const int row0 = u.pm * BM + wr * 64 + fr, col0 = u.pn * BM + wc * 32 + 8 * fq;
#pragma unroll
    for (int bj = 0; bj < 2; ++bj) {
      const int c8 = col0 + bj * HALF; const int f = c8 % 96; const bool rope = f >= 64; const int rp = f - 64; const int a = (rp >> 4) & 1, e = (rp >> 3) & 1;
      float invf[4];
#pragma unroll
      for (int jj = 0; jj < 4; ++jj) invf[jj] = rope_inv_freq(4 * e + jj);
#pragma unroll
      for (int ai = 0; ai < 2; ++ai)
#pragma unroll
        for (int m = 0; m < 4; ++m) {
          const int row = row0 + ai * HALF + m * 16; const int t = row & (SEQ - 1); const float pos = (float)(a == 0 ? (t >> 6) : (t & 63));
          const f32x4 v0 = acc[ai][bj][m][0], v1 = acc[ai][bj][m][1];
          float v[8] = {v0[0], v0[1], v0[2], v0[3], v1[0], v1[1], v1[2], v1[3]};
          if (rope) {
#pragma unroll
            for (int jj = 0; jj < 4; ++jj) { const float ang = pos * invf[jj]; const float cs = __cosf(ang), sn = __sinf(ang); const float x1 = v[2 * jj], x2 = v[2 * jj + 1];
              v[2 * jj] = x1 * cs - x2 * sn; v[2 * jj + 1] = x2 * cs + x1 * sn; }
          }
          u32x4 w; w.x = cvt_pk_bf16(v[0], v[1]); w.y = cvt_pk_bf16(v[2], v[3]); w.z = cvt_pk_bf16(v[4], v[5]); w.w = cvt_pk_bf16(v[6], v[7]);
          *(u32x4*)(O + (size_t)row * 1536 + c8) = w;
        }
    }
  }
};

enum { MAP_ID = 0, MAP_SWIGLU, MAP_MLAIN, MAP_QUP, MAP_KUP, MAP_VUP, MAP_RG };
struct ConvDesc { int kind, K, ld, tile; const float* W; const float* W2; const float* sc; bf16_t* dst; };
__device__ __forceinline__ void conv_load(const ConvDesc& d, int tid, float (&v)[8]) {
  const int nkt = d.K >> 6; const int kt = d.tile % nkt, nt = d.tile / nkt; const int k0 = kt * 64, n0 = nt * 64;
  const int nn = tid & 63, kq = tid >> 6; const int n = n0 + nn; const int kind = d.kind;
  int col = n;
  if (kind == MAP_SWIGLU) { const int t = n >> 8, h = (n >> 7) & 1, j = n & 127; col = h * DFF + t * 128 + j; }
  else if (kind == MAP_MLAIN) { col = n < 1056 ? n : -1; }
  else if (kind == MAP_QUP) { const int hh = n / 96, f = n % 96; if (f >= 64) { const int rp = f - 64, a = rp >> 4, w = rp & 15, pp = w >> 1, hf = w & 1; col = hh * 96 + 64 + a * 16 + hf * 8 + pp; } }
  else if (kind == MAP_KUP) { col = (n >> 6) * 128 + (n & 63); }
  else if (kind == MAP_VUP) { col = (n >> 6) * 128 + 64 + (n & 63); }
#pragma unroll
  for (int i = 0; i < 8; ++i) {
    const int k = k0 + i * 8 + kq; float x;
    if (kind == MAP_RG) { const int g = n >> 9, e = n & 511, nb = e >> 6; x = ((k >> 6) == nb) ? ((g & 1) ? d.W2 : d.W)[((((g >> 1) * 8 + nb) * 64 + (k & 63)) << 6) + (e & 63)] : 0.f; }
    else x = col >= 0 ? d.W[(size_t)k * d.ld + col] : 0.f;
    if (d.sc) x *= d.sc[k];
    if (Q8_EMU && (kind == MAP_SWIGLU || d.K == 2816)) x = q8(x);
    v[i] = x;
  }
}
__device__ __forceinline__ void conv_store(LAS float* scr, const ConvDesc& d, int tid, const float (&v)[8]) {
  const int nkt = d.K >> 6; const int kt = d.tile % nkt, nt = d.tile / nkt; const int k0 = kt * 64, n0 = nt * 64;
  const int nn = tid & 63, kq = tid >> 6;
#pragma unroll
  for (int i = 0; i < 8; ++i) scr[(i * 8 + kq) * 65 + nn] = v[i];
  __syncthreads();
  { const int nl = tid >> 3, c = tid & 7; const LAS float* s = scr + (8 * c) * 65 + nl;
    u32x4 o; o.x = cvt_pk_bf16(s[0], s[65]); o.y = cvt_pk_bf16(s[2 * 65], s[3 * 65]); o.z = cvt_pk_bf16(s[4 * 65], s[5 * 65]); o.w = cvt_pk_bf16(s[6 * 65], s[7 * 65]);
    *(u32x4*)(d.dst + (size_t)(n0 + nl) * d.K + k0 + 8 * c) = o; }
  __syncthreads();
}
__device__ __forceinline__ void convw_load(const ConvDesc& d, int tid, f32x4 (&v)[8]) {
  const int nkt = d.K >> 6; const int kt = d.tile % nkt, nt = d.tile / nkt; const int k0 = kt * 64;
  const int c4 = (tid & 63) * 4, kq = tid >> 6;
  const int col = d.kind == MAP_SWIGLU ? (c4 < 128 ? nt * 128 + c4 : DFF + nt * 128 + (c4 - 128)) : nt * 256 + c4;
#pragma unroll
  for (int i = 0; i < 8; ++i) v[i] = *(const f32x4*)(d.W + (size_t)(k0 + i * 8 + kq) * d.ld + col);
}
__device__ __forceinline__ void convw_store(LAS float* scr, const ConvDesc& d, int tid, const f32x4 (&v)[8]) {
  const int nkt = d.K >> 6; const int kt = d.tile % nkt, nt = d.tile / nkt; const int k0 = kt * 64, n0 = nt * 256;
  const int c4 = (tid & 63) * 4, kq = tid >> 6;
#pragma unroll
  for (int i = 0; i < 8; ++i) *(LAS f32x4*)(scr + (i * 8 + kq) * 260 + c4) = v[i];
  __syncthreads();
  { const int nl = tid >> 1, ch0 = (tid & 1) * 4;
#pragma unroll
    for (int c = 0; c < 4; ++c) { const LAS float* s = scr + (8 * (ch0 + c)) * 260 + nl;
      u32x4 o; o.x = cvt_pk_bf16(s[0], s[260]); o.y = cvt_pk_bf16(s[2 * 260], s[3 * 260]); o.z = cvt_pk_bf16(s[4 * 260], s[5 * 260]); o.w = cvt_pk_bf16(s[6 * 260], s[7 * 260]);
      *(u32x4*)(d.dst + (size_t)(n0 + nl) * d.K + k0 + 8 * (ch0 + c)) = o; } }
  __syncthreads();
}
__device__ __forceinline__ void adaln_job(LAS float* L, const Params& p, int z, float* MOD, int job, bool fill) {
  const int tid = ltid(); const int l = job / 288, col0 = (job % 288) * 32;
  if (fill) { const float* pc = PIN(I_C); const float* pcc = PIN(I_CCTX); for (int i = tid; i < 9 * 1024; i += 512) { const int r = i >> 10, k = i & 1023; const float x = r < 8 ? pc[r * 1024 + k] : pcc[k]; L[i] = x * sigmoidf_(x); }
    __syncthreads(); }
  const int col = tid & 31, kg = tid >> 5;
  const float* W = PIN(I_ADAW) + (size_t)l * 1024 * 9216 + col0 + col + (size_t)(kg * 64) * 9216;
  float acc[9];
#pragma unroll
  for (int r = 0; r < 9; ++r) acc[r] = 0.f;
#pragma unroll 1
  for (int kb = 0; kb < 64; kb += 16) { float w[16];
#pragma unroll
    for (int j = 0; j < 16; ++j) w[j] = W[(size_t)(kb + j) * 9216];
#pragma unroll
    for (int j = 0; j < 16; ++j)
#pragma unroll
      for (int r = 0; r < 9; ++r) acc[r] += L[r * 1024 + kg * 64 + kb + j] * w[j]; }
  LAS float* part = L + 9 * 1024;
#pragma unroll
  for (int r = 0; r < 9; ++r) part[(kg * 9 + r) * 32 + col] = acc[r];
  __syncthreads();
  if (tid < 288) { const int r = tid >> 5, cc = tid & 31; float s = 0.f;
#pragma unroll
    for (int g = 0; g < 16; ++g) s += part[(g * 9 + r) * 32 + cc];
    MOD[(size_t)(l * 9 + r) * 9216 + col0 + cc] = s + PIN(I_ADAB)[l * 9216 + col0 + cc]; }
  __syncthreads();
}
__device__ __forceinline__ void filter_job(LAS float* Ls, const Params& p, int z, float* KF, int L, int job) {
  const int tid = ltid(); const int pos0 = job * 16;
  LAS float* feats = Ls; LAS float* h1 = Ls + 16 * 33; LAS float* h2 = h1 + 1024;
  for (int e = tid; e < 16 * 33; e += 512) { const int pp = e / 33, i = e % 33; const float pos = (float)(pos0 + pp); const float t = pos / (float)L; float v;
    if (i == 0) v = t;
    else { const int j = (i - 1) & 15; const float band = 1e-4f + (float)j * ((15.0f - 1e-4f) / 15.0f); const float rev = t * band;
      v = (i <= 16) ? __builtin_amdgcn_cosf(rev) : -__builtin_amdgcn_sinf(rev); }
    feats[e] = v; }
  __syncthreads();
  { const int j = tid & 63; const float b1 = PIN(I_HB1)[j], f0 = PIN(I_HSF)[j]; float s0 = b1, s1 = b1; const int p0 = tid >> 6, p1 = p0 + 8;
    const float* pw1 = PIN(I_HW1);
#pragma unroll 11
    for (int i = 0; i < 33; ++i) { const float w = pw1[i * 64 + j]; s0 += feats[p0 * 33 + i] * w; s1 += feats[p1 * 33 + i] * w; }
    h1[p0 * 64 + j] = __sinf(f0 * s0); h1[p1 * 64 + j] = __sinf(f0 * s1); }
  __syncthreads();
  { const int j = tid & 63; const float b2 = PIN(I_HB2)[j], f1 = PIN(I_HSF)[64 + j]; float s0 = b2, s1 = b2; const int p0 = tid >> 6, p1 = p0 + 8;
    const float* pw2 = PIN(I_HW2);
#pragma unroll 16
    for (int i = 0; i < 64; ++i) { const float w = pw2[i * 64 + j]; s0 += h1[p0 * 64 + i] * w; s1 += h1[p1 * 64 + i] * w; }
    h2[p0 * 64 + j] = __sinf(f1 * s0); h2[p1 * 64 + j] = __sinf(f1 * s1); }
  __syncthreads();
  const int ch = tid; const float delta = fabsf(-3.0701134573253945f + (float)ch * ((-15.350567286626973f + 3.0701134573253945f) / 511.0f));
#pragma unroll 1
  for (int q = 0; q < 2; ++q) {
    const int n = q * 512 + ch; float acc[16]; const float* pw3 = PIN(I_HW3);
#pragma unroll
    for (int pp = 0; pp < 16; ++pp) acc[pp] = 0.f;
#pragma unroll 1
    for (int ib = 0; ib < 64; ib += 4) { float w[4];
#pragma unroll
      for (int j = 0; j < 4; ++j) w[j] = pw3[(ib + j) * 1024 + n];
#pragma unroll
      for (int j = 0; j < 4; ++j)
#pragma unroll
        for (int pp = 0; pp < 16; ++pp) acc[pp] += h2[pp * 64 + ib + j] * w[j]; }
#pragma unroll
    for (int pp = 0; pp < 16; ++pp) { const int d = pos0 + pp; const float t = (float)d / (float)L; const float val = acc[pp] * (__expf(-t * delta) + 0.05f);
      if (q == 0) KF[(size_t)ch * (2 * L) + L + d] = val; else if (d >= 1) KF[(size_t)ch * (2 * L) + L - d] = val; }
  }
  __syncthreads();
}

typedef _Float16 f16x4 __attribute__((ext_vector_type(4)));
__device__ __forceinline__ void row_pass(const float* s32lat, const float* s32ctx, const _Float16* s16, _Float16* d16, float* d32, bool do_ln, const float* g, const float* b, bf16_t* H, const float* modn  , int sidx, int nrows, const float* zp, const float* gate8, float gs, const bf16_t* y2) {
  const int lane = ltid() & 63; const int gw = blockIdx.x * 8 + (ltid() >> 6), ngw = gridDim.x * 8;
  constexpr int R = 3;
#pragma unroll 1
  for (int row0 = gw; row0 < nrows; row0 += R * ngw) {
    f32x4 v[R][4]; bool ok[R]; int rows[R];
#pragma unroll
    for (int r = 0; r < R; ++r) { const int row = row0 + r * ngw; ok[r] = row < nrows; const int rr = ok[r] ? row : row0; rows[r] = rr; const bool lat = rr < NLAT;
      if (s16) { const _Float16* sp = s16 + (size_t)rr * D + lane * 4;
#pragma unroll
        for (int j = 0; j < 4; ++j) v[r][j] = __builtin_convertvector(*(const f16x4*)(sp + 256 * j), f32x4); }
      else { const float* sp = (lat ? s32lat + (size_t)rr * D : s32ctx + (size_t)(rr - NLAT) * D) + lane * 4;
#pragma unroll
        for (int j = 0; j < 4; ++j) v[r][j] = *(const f32x4*)(sp + 256 * j); }
      if (y2 && lat) { const bf16_t* yr = y2 + (size_t)rr * D + lane * 4;
#pragma unroll
        for (int j = 0; j < 4; ++j) { const u32x2 w = *(const u32x2*)(yr + 256 * j); v[r][j] = v[r][j] * ALPHA_F + (f32x4){bflo(w.x), bfhi(w.x), bflo(w.y), bfhi(w.y)}; } }
      if (zp && !lat) { const float* zr = zp + (size_t)(rr - NLAT) * D + lane * 4;
#pragma unroll
        for (int j = 0; j < 4; ++j) { const f32x4 y = (*(const f32x4*)(zr + 256 * j) + *(const f32x4*)(zr + (size_t)NCTX * D + 256 * j)) + (*(const f32x4*)(zr + (size_t)2 * NCTX * D + 256 * j) + *(const f32x4*)(zr + (size_t)3 * NCTX * D + 256 * j));
          v[r][j] = v[r][j] * ALPHA_F + (*(const f32x4*)(gate8 + lane * 4 + 256 * j) * gs) * y; } } }
    if (do_ln) {
      float s[R], q[R];
#pragma unroll
      for (int r = 0; r < R; ++r) { s[r] = 0.f;
#pragma unroll
        for (int j = 0; j < 4; ++j) s[r] += (v[r][j][0] + v[r][j][1]) + (v[r][j][2] + v[r][j][3]); }
#pragma unroll
      for (int o = 1; o < 64; o <<= 1) {
#pragma unroll
        for (int r = 0; r < R; ++r) s[r] += __shfl_xor(s[r], o); }
#pragma unroll
      for (int r = 0; r < R; ++r) { const float mean = s[r] * (1.0f / D); q[r] = 0.f;
#pragma unroll
        for (int j = 0; j < 4; ++j) { v[r][j] = v[r][j] - mean; q[r] += (v[r][j][0] * v[r][j][0] + v[r][j][1] * v[r][j][1]) + (v[r][j][2] * v[r][j][2] + v[r][j][3] * v[r][j][3]); } }
#pragma unroll
      for (int o = 1; o < 64; o <<= 1) {
#pragma unroll
        for (int r = 0; r < R; ++r) q[r] += __shfl_xor(q[r], o); }
#pragma unroll
      for (int j = 0; j < 4; ++j) { const f32x4 gg = *(const f32x4*)(g + lane * 4 + 256 * j), bb = *(const f32x4*)(b + lane * 4 + 256 * j);
#pragma unroll
        for (int r = 0; r < R; ++r) { const float rstd = 1.0f / sqrtf(q[r] * (1.0f / D) + 1e-6f); v[r][j] = v[r][j] * rstd * gg + bb; } }
    }
#pragma unroll
    for (int r = 0; r < R; ++r) {
      if (!ok[r]) continue;
      const int row = rows[r];
      if (d16) { _Float16* dp = d16 + (size_t)row * D + lane * 4;
#pragma unroll
        for (int j = 0; j < 4; ++j) *(f16x4*)(dp + 256 * j) = __builtin_convertvector(v[r][j], f16x4); }
      if (d32 && row < NLAT) { float* dp = d32 + (size_t)row * D + lane * 4;
#pragma unroll
        for (int j = 0; j < 4; ++j) *(f32x4*)(dp + 256 * j) = v[r][j]; }
      if (H) {
        const int mr = row < NLAT ? row / SEQ : 8; const float* sh = modn + (size_t)(mr * 9 + sidx) * D; const float* sc = sh + D;
#pragma unroll
        for (int j = 0; j < 4; ++j) { const f32x4 s1 = *(const f32x4*)(sh + lane * 4 + 256 * j), s2 = *(const f32x4*)(sc + lane * 4 + 256 * j); const f32x4 h = v[r][j] * (s2 + 1.0f) + s1;
          u32x2 w; w.x = cvt_pk_bf16(h[0], h[1]); w.y = cvt_pk_bf16(h[2], h[3]); *(u32x2*)(H + (size_t)row * D + lane * 4 + 256 * j) = w; }
      }
    }
  }
}
__device__ __forceinline__ void mla_rownorm(const bf16_t* P, bf16_t* QN, bf16_t* KVN, bf16_t* KR) {
  const int lane = ltid() & 63; const int gw = blockIdx.x * 8 + (ltid() >> 6), ngw = gridDim.x * 8;
  for (int row = gw; row < NROW; row += ngw) {
    const bf16_t* pr = P + (size_t)row * 1280; const bool lat = row < NLAT;
    if (lat) {
      u32x2 w[3]; float ss = 0.f;
#pragma unroll
      for (int j = 0; j < 3; ++j) { w[j] = *(const u32x2*)(pr + lane * 4 + 256 * j); const float a = bflo(w[j].x), b = bfhi(w[j].x), c = bflo(w[j].y), d = bfhi(w[j].y); ss += (a * a + b * b) + (c * c + d * d); }
      const float r = 1.0f / sqrtf(wave_sum(ss) * (1.0f / 768.0f) + 1e-6f);
#pragma unroll
      for (int j = 0; j < 3; ++j) { u32x2 o; o.x = cvt_pk_bf16(bflo(w[j].x) * r, bfhi(w[j].x) * r); o.y = cvt_pk_bf16(bflo(w[j].y) * r, bfhi(w[j].y) * r); *(u32x2*)(QN + (size_t)row * 768 + lane * 4 + 256 * j) = o; }
    }
    { const u32x2 w = *(const u32x2*)(pr + 768 + lane * 4); const float a = bflo(w.x), b = bfhi(w.x), c = bflo(w.y), d = bfhi(w.y);
      const float r = 1.0f / sqrtf(wave_sum((a * a + b * b) + (c * c + d * d)) * (1.0f / 256.0f) + 1e-6f);
      u32x2 o; o.x = cvt_pk_bf16(a * r, b * r); o.y = cvt_pk_bf16(c * r, d * r); *(u32x2*)(KVN + (size_t)row * 256 + lane * 4) = o; }
    if (lane < 16) { const int a = lane >> 3, pp = lane & 7; float x1 = bf2f(pr[1024 + a * 16 + pp]), x2 = bf2f(pr[1024 + a * 16 + 8 + pp]);
      if (lat) { const int t = row & (SEQ - 1); const float pos = (float)(a == 0 ? (t >> 6) : (t & 63)); const float ang = pos * rope_inv_freq(pp); const float cs = __cosf(ang), sn = __sinf(ang);
        const float o1 = x1 * cs - x2 * sn, o2 = x2 * cs + x1 * sn; x1 = o1; x2 = o2; }
      *(unsigned*)(KR + (size_t)row * 32 + a * 16 + 2 * pp) = cvt_pk_bf16(x1, x2); }
  }
}

__device__ __forceinline__ void xc_build(const Params& p, int z, const bf16_t* URG, bf16_t* XC) {
  const float* cw = PIN(I_RCW); const float* cb = PIN(I_RCB);
  for (int it = blockIdx.x * 512 + ltid(); it < NROW * 64; it += gridDim.x * 512) {
    const int row = it >> 6, c8 = (it & 63) * 8; int t, Ls; if (row < NLAT) { t = row & (SEQ - 1); Ls = SEQ; } else { t = (row - NLAT) & (CTXL - 1); Ls = CTXL; }
    float acc[8];
#pragma unroll
    for (int j = 0; j < 8; ++j) acc[j] = cb[c8 + j];
#pragma unroll
    for (int k = 0; k < 4; ++k) { const int tt = t + k - 2; if (tt >= 0 && tt < Ls) { const u32x4 w = *(const u32x4*)(URG + (size_t)(row + k - 2) * 1024 + c8);
        const f32x4 w0 = *(const f32x4*)(cw + k * 512 + c8), w1 = *(const f32x4*)(cw + k * 512 + c8 + 4);
        acc[0] += bflo(w.x) * w0[0]; acc[1] += bfhi(w.x) * w0[1]; acc[2] += bflo(w.y) * w0[2]; acc[3] += bfhi(w.y) * w0[3];
        acc[4] += bflo(w.z) * w1[0]; acc[5] += bfhi(w.z) * w1[1]; acc[6] += bflo(w.w) * w1[2]; acc[7] += bfhi(w.w) * w1[3]; } }
    u32x4 o; o.x = cvt_pk_bf16(acc[0], acc[1]); o.y = cvt_pk_bf16(acc[2], acc[3]); o.z = cvt_pk_bf16(acc[4], acc[5]); o.w = cvt_pk_bf16(acc[6], acc[7]);
    *(u32x4*)(XC + (size_t)row * 512 + c8) = o;
  }
}
constexpr int HY_CSTRIDE = 8224;
__device__ __forceinline__ void hyena_unit(LAS unsigned char* lds, const Params& p, int z, const bf16_t* UT, const float* KFa, bf16_t* YT, int c, int L, int tokbase) {
  const int tid = ltid(), lane = tid & 63, wid = tid >> 6;
  const int OFF = L + 16, NC = 2 * L + 16; const int rstride = L * 2 + 16;
  LAS unsigned char* cp = lds; LAS unsigned char* WT = lds + 8 * HY_CSTRIDE; LAS unsigned char* X0 = WT + 8 * (2048 * 2 + 16);
  { const float bias = PIN(I_HBIAS)[c]; const float* kf = KFa + (size_t)c * (2 * L) + L; const int ngrp = NC >> 3;
#pragma unroll 3
    for (int gidx = tid; gidx < 8 * ngrp; gidx += 512) { const int r = gidx / ngrp, m = gidx - r * ngrp; const int dhi = OFF + r - 8 * m;
      float v[8];
      if (dhi < L && dhi - 7 > -L) { const f32x4 lo = *(const f32x4*)(kf + dhi - 7), hi = *(const f32x4*)(kf + dhi - 3);
        v[0] = hi[3]; v[1] = hi[2]; v[2] = hi[1]; v[3] = hi[0]; v[4] = lo[3]; v[5] = lo[2]; v[6] = lo[1]; v[7] = lo[0]; }
      else {
#pragma unroll
        for (int j = 0; j < 8; ++j) { const int d = dhi - j; v[j] = (d > -L && d < L) ? kf[d] : 0.f; } }
#pragma unroll
      for (int j = 0; j < 8; ++j) if (dhi - j == 0) v[j] += bias;
      u32x4 o; o.x = cvt_pk_bf16(v[0], v[1]); o.y = cvt_pk_bf16(v[2], v[3]); o.z = cvt_pk_bf16(v[4], v[5]); o.w = cvt_pk_bf16(v[6], v[7]);
      *(LAS u32x4*)(cp + r * HY_CSTRIDE + m * 16) = o; } }
  { const float* cw = PIN(I_HCW); const float* cb = PIN(I_HCB);
    float w0[3], w1[3], w2[3], bb[3];
#pragma unroll
    for (int a = 0; a < 3; ++a) { w0[a] = cw[0 * 1536 + a * 512 + c]; w1[a] = cw[1 * 1536 + a * 512 + c]; w2[a] = cw[2 * 1536 + a * 512 + c]; bb[a] = cb[a * 512 + c]; }
    const int cpb = L >> 3;
#pragma unroll 2
    for (int ch = tid; ch < 8 * cpb; ch += 512) { const int b = ch / cpb, t8 = (ch - b * cpb) * 8; float res[3][8];
#pragma unroll
      for (int a = 0; a < 3; ++a) { const bf16_t* rowp = UT + (size_t)(a * 512 + c) * NROW + tokbase + b * L + t8; const u32x4 w = *(const u32x4*)rowp;
        float x[10]; x[0] = t8 > 0 ? bf2f(rowp[-1]) : 0.f; x[9] = t8 + 8 < L ? bf2f(rowp[8]) : 0.f;
        x[1] = bflo(w.x); x[2] = bfhi(w.x); x[3] = bflo(w.y); x[4] = bfhi(w.y); x[5] = bflo(w.z); x[6] = bfhi(w.z); x[7] = bflo(w.w); x[8] = bfhi(w.w);
#pragma unroll
        for (int j = 0; j < 8; ++j) res[a][j] = x[j] * w0[a] + x[j + 1] * w1[a] + x[j + 2] * w2[a] + bb[a]; }
      u32x4 ow, ox;
      ow.x = cvt_pk_bf16(res[2][0] * res[1][0], res[2][1] * res[1][1]); ow.y = cvt_pk_bf16(res[2][2] * res[1][2], res[2][3] * res[1][3]);
      ow.z = cvt_pk_bf16(res[2][4] * res[1][4], res[2][5] * res[1][5]); ow.w = cvt_pk_bf16(res[2][6] * res[1][6], res[2][7] * res[1][7]);
      ox.x = cvt_pk_bf16(res[0][0], res[0][1]); ox.y = cvt_pk_bf16(res[0][2], res[0][3]); ox.z = cvt_pk_bf16(res[0][4], res[0][5]); ox.w = cvt_pk_bf16(res[0][6], res[0][7]);
      *(LAS u32x4*)(WT + b * rstride + t8 * 2) = ow; *(LAS u32x4*)(X0 + b * rstride + t8 * 2) = ox; }
  }
  __syncthreads();
  { const int n = lane & 15, g = lane >> 4, bq = n & 7; const int i = lane & 15, q = i >> 3, r = i & 7;
    const int ngroups = L >> 6;
    const LAS unsigned char* bbase = WT + bq * rstride + g * 16;
    const LAS unsigned char* abase = cp + r * HY_CSTRIDE + (8 * g - 8 * q + OFF) * 2;
    for (int grp = wid; grp < ngroups; grp += 8) {
      f32x4 acc[4];
#pragma unroll
      for (int ii = 0; ii < 4; ++ii) acc[ii] = (f32x4){0.f, 0.f, 0.f, 0.f};
      const int t0 = grp * 64;
      for (int J = 0; J < (L >> 5); ++J) {
        const bf16x8 bf = *(const LAS bf16x8*)(bbase + J * 64);
#pragma unroll
        for (int ii = 0; ii < 4; ++ii) { const bf16x8 af = *(const LAS bf16x8*)(abase + (32 * J - t0 - 16 * ii) * 2);
          acc[ii] = __builtin_amdgcn_mfma_f32_16x16x32_bf16(af, bf, acc[ii], 0, 0, 0); }
      }
      if (n < 8) {
#pragma unroll
        for (int ii = 0; ii < 4; ++ii) { const int t = t0 + 16 * ii + 4 * g; const u32x2 xw = *(const LAS u32x2*)(X0 + n * rstride + t * 2);
          u32x2 o; o.x = cvt_pk_bf16(acc[ii][0] * bflo(xw.x), acc[ii][1] * bfhi(xw.x)); o.y = cvt_pk_bf16(acc[ii][2] * bflo(xw.y), acc[ii][3] * bfhi(xw.y));
          *(u32x2*)(YT + (size_t)c * NROW + tokbase + n * L + t) = o; }
      }
    }
  }
  __syncthreads();
}
__device__ __forceinline__ void yt_transpose(LAS unsigned char* lds, const bf16_t* YT, bf16_t* Y, int job) {
  const int tid = ltid(); const int ct = job & 7, tt = job >> 3; const int c0 = ct * 64, tok0 = tt * 64;
  LAS unsigned short* T = (LAS unsigned short*)lds;
  { const int i = tid >> 3, ch = tid & 7; const u32x4 w = *(const u32x4*)(YT + (size_t)(c0 + i) * NROW + tok0 + ch * 8); *(LAS u32x4*)(T + i * 72 + ch * 8) = w; }
  __syncthreads();
  { const int t = tid >> 3, cc = (tid & 7) * 8; unsigned short v[8];
#pragma unroll
    for (int j = 0; j < 8; ++j) v[j] = T[(cc + j) * 72 + t];
    u32x4 o; o.x = v[0] | ((unsigned)v[1] << 16); o.y = v[2] | ((unsigned)v[3] << 16); o.z = v[4] | ((unsigned)v[5] << 16); o.w = v[6] | ((unsigned)v[7] << 16);
    *(u32x4*)(Y + (size_t)(tok0 + t) * 1024 + c0 + cc) = o; }
  __syncthreads();
}
constexpr int SC_CL = 32, SC_NC = 72, SC_NCTX = 8;
__device__ __forceinline__ int scan_row0(int b, int chunk) { return chunk < SC_NCTX ? NLAT + b * CTXL + chunk * SC_CL : b * SEQ + (chunk - SC_NCTX) * SC_CL; }
__device__ __forceinline__ void rg_coef(float r, float ig, float xc, float cl, float& a, float& bb) {
  const float la = r * cl; a = __builtin_amdgcn_exp2f(la * 1.4426950408889634f); const float x = 2.0f * la;
  float om = -x * (1.0f + x * (0.5f + x * (0.16666667f + x * (0.041666668f + x * (0.0083333338f + x * 0.0013888889f)))));
  om = (x < -0.5f) ? 1.0f - a * a : om;
  bb = __builtin_amdgcn_sqrtf(fmaxf(om, 0.f)) * (ig * xc);
}
__device__ __forceinline__ float scan_cl(const Params& p, int z, int dir, int ch) { const float lam = PIN(I_RLAM)[dir * 512 + ch]; return -8.0f * log1pf(__expf(-lam)); }
constexpr int SC_XROW = 1040;
__device__ __forceinline__ void scan_xc_load(const bf16_t* XC, int job, int tid, u32x4 (&xr)[4]) {
  const int b = job / SC_NC, chunk = job % SC_NC; const int row0 = scan_row0(b, chunk);
#pragma unroll
  for (int it = 0; it < 4; ++it) { const int id = it * 512 + tid; const int r = id >> 6, c8 = (id & 63) * 8; xr[it] = *(const u32x4*)(XC + (size_t)(row0 + r) * 512 + c8); }
}
__device__ __forceinline__ void scan_pass_a(LAS unsigned char* lds, const Params& p, int z, const bf16_t* XC, const bf16_t* WRG, unsigned* COEF, float* AGG, int job, int tid, const u32x4 (&xr)[4]) {
  const int lane = tid & 63, w = tid >> 6; const int b = job / SC_NC, chunk = job % SC_NC; const int row0 = scan_row0(b, chunk);
  LAS unsigned* coef = (LAS unsigned*)lds;
  LAS unsigned char* xcl = lds + 65536;
#pragma unroll
  for (int it = 0; it < 4; ++it) { const int id = it * 512 + tid; const int r = id >> 6, c8 = (id & 63) * 8; *(LAS u32x4*)(xcl + r * SC_XROW + c8 * 2) = xr[it]; }
  const int n = lane & 15, g = lane >> 4;
  __syncthreads();
  bf16x8 af[2][2];
#pragma unroll
  for (int mb = 0; mb < 2; ++mb)
#pragma unroll
    for (int ks = 0; ks < 2; ++ks) af[mb][ks] = *(const LAS bf16x8*)(xcl + (16 * mb + n) * SC_XROW + (64 * w + 32 * ks + 8 * g) * 2);
#pragma unroll 1
  for (int dir = 0; dir < 2; ++dir) {
    bf16x8 wf[4][2][2];
#pragma unroll
    for (int nblk = 0; nblk < 4; ++nblk)
#pragma unroll
      for (int ty = 0; ty < 2; ++ty) { const bf16_t* wp = WRG + (size_t)((dir * 2 + ty) * 512 + 64 * w + 16 * nblk + n) * 512 + 64 * w + 8 * g; wf[nblk][ty][0] = *(const bf16x8*)wp; wf[nblk][ty][1] = *(const bf16x8*)(wp + 32); }
#pragma unroll
    for (int nblk = 0; nblk < 4; ++nblk) {
      const int ch = 64 * w + 16 * nblk + n;
      f32x4 ar[2], ai[2];
#pragma unroll
      for (int mb = 0; mb < 2; ++mb) { ar[mb] = (f32x4){0.f, 0.f, 0.f, 0.f}; ai[mb] = (f32x4){0.f, 0.f, 0.f, 0.f};
        ar[mb] = __builtin_amdgcn_mfma_f32_16x16x32_bf16(af[mb][0], wf[nblk][0][0], ar[mb], 0, 0, 0); ar[mb] = __builtin_amdgcn_mfma_f32_16x16x32_bf16(af[mb][1], wf[nblk][0][1], ar[mb], 0, 0, 0);
        ai[mb] = __builtin_amdgcn_mfma_f32_16x16x32_bf16(af[mb][0], wf[nblk][1][0], ai[mb], 0, 0, 0); ai[mb] = __builtin_amdgcn_mfma_f32_16x16x32_bf16(af[mb][1], wf[nblk][1][1], ai[mb], 0, 0, 0); }
      const float biasr = PIN(I_RAB)[dir * 512 + ch], biasi = PIN(I_RXB)[dir * 512 + ch]; const float cl = scan_cl(p, z, dir, ch);
#pragma unroll
      for (int mb = 0; mb < 2; ++mb)
#pragma unroll
        for (int jj = 0; jj < 4; ++jj) { const int row = 16 * mb + 4 * g + jj;
          const float r = __fdividef(1.0f, 1.0f + __expf(-(ar[mb][jj] + biasr))), ig = __fdividef(1.0f, 1.0f + __expf(-(ai[mb][jj] + biasi))); const float xc = bf2f(*(const LAS unsigned short*)(xcl + row * SC_XROW + ch * 2));
          const float rq = bflo(cvt_pk_bf16(r, 0.f)), iq = bflo(cvt_pk_bf16(ig, 0.f));
          const float la = rq * cl; const float a = __builtin_amdgcn_exp2f(la * 1.4426950408889634f); const float x = 2.0f * la;
          float om = -x * (1.0f + x * (0.5f + x * (0.16666667f + x * (0.041666668f + x * (0.0083333338f + x * 0.0013888889f)))));
          om = (x < -0.5f) ? 1.0f - a * a : om;
          const float bb = __builtin_amdgcn_sqrtf(fmaxf(om, 0.f)) * (iq * xc);
          coef[row * 512 + ch] = cvt_pk_bf16(la, bb); }
    }
    __syncthreads();
    { const int ch = tid; float A = 1.f, B = 0.f; unsigned* cg_ = COEF + (size_t)row0 * 1024 + dir * 512 + ch;
#pragma unroll 8
      for (int tt = 0; tt < SC_CL; ++tt) { const int t = dir ? SC_CL - 1 - tt : tt; const unsigned c = coef[t * 512 + ch]; cg_[(size_t)t * 1024] = c;
        const float a = __builtin_amdgcn_exp2f(bflo(c) * 1.4426950408889634f); A *= a; B = B * a + bfhi(c); }
      float* ag = AGG + ((size_t)((dir * 8 + b) * SC_NC + chunk) * 512 + ch) * 2; ag[0] = A; ag[1] = B; }
    __syncthreads();
  }
}
__device__ __forceinline__ float scan_carry(const float* AGG, int dir, int b, int chunk, int ch) {
  const int pos = dir == 0 ? chunk : (chunk < SC_NCTX ? SC_NCTX - 1 - chunk : (SC_NC + SC_NCTX - 1) - chunk);
  float h = 0.f;
#pragma unroll 1
  for (int ob = 0; ob < pos; ob += 24) { float aa[24], bb[24];
#pragma unroll
    for (int j = 0; j < 24; ++j) { const int o = ob + j; const int oo = o < pos ? o : 0; const int cj = dir == 0 ? oo : (oo < SC_NCTX ? SC_NCTX - 1 - oo : (SC_NC + SC_NCTX - 1) - oo);
      const f32x2 v = *(const f32x2*)(AGG + ((size_t)((dir * 8 + b) * SC_NC + cj) * 512 + ch) * 2); aa[j] = o < pos ? v.x : 1.f; bb[j] = o < pos ? v.y : 0.f; }
#pragma unroll
    for (int j = 0; j < 24; ++j) h = aa[j] * h + bb[j]; }
  return h;
}
__device__ __forceinline__ void scan_pass_b(LAS unsigned char* lds, const unsigned* COEF, const bf16_t* URG, const float* AGG, bf16_t* Y, int job) {
  const int ch = ltid(); const int b = job / SC_NC, chunk = job % SC_NC; const int row0 = scan_row0(b, chunk);
  LAS float* hf = (LAS float*)lds;
  const unsigned* c0 = COEF + (size_t)row0 * 1024 + ch;
  { float h = scan_carry(AGG, 0, b, chunk, ch);
#pragma unroll 1
    for (int tb = 0; tb < SC_CL; tb += 16) { unsigned cc[16];
#pragma unroll
      for (int j = 0; j < 16; ++j) cc[j] = c0[(size_t)(tb + j) * 1024];
#pragma unroll
      for (int j = 0; j < 16; ++j) { const float a = __builtin_amdgcn_exp2f(bflo(cc[j]) * 1.4426950408889634f); h = a * h + bfhi(cc[j]); hf[(tb + j) * 512 + ch] = h; } } }
  { float h = scan_carry(AGG, 1, b, chunk, ch);
#pragma unroll 1
    for (int tb = 0; tb < SC_CL; tb += 16) { unsigned cc[16]; float gg[16];
#pragma unroll
      for (int j = 0; j < 16; ++j) { const int t = SC_CL - 1 - (tb + j); cc[j] = c0[(size_t)t * 1024 + 512]; gg[j] = bf2f(URG[(size_t)(row0 + t) * 1024 + 512 + ch]); }
#pragma unroll
      for (int j = 0; j < 16; ++j) { const int t = SC_CL - 1 - (tb + j); const float a = __builtin_amdgcn_exp2f(bflo(cc[j]) * 1.4426950408889634f); h = a * h + bfhi(cc[j]);
        const float gt = gg[j]; const float zz = 0.7978845608028654f * (gt + 0.044715f * gt * gt * gt);
        const float th = 1.0f - 2.0f * __builtin_amdgcn_rcpf(1.0f + __expf(2.0f * zz)); const float ge = 0.5f * gt * (1.0f + th);
        Y[(size_t)(row0 + t) * 1024 + 512 + ch] = (unsigned short)(cvt_pk_bf16((h + hf[t * 512 + ch]) * ge, 0.f) & 0xffffu); } } }
}

__device__ __forceinline__ void attn_phase(LAS unsigned char* lds, const bf16_t* Q, const bf16_t* Kb, const bf16_t* KR, const bf16_t* VT, bf16_t* O) {
  const int tid = threadIdx.x, wid = tid >> 6, lane = tid & 63, l32 = lane & 31, hf = lane >> 5;
  constexpr int KROW = 208, KBUF = 64 * KROW, VROW = 136, VBUF = 64 * VROW;
  LAS unsigned char* Kl = lds; LAS unsigned char* Vl = lds + 2 * KBUF;
  const int G = gridDim.x; const float cs = 0.10206207261596575f * 1.4426950408889634f;
  const int kkey = tid >> 3, kpart = tid & 7, rkey = (tid >> 2) & 63, rpart = tid & 3, vdv = tid >> 3, vpart = tid & 7;
  for (int u = blockIdx.x; u < 1024; u += G) {
    int bh, qb;
    if (G == 256) { const int xcd = blockIdx.x & 7, within = blockIdx.x >> 3, r = u >> 8; bh = xcd * 16 + r * 4 + (within >> 3); qb = within & 7; } else { bh = u >> 3; qb = u & 7; }
    const int b = bh >> 4, h = bh & 15;
    const int q = qb * 256 + wid * 32 + l32;
    const bf16_t* qp = Q + (size_t)(b * SEQ + q) * 1536 + h * 96 + hf * 8;
    bf16x8 qf[6];
#pragma unroll
    for (int ks = 0; ks < 6; ++ks) qf[ks] = *(const bf16x8*)(qp + ks * 16);
    f32x16 o0, o1;
#pragma unroll
    for (int i = 0; i < 16; ++i) { o0[i] = 0.f; o1[i] = 0.f; }
    float mrun = -1e30f, lsum = 0.f;
    u32x4 kreg, rreg, vreg;
#define ATT_LOAD(j) do { const int tb_ = (j) < 32 ? b * SEQ + (j) * 64 : NLAT + b * CTXL + ((j) - 32) * 64; \
      kreg = *(const u32x4*)(Kb + (size_t)(tb_ + kkey) * 1024 + h * 64 + kpart * 8); \
      if (tid < 256) rreg = *(const u32x4*)(KR + (size_t)(tb_ + rkey) * 32 + rpart * 8); \
      vreg = *(const u32x4*)(VT + (size_t)(h * 64 + vdv) * NROW + tb_ + vpart * 8); } while (0)
#define ATT_STORE(buf) do { *(LAS u32x4*)(Kl + (buf) * KBUF + kkey * KROW + kpart * 16) = kreg; \
      if (tid < 256) *(LAS u32x4*)(Kl + (buf) * KBUF + rkey * KROW + 128 + rpart * 16) = rreg; \
      *(LAS u32x2*)(Vl + (buf) * VBUF + vdv * VROW + vpart * 16) = (u32x2){vreg.x, vreg.y}; *(LAS u32x2*)(Vl + (buf) * VBUF + vdv * VROW + vpart * 16 + 8) = (u32x2){vreg.z, vreg.w}; } while (0)
    ATT_LOAD(0); ATT_STORE(0); __syncthreads();
    for (int j = 0; j < 36; ++j) {
      if (j + 1 < 36) ATT_LOAD(j + 1);
      const int cur = j & 1;
      f32x16 s0, s1;
#pragma unroll
      for (int i = 0; i < 16; ++i) { s0[i] = 0.f; s1[i] = 0.f; }
      const LAS unsigned char* kb0 = Kl + cur * KBUF + l32 * KROW + hf * 16;
#pragma unroll
      for (int ks = 0; ks < 6; ++ks) { const bf16x8 a0 = *(const LAS bf16x8*)(kb0 + ks * 32), a1 = *(const LAS bf16x8*)(kb0 + 32 * KROW + ks * 32);
        s0 = __builtin_amdgcn_mfma_f32_32x32x16_bf16(a0, qf[ks], s0, 0, 0, 0); s1 = __builtin_amdgcn_mfma_f32_32x32x16_bf16(a1, qf[ks], s1, 0, 0, 0); }
      float tmax = s0[0];
#pragma unroll
      for (int i = 1; i < 16; ++i) tmax = fmaxf(tmax, s0[i]);
#pragma unroll
      for (int i = 0; i < 16; ++i) tmax = fmaxf(tmax, s1[i]);
      tmax = fmaxf(tmax, __shfl_xor(tmax, 32));
      const float mnew = fmaxf(mrun, tmax * cs); const float alpha = __builtin_amdgcn_exp2f(mrun - mnew); mrun = mnew;
      float psum = 0.f;
#pragma unroll
      for (int i = 0; i < 16; ++i) { s0[i] = __builtin_amdgcn_exp2f(s0[i] * cs - mnew); s1[i] = __builtin_amdgcn_exp2f(s1[i] * cs - mnew); psum += s0[i] + s1[i]; }
      lsum = lsum * alpha + psum;
#pragma unroll
      for (int i = 0; i < 16; ++i) { o0[i] *= alpha; o1[i] *= alpha; }
      const LAS unsigned char* vb0 = Vl + cur * VBUF + l32 * VROW + hf * 8;
#pragma unroll
      for (int kb = 0; kb < 2; ++kb)
#pragma unroll
        for (int k2 = 0; k2 < 2; ++k2) {
          bf16x8 pf; { unsigned w0, w1, w2, w3;
            if (kb == 0) { w0 = cvt_pk_bf16(s0[8 * k2 + 0], s0[8 * k2 + 1]); w1 = cvt_pk_bf16(s0[8 * k2 + 2], s0[8 * k2 + 3]); w2 = cvt_pk_bf16(s0[8 * k2 + 4], s0[8 * k2 + 5]); w3 = cvt_pk_bf16(s0[8 * k2 + 6], s0[8 * k2 + 7]); }
            else { w0 = cvt_pk_bf16(s1[8 * k2 + 0], s1[8 * k2 + 1]); w1 = cvt_pk_bf16(s1[8 * k2 + 2], s1[8 * k2 + 3]); w2 = cvt_pk_bf16(s1[8 * k2 + 4], s1[8 * k2 + 5]); w3 = cvt_pk_bf16(s1[8 * k2 + 6], s1[8 * k2 + 7]); }
            const u32x4 pw = {w0, w1, w2, w3}; pf = __builtin_bit_cast(bf16x8, pw); }
          const int koff = (32 * kb + 16 * k2) * 2;
          { const u32x2 va = *(const LAS u32x2*)(vb0 + koff), vb = *(const LAS u32x2*)(vb0 + koff + 16); const u32x4 vw = {va.x, va.y, vb.x, vb.y};
            o0 = __builtin_amdgcn_mfma_f32_32x32x16_bf16(__builtin_bit_cast(bf16x8, vw), pf, o0, 0, 0, 0); }
          { const u32x2 va = *(const LAS u32x2*)(vb0 + 32 * VROW + koff), vb = *(const LAS u32x2*)(vb0 + 32 * VROW + koff + 16); const u32x4 vw = {va.x, va.y, vb.x, vb.y};
            o1 = __builtin_amdgcn_mfma_f32_32x32x16_bf16(__builtin_bit_cast(bf16x8, vw), pf, o1, 0, 0, 0); }
        }
      if (j + 1 < 36) ATT_STORE(cur ^ 1);
      __syncthreads();
    }
#undef ATT_LOAD
#undef ATT_STORE
    const float inv = 1.0f / (lsum + __shfl_xor(lsum, 32));
    bf16_t* op = O + (size_t)(b * SEQ + q) * 1024 + h * 64 + 4 * hf;
#pragma unroll
    for (int i = 0; i < 4; ++i) {
      u32x2 w; w.x = cvt_pk_bf16(o0[4 * i] * inv, o0[4 * i + 1] * inv); w.y = cvt_pk_bf16(o0[4 * i + 2] * inv, o0[4 * i + 3] * inv); *(u32x2*)(op + 8 * i) = w;
      w.x = cvt_pk_bf16(o1[4 * i] * inv, o1[4 * i + 1] * inv); w.y = cvt_pk_bf16(o1[4 * i + 2] * inv, o1[4 * i + 3] * inv); *(u32x2*)(op + 32 + 8 * i) = w;
    }
  }
}

__device__ __forceinline__ int wide_count(int sel) { return sel == 0 ? 752 : (sel == 3 ? 64 : 528); }
__device__ __forceinline__ ConvDesc wide_desc(const Params& p, int z, unsigned char* ws, int sel, int it) {
  ConvDesc d; int r = it; d.W2 = nullptr; d.sc = nullptr; d.kind = MAP_ID;
  if (sel == 3) { d.W = PIN(I_MWO); d.K = 1024; d.ld = 1024; d.dst = (bf16_t*)(ws + WS_WMO); }
  else { const int m = sel == 4 ? 3 : sel;
    if (r < 352) { d.kind = MAP_SWIGLU; d.W = PIN(I_FWI) + (size_t)m * 1024 * 5632; d.K = 1024; d.ld = 5632; d.dst = (bf16_t*)(ws + WS_WFI + m * SZ_WFI); }
    else if ((r -= 352) < 176) { d.W = PIN(I_FWO) + (size_t)m * 2816 * 1024; d.K = 2816; d.ld = 1024; d.dst = (bf16_t*)(ws + WS_WFO + m * SZ_WFO); }
    else if ((r -= 176) < 160) { d.W = PIN(I_EWI); d.K = 1024; d.ld = 2560; d.dst = (bf16_t*)(ws + WS_WEI); }
    else { r -= 160; d.W = PIN(I_EWO); d.K = 1024; d.ld = 1024; d.dst = (bf16_t*)(ws + WS_WEO); } }
  d.tile = r; return d;
}
__device__ __forceinline__ void conv_wide_list(LAS float* L, const Params& p, int z, unsigned char* ws, int sel, int t0, int tstride) {
  const int total = wide_count(sel); const int tid = ltid(); f32x4 cur[8], nxt[8];
  if (t0 < total) convw_load(wide_desc(p, z, ws, sel, t0), tid, cur);
#pragma unroll 1
  for (int it = t0; it < total; it += tstride) {
    const bool has = it + tstride < total;
    if (has) convw_load(wide_desc(p, z, ws, sel, it + tstride), tid, nxt);
    convw_store(L, wide_desc(p, z, ws, sel, it), tid, cur);
#pragma unroll
    for (int i = 0; i < 8; ++i) cur[i] = nxt[i];
  }
}
__device__ __forceinline__ int small_count(int sel) { return sel == 0 ? 256 : 736; }
__device__ __forceinline__ ConvDesc small_desc(const Params& p, int z, unsigned char* ws, int sel, int it) {
  ConvDesc d; int r = it; d.W2 = nullptr; d.sc = nullptr;
  if (sel == 0) { d.kind = MAP_RG; d.W = PIN(I_RAW); d.W2 = PIN(I_RXW); d.K = 512; d.ld = 0; d.dst = (bf16_t*)(ws + WS_WRG); }
  else if (r < 320) { d.kind = MAP_MLAIN; d.W = PIN(I_MWI); d.K = 1024; d.ld = 1056; d.dst = (bf16_t*)(ws + WS_WMI); }
  else if ((r -= 320) < 288) { d.kind = MAP_QUP; d.W = PIN(I_MWQ); d.sc = PIN(I_MQN); d.K = 768; d.ld = 1536; d.dst = (bf16_t*)(ws + WS_WQU); }
  else if ((r -= 288) < 64) { d.kind = MAP_KUP; d.W = PIN(I_MWKV); d.sc = PIN(I_MKVN); d.K = 256; d.ld = 2048; d.dst = (bf16_t*)(ws + WS_WKU); }
  else { r -= 64; d.kind = MAP_VUP; d.W = PIN(I_MWKV); d.sc = PIN(I_MKVN); d.K = 256; d.ld = 2048; d.dst = (bf16_t*)(ws + WS_WVU); }
  d.tile = r; return d;
}
__device__ __forceinline__ void conv_small_list(LAS float* L, const Params& p, int z, unsigned char* ws, int sel, int t0, int tstride) {
  const int total = small_count(sel); const int tid = ltid(); float cur[8], nxt[8];
  if (t0 < total) conv_load(small_desc(p, z, ws, sel, t0), tid, cur);
#pragma unroll 1
  for (int it = t0; it < total; it += tstride) {
    const bool has = it + tstride < total;
    if (has) conv_load(small_desc(p, z, ws, sel, it + tstride), tid, nxt);
    conv_store(L, small_desc(p, z, ws, sel, it), tid, cur);
#pragma unroll
    for (int i = 0; i < 8; ++i) cur[i] = nxt[i];
  }
}

#define XB_TMO      128
#define XB_XCNT(j)  (256  + 64 * (j))
#define XB_XSUB(j)  (1280 + 64 * (j))
#define XB_XGEN(j)  (2304 + 64 * (j))
#define XB_TOP      3328
#define XB_TOPGEN   3392
#define XCD_BAR_WORDS 3456
#define XB_SPIN_CAP (1u << 18)

__device__ __forceinline__ unsigned xb_ld(unsigned* p)              { return __hip_atomic_load(p, __ATOMIC_RELAXED, __HIP_MEMORY_SCOPE_AGENT); }
__device__ __forceinline__ unsigned xb_add(unsigned* p, unsigned v) { return __hip_atomic_fetch_add(p, v, __ATOMIC_RELAXED, __HIP_MEMORY_SCOPE_AGENT); }
__device__ __forceinline__ unsigned xb_xcc_id() { return (unsigned)__builtin_amdgcn_s_getreg((3 << 11) | 20) & 0xFu; }
#define XB_SPIN(cond, bar) do { unsigned _sp = 0; while (cond) { __builtin_amdgcn_s_sleep(1); \
    if ((++_sp & 255u) == 0u) { if (xb_ld(&(bar)[XB_TMO])) break; if (_sp > XB_SPIN_CAP) { atomicAdd(&(bar)[XB_TMO], 1u); break; } } } } while (0)

struct XcdBarrier {
    unsigned* bar; unsigned x;
    volatile LAS unsigned* st;
};

__device__ __forceinline__ XcdBarrier xcd_barrier_post(unsigned* bar, volatile LAS unsigned* st) {
    XcdBarrier b; b.bar = bar; b.x = xb_xcc_id(); b.st = st;
    if (threadIdx.x == 0) (void)xb_add(&bar[XB_XCNT(b.x)], 1u);
    return b;
}
__device__ __forceinline__ void xcd_barrier_complete(unsigned* bar, unsigned x, unsigned& nloc, unsigned& nx) {
    const unsigned G = gridDim.x * gridDim.y * gridDim.z;
    unsigned sum, cnt, mine, sp = 0u;
    for (;;) {
        sum = 0u; cnt = 0u; mine = 0u;
#pragma unroll
        for (unsigned j = 0; j < 16; ++j) { const unsigned c = xb_ld(&bar[XB_XCNT(j)]); sum += c; cnt += (c > 0u) ? 1u : 0u; mine = (j == x) ? c : mine; }
        if (sum == G) break;
        __builtin_amdgcn_s_sleep(1);
        if ((++sp & 255u) == 0u) { if (xb_ld(&bar[XB_TMO])) break; if (sp > XB_SPIN_CAP) { atomicAdd(&bar[XB_TMO], 1u); break; } }
    }
    nloc = mine > 0u ? mine : 1u; nx = cnt > 0u ? cnt : 1u;
}

__device__ __forceinline__ void xcd_barrier(const XcdBarrier& b) {
    asm volatile("s_waitcnt vmcnt(0)" ::: "memory");
    __syncthreads();
    if (threadIdx.x == 0) {
        unsigned* bar = b.bar;
        __builtin_amdgcn_s_waitcnt(0);
        unsigned nloc = b.st[0], nx = b.st[1];
        if (nloc == 0u) { xcd_barrier_complete(bar, b.x, nloc, nx); b.st[0] = nloc; b.st[1] = nx; }
        const unsigned old = xb_add(&bar[XB_XSUB(b.x)], 1u);
        const unsigned gen = old / nloc;
        if (old + 1u == (gen + 1u) * nloc) {
            __builtin_amdgcn_fence(__ATOMIC_RELEASE, "agent");
            asm volatile("s_waitcnt vmcnt(0)" ::: "memory");
            const unsigned og = xb_add(&bar[XB_TOP], 1u);
            const unsigned tg = og / nx;
            if (og + 1u == (tg + 1u) * nx) xb_add(&bar[XB_TOPGEN], 1u);
            else XB_SPIN(xb_ld(&bar[XB_TOPGEN]) == tg, bar);
            __builtin_amdgcn_fence(__ATOMIC_ACQUIRE, "agent");
            xb_add(&bar[XB_XGEN(b.x)], 1u);
            asm volatile("s_waitcnt vmcnt(0)" ::: "memory");
        } else {
            XB_SPIN(xb_ld(&bar[XB_XGEN(b.x)]) == gen, bar);
            __builtin_amdgcn_fence(__ATOMIC_ACQUIRE, "agent");
            asm volatile("s_waitcnt vmcnt(0)" ::: "memory");
        }
    }
    __syncthreads();
}


__device__ __forceinline__ unsigned char* launder_ptr(const void* q) { unsigned lo = (unsigned)(size_t)q, hi = (unsigned)((size_t)q >> 32); asm volatile("" : "+v"(lo), "+v"(hi));
  lo = __builtin_amdgcn_readfirstlane(lo); hi = __builtin_amdgcn_readfirstlane(hi); return (unsigned char*)(((size_t)hi << 32) | (size_t)lo); }
#define PHASE_BEGIN const int z = 0; unsigned char* ws = tabptr(35); float* xout = (float*)tabptr(34); (void)ws; (void)xout; (void)z
#define P_MOD ((float*)(ws + WS_MOD))
#define P_KF ((float*)(ws + WS_KF))
#define P_KFC ((float*)(ws + WS_KFC))
#define P_XCTX ((float*)(ws + WS_XCTX))
#define P_AGG ((float*)(ws + WS_AGG))
#define P_H ((bf16_t*)(ws + WS_H))
#define P_ACT ((bf16_t*)(ws + WS_ACT))
#define P_G ((bf16_t*)(ws + WS_G))
#define P_XC ((bf16_t*)(ws + WS_XC))
#define P_YT ((bf16_t*)(ws + WS_YT))
#define P_UT ((bf16_t*)(ws + WS_UT))
#define P_URG ((bf16_t*)(ws + WS_URG))
#define P_P ((bf16_t*)(ws + WS_P))
#define P_Q ((bf16_t*)(ws + WS_Q))
#define P_QN ((bf16_t*)(ws + WS_QN))
#define P_KVN ((bf16_t*)(ws + WS_KVN))
#define P_KR ((bf16_t*)(ws + WS_KR))
#define P_K ((bf16_t*)(ws + WS_K))
#define P_VT ((bf16_t*)(ws + WS_VT))
__global__ void __launch_bounds__(512) mk_fwd(Params p) {
  LAS unsigned char* lds = (LAS unsigned char*)lds_raw;
  const int G = gridDim.x, bid = blockIdx.x;
  if (threadIdx.x == 0) { LAS unsigned long long* tab = (LAS unsigned long long*)(lds + TAB_OFF);
#pragma unroll
    for (int i = 0; i < 34; ++i) tab[i] = (unsigned long long)(size_t)p.in[i];
    tab[34] = (unsigned long long)(size_t)p.out; tab[35] = (unsigned long long)(size_t)p.ws; }
  volatile LAS unsigned* bst = (volatile LAS unsigned*)(lds + LDS_BYTES - 16);
  if (threadIdx.x == 0) { bst[0] = 0u; bst[1] = 0u; }
  __syncthreads();
  if (p.ws == nullptr) cg::this_grid().sync();
  (void)xcd_barrier_post((unsigned*)(tabptr(35) + WS_BAR), bst);
#define GSYNC() do { XcdBarrier b_; b_.bar = (unsigned*)(tabptr(35) + WS_BAR); b_.x = xb_xcc_id(); b_.st = (volatile LAS unsigned*)(lds + LDS_BYTES - 16); xcd_barrier(b_); } while (0)

  PROBE_REP(1) {
    PHASE_BEGIN;
    LAS float* L = (LAS float*)lds;
    { bool first = true; for (int job = bid; job < 576; job += G) { adaln_job(L, p, z, P_MOD, job, first); first = false; } }
    for (int job = bid; job < 144; job += G) { if (job < 128) filter_job(L, p, z, P_KF, SEQ, job); else filter_job(L, p, z, P_KFC, CTXL, job - 128); }
    conv_wide_list(L, p, z, ws, 0, bid, G);
    conv_small_list(L, p, z, ws, 0, bid, G);
  }
  GSYNC();
  PROBE_REP(1) { PHASE_BEGIN; row_pass(PIN(I_X), PIN(I_CTX), nullptr, nullptr, nullptr, false, nullptr, nullptr, P_H, P_MOD, 0, NROW, nullptr, nullptr, 0.f, nullptr); }
  GSYNC();

  if (PROBE_MASK & 16) { for (int i = 0; i < 20; ++i) GSYNC(); }
#pragma unroll 1
  for (int st = 0; st < 6; ++st) {
    const int l = st / 3, k = st % 3;
    const int Mrows = (st >= 4) ? NLAT : NROW;
    int rsel;
    if (k != 1) {
      PROBE_REP(64) { PHASE_BEGIN; const int wi = l * 2 + (k == 0 ? 0 : 1);
        Gemm g; g.A = P_H; g.Bt = (const bf16_t*)(ws + WS_WFI + wi * SZ_WFI); g.M = Mrows; g.N = 5632; g.K = 1024; g.kn = 1024;
        StaticOrder S; S.init(g.M, g.N, G, bid); EpiSwiGLU E; E.O = P_ACT; gemm_phase<EpiSwiGLU, StaticOrder, false>(lds, g, S, E, nullptr);
        { PHASE_BEGIN; int wsel = -1, ssel = -1; if (st == 0) wsel = 1; else if (st == 2) wsel = 2; else if (st == 3) { wsel = 3; ssel = 1; }
          const int t0 = G == 256 ? bid - 48 : bid, ts = G == 256 ? 208 : G; LAS float* L = (LAS float*)lds;
          if (rep_ == 0 && t0 >= 0) { if (ssel >= 0) conv_small_list(L, p, z, ws, ssel, t0, ts); if (wsel >= 0) conv_wide_list(L, p, z, ws, wsel, t0, ts); } } }
      GSYNC();
      rsel = 0;
    } else if (l == 0) {
      PROBE_REP(128)
#pragma unroll 1
      for (int gi = 0; gi < 2; ++gi) {
        PHASE_BEGIN; Gemm g; EpiBf16P E; int c;
        if (gi == 0) { g.A = (const bf16_t*)(ws + WS_WEI); g.Bt = P_H; g.M = 1536; g.N = NROW; g.K = 1024; g.kn = 1024; E.O = P_UT; E.ldc = NROW; c = bid; }
        else { g.A = P_H; g.Bt = (const bf16_t*)(ws + WS_WEI) + (size_t)1536 * 1024; g.M = NROW; g.N = 1024; g.K = 1024; g.kn = 1024; E.O = P_URG; E.ldc = 1024; c = (bid + G - (432 % G)) % G; }
        StaticOrder S; S.init(g.M, g.N, G, c); gemm_phase<EpiBf16P, StaticOrder, false>(lds, g, S, E, nullptr);
      }
      GSYNC();
      PROBE_REP(2) { PHASE_BEGIN; xc_build(p, z, P_URG, P_XC);
#pragma unroll 1
        for (int u = bid; u < 1024; u += G) { const bool lat = u < 512; hyena_unit(lds, p, z, P_UT, lat ? P_KF : P_KFC, P_YT, lat ? u : u - 512, lat ? SEQ : CTXL, lat ? 0 : NLAT); } }
      GSYNC();
      PROBE_REP(4) { PHASE_BEGIN;
        for (int job = bid; job < 8 * SC_NC; job += G) { const int tid = ltid(); u32x4 xr[4]; scan_xc_load(P_XC, job, tid, xr); scan_pass_a(lds, p, z, P_XC, (const bf16_t*)(ws + WS_WRG), (unsigned*)P_G, P_AGG, job, tid, xr); }
        for (int job = bid; job < 8 * (NROW / 64); job += G) yt_transpose(lds, P_YT, P_H, job); }
      GSYNC();
      PROBE_REP(4) { PHASE_BEGIN; for (int job = bid; job < 8 * SC_NC; job += G) scan_pass_b(lds, (const unsigned*)P_G, P_URG, P_AGG, P_H, job); }
      GSYNC();
      rsel = 1;
    } else {
      PROBE_REP(256) { PHASE_BEGIN; Gemm g; g.A = P_H; g.Bt = (const bf16_t*)(ws + WS_WMI); g.M = NROW; g.N = 1280; g.K = 1024; g.kn = 1024; EpiBf16P E; E.O = P_P; E.ldc = 1280;
        StaticOrder S; S.init(g.M, g.N, G, bid); gemm_phase<EpiBf16P, StaticOrder, false>(lds, g, S, E, nullptr);
        { PHASE_BEGIN; const int t0 = G == 256 ? bid - 104 : bid, ts = G == 256 ? 152 : G; if (rep_ == 0 && t0 >= 0) conv_wide_list((LAS float*)lds, p, z, ws, 4, t0, ts); } }
      GSYNC();
      { PHASE_BEGIN; mla_rownorm(P_P, P_QN, P_KVN, P_KR); }
      GSYNC();
      PROBE_REP(256) { PHASE_BEGIN; Gemm g; g.A = P_QN; g.Bt = (const bf16_t*)(ws + WS_WQU); g.M = NLAT; g.N = 1536; g.K = 768; g.kn = 768; EpiQ E; E.O = P_Q;
        StaticOrder S; S.init(g.M, g.N, G, bid); gemm_phase<EpiQ, StaticOrder, false>(lds, g, S, E, nullptr); }
      PROBE_REP(256)
#pragma unroll 1
      for (int gi = 0; gi < 2; ++gi) {
        PHASE_BEGIN; Gemm g; EpiBf16P E; int c;
        if (gi == 0) { g.A = P_KVN; g.Bt = (const bf16_t*)(ws + WS_WKU); g.M = NROW; g.N = 1024; g.K = 256; g.kn = 256; E.O = P_K; E.ldc = 1024; c = (bid + G - (384 % G)) % G; }
        else { g.A = (const bf16_t*)(ws + WS_WVU); g.Bt = P_KVN; g.M = 1024; g.N = NROW; g.K = 256; g.kn = 256; E.O = P_VT; E.ldc = NROW; c = (bid + G - ((384 + 288) % G)) % G; }
        StaticOrder S; S.init(g.M, g.N, G, c); gemm_phase<EpiBf16P, StaticOrder, false>(lds, g, S, E, nullptr);
      }
      GSYNC();
      PROBE_REP(8) { PHASE_BEGIN; attn_phase(lds, P_Q, P_K, P_KR, P_VT, P_H); }
      GSYNC();
      rsel = 2;
    }
    PROBE_REP(512) { PHASE_BEGIN; Gemm g; EpiResid E; g.M = NLAT; g.N = 1024; E.Y2 = P_XC; E.mod = P_MOD + (size_t)l * 9 * 9216;
      if (rsel == 0) { g.A = P_ACT; g.Bt = (const bf16_t*)(ws + WS_WFO + (l * 2 + (k == 0 ? 0 : 1)) * SZ_WFO); g.K = 2816; g.kn = 2816; E.gidx = k == 0 ? 2 : 8; E.gs = 0.5f; }
      else if (rsel == 1) { g.A = P_H; g.Bt = (const bf16_t*)(ws + WS_WEO); g.K = 1024; g.kn = 1024; E.gidx = 5; E.gs = 1.0f; }
      else { g.A = P_H; g.Bt = (const bf16_t*)(ws + WS_WMO); g.K = 1024; g.kn = 1024; E.gidx = 5; E.gs = 1.0f; }
      StaticOrder S; S.init(g.M, g.N, G, bid); gemm_phase<EpiResid, StaticOrder, false>(lds, g, S, E, nullptr); }
    if (Mrows == NROW) {
#pragma unroll 1
      for (int s = 0; s < 4; ++s) { PHASE_BEGIN; Gemm g; EpiF32 E; int kt0, ktn; const bf16_t* A; const bf16_t* B;
        if (rsel == 0) { kt0 = s < 2 ? 12 * s : 24 + 10 * (s - 2); ktn = s < 2 ? 12 : 10; A = P_ACT; B = (const bf16_t*)(ws + WS_WFO + (l * 2 + (k == 0 ? 0 : 1)) * SZ_WFO); g.K = 2816; }
        else { kt0 = 4 * s; ktn = 4; A = P_H; B = (const bf16_t*)(ws + WS_WEO); g.K = 1024; }
        g.A = A + (size_t)NLAT * g.K + kt0 * 64; g.Bt = B + kt0 * 64; g.M = NCTX; g.N = 1024; g.kn = ktn * 64;
        E.C = (float*)(ws + WS_G) + (size_t)s * NCTX * D; E.ldc = D; E.bias = nullptr;
        StaticOrder S; S.init(g.M, g.N, G, (bid + G - ((128 + 32 * s) % G)) % G); gemm_phase<EpiF32, StaticOrder, false>(lds, g, S, E, nullptr); }
    }
    GSYNC();
    { PHASE_BEGIN; const float* lg = PIN(I_LNG) + (size_t)(l * 3 + k) * D; const float* lb = PIN(I_LNB) + (size_t)(l * 3 + k) * D;
      const bool hw = st < 5; const float* modn = P_MOD + (size_t)((k < 2) ? l : l + 1) * 9 * 9216; const int sidx = (k < 2) ? 3 * k + 3 : 0;
      const int gidx = k == 0 ? 2 : (k == 1 ? 5 : 8); const float* gate8 = P_MOD + (size_t)l * 9 * 9216 + (size_t)(8 * 9 + gidx) * D;
      _Float16* x16a = (_Float16*)xout; _Float16* x16b = (_Float16*)(ws + WS_G);
      row_pass(PIN(I_X), PIN(I_CTX), st == 0 ? nullptr : (st == 5 ? x16b : x16a), st < 4 ? x16a : (st == 4 ? x16b : nullptr), st == 5 ? xout : nullptr, true, lg, lb, hw ? P_H : nullptr, modn, sidx, Mrows, Mrows == NROW ? (const float*)(ws + WS_G) : nullptr, gate8, k == 1 ? 1.0f : 0.5f, P_XC); }
    if (st < 5) GSYNC();
  }
}

extern "C" void kernel_launch(void* const* d_in, const int* in_sizes, int n_in, void* d_out, int out_size, void* d_ws, size_t ws_size, hipStream_t stream) {
  static int grid_blocks = 0;
  if (!grid_blocks) {
    int dev = 0, cus = 0, per_cu = 0;
    if (n_in != 34 || out_size != NLAT * D || ws_size < WS_END) { fprintf(stderr, "kernel_launch: unexpected problem (n_in %d out %d ws %zu need %zu)\n", n_in, out_size, ws_size, (size_t)WS_END); grid_blocks = -1; return; }
    (void)hipGetDevice(&dev);
    (void)hipDeviceGetAttribute(&cus, hipDeviceAttributeMultiprocessorCount, dev);
    (void)hipFuncSetAttribute((const void*)mk_fwd, hipFuncAttributeMaxDynamicSharedMemorySize, LDS_BYTES);
    (void)hipOccupancyMaxActiveBlocksPerMultiprocessor(&per_cu, (const void*)mk_fwd, 512, LDS_BYTES);
    if (per_cu < 1 || cus < 1) { fprintf(stderr, "kernel_launch: occupancy %d cus %d\n", per_cu, cus); grid_blocks = -1; return; }
    grid_blocks = cus;
  }
  if (grid_blocks < 0) return;
  Params p{};
  for (int i = 0; i < 34; ++i) p.in[i] = (const float*)d_in[i];
  p.out = (float*)d_out; p.ws = (unsigned char*)d_ws;
  if (hipMemsetAsync((unsigned char*)d_ws + WS_BAR, 0, 16384, stream) != hipSuccess) { fprintf(stderr, "kernel_launch: memset of the barrier words failed\n"); return; }
  void* args[] = {&p};
  hipError_t e = hipLaunchCooperativeKernel((const void*)mk_fwd, dim3(grid_blocks), dim3(512), args, LDS_BYTES, stream);
  if (e != hipSuccess) fprintf(stderr, "cooperative launch failed: %s (grid %d)\n", hipGetErrorString(e), grid_blocks);
}
```

```cpp
#include <hip/hip_runtime.h>
namespace pg8 {
#define PG8_LAS __attribute__((address_space(3)))
typedef unsigned short bf16_t;
typedef short bf16x8 __attribute__((ext_vector_type(8)));
typedef float f32x4 __attribute__((ext_vector_type(4)));
typedef unsigned u32x4 __attribute__((ext_vector_type(4)));
constexpr int BM = 256, BK = 64, HALF = 128, HTB = HALF * BK * 2  , STAGE_BYTES = 8 * HTB, NXCD = 8, WGM = 8;

__host__ __device__ __forceinline__ int lds_byte(int r, int c) { const int st = (r >> 4) * 2 + (c >> 5), rr = r & 15, cc = c & 31, ob = rr * 64 + cc * 2; return st * 1024 + (ob ^ (((ob >> 9) & 1) << 5)); }
__host__ __device__ __forceinline__ void stage_rc(int b, int& R, int& C) { const int st = b / 1024, sb = b % 1024, swz = sb ^ (((sb >> 9) & 1) << 5); R = (st >> 1) * 16 + swz / 64; C = (st & 1) * 32 + (swz % 64) / 2; }
__host__ __device__ __forceinline__ int perm32(int rho) { const int n = rho >> 4, i = rho & 15; return 8 * (i >> 2) + 4 * n + (i & 3); }

struct Unit { int pm, pn; };
struct Gemm { const bf16_t* A; const bf16_t* Bt; int M, N, K, kn; };

struct StaticOrder {
    int nM, nN, nwg, G, c;
    __host__ __device__ void init(int M, int N, int G_, int c_) { nM = M / BM; nN = N / BM; nwg = nM * nN; G = G_; c = c_; }
    __host__ __device__ bool next(int i, Unit& u) const {
        const long L = (long)i * G + c; if (L >= nwg) return false;
        int wgid = (int)L; { const int q = nwg / NXCD, r = nwg % NXCD, xcd = wgid % NXCD, off = wgid / NXCD; wgid = (xcd < r ? xcd * (q + 1) : r * (q + 1) + (xcd - r) * q) + off; }
        const int nig = WGM * nN, gid = wgid / nig, fm = gid * WGM, gsz = (nM - fm) < WGM ? (nM - fm) : WGM;
        u.pm = fm + ((wgid % nig) % gsz); u.pn = (wgid % nig) / gsz; return true;
    }
    __device__ __forceinline__ void a_ready(const Unit&) const {}
    __device__ __forceinline__ void done(const Unit&) const {}
};
struct CountedOrder : StaticOrder {
    const unsigned* ready; unsigned need; unsigned* tmo;
    __device__ __forceinline__ void a_ready(const Unit& u) const {
        if (threadIdx.x < 64) {
            const unsigned long long t0 = __builtin_amdgcn_s_memrealtime(); unsigned polls = 0;
            while ((unsigned)__builtin_amdgcn_readfirstlane(__hip_atomic_load(ready + 64 * u.pm, __ATOMIC_RELAXED, __HIP_MEMORY_SCOPE_AGENT)) < need) {
                if ((++polls & 255u) == 0u && __builtin_amdgcn_readfirstlane(__hip_atomic_load(tmo, __ATOMIC_RELAXED, __HIP_MEMORY_SCOPE_AGENT)) != 0u) break;
                if (__builtin_amdgcn_s_memrealtime() - t0 > 2000000ull) {
                    if (threadIdx.x == 0) { unsigned expect = 0u; __hip_atomic_compare_exchange_strong(tmo + 1, &expect, 0x600u | (unsigned)(u.pm & 0xff), __ATOMIC_RELAXED, __ATOMIC_RELAXED, __HIP_MEMORY_SCOPE_AGENT); __hip_atomic_store(tmo, 1u, __ATOMIC_RELAXED, __HIP_MEMORY_SCOPE_AGENT); }
                    break; }
                __builtin_amdgcn_s_sleep(2); }
            __builtin_amdgcn_fence(__ATOMIC_ACQUIRE, "agent");
            asm volatile("s_waitcnt vmcnt(0)" ::: "memory");
        }
#if !defined(BROKEN_HOOK_NO_BARRIER)
        asm volatile("" ::: "memory"); __builtin_amdgcn_s_barrier(); asm volatile("" ::: "memory");
#endif
    }
};

__device__ __forceinline__ unsigned cvt_pk_bf16(float lo, float hi) { unsigned r; asm volatile("v_cvt_pk_bf16_f32 %0, %1, %2" : "=v"(r) : "v"(lo), "v"(hi)); return r; }
typedef float f32x2 __attribute__((ext_vector_type(2)));
__device__ __forceinline__ f32x2 gelu_pk(f32x2 v) {
    const f32x2 av = __builtin_elementwise_abs(v), d = av * 0.2316418882f + 1.0f;
    f32x2 t; t.x = __builtin_amdgcn_rcpf(d.x); t.y = __builtin_amdgcn_rcpf(d.y);
    f32x2 q = t * 0.5307027145f + (-0.7265760135f); q = q * t + 0.7107068705f; q = q * t + (-0.142248368f); q = q * t + 0.127414796f; q = q * t;
    const f32x2 s = (v * v) * (-0.72134752044f);
    f32x2 e; e.x = __builtin_amdgcn_exp2f(s.x); e.y = __builtin_amdgcn_exp2f(s.y);
    const f32x2 m = v * (q * e), r = v - m;
    f32x2 o; o.x = v.x < 0.f ? m.x : r.x; o.y = v.y < 0.f ? m.y : r.y; return o;
}

struct EpiF32 {
    static constexpr bool PERM = false, AFTER_DRAIN = false;
    float* C; int ldc; const float* bias;
    __device__ __forceinline__ void operator()(const f32x4 (&acc)[2][2][4][2], const Unit& u, int wr, int wc, int fr, int fq) const {
        const int row0 = u.pm * BM + wr * 64 + fr, col0 = u.pn * BM + wc * 32 + 4 * fq;
        f32x4 bv[2][2];
#pragma unroll
        for (int bj = 0; bj < 2; ++bj)
#pragma unroll
            for (int n = 0; n < 2; ++n) bv[bj][n] = bias ? *(const f32x4*)(bias + col0 + bj * HALF + n * 16) : (f32x4){0.f, 0.f, 0.f, 0.f};
#pragma unroll
        for (int ai = 0; ai < 2; ++ai)
#pragma unroll
            for (int m = 0; m < 4; ++m) { float* rowp = C + (size_t)(row0 + ai * HALF + m * 16) * ldc + col0;
#pragma unroll
                for (int bj = 0; bj < 2; ++bj)
#pragma unroll
                    for (int n = 0; n < 2; ++n) *(f32x4*)(rowp + bj * HALF + n * 16) = acc[ai][bj][m][n] + bv[bj][n]; }
    }
};
template <int ACT  > struct EpiBf16 {
    static constexpr bool PERM = true, AFTER_DRAIN = false;
    bf16_t* O; int ldc; const float* bias; int split_cols; size_t split_stride;
    __device__ __forceinline__ void operator()(const f32x4 (&acc)[2][2][4][2], const Unit& u, int wr, int wc, int fr, int fq) const {
        const int row0 = u.pm * BM + wr * 64 + fr; int colt = u.pn * BM; bf16_t* base = O;
        if (split_cols) { const int t = colt / split_cols; base += (size_t)t * split_stride; colt -= t * split_cols; }
        const int col0 = colt + wc * 32 + 8 * fq, bcol0 = u.pn * BM + wc * 32 + 8 * fq;
        f32x4 bv[2][2];
#pragma unroll
        for (int bj = 0; bj < 2; ++bj)
#pragma unroll
            for (int n = 0; n < 2; ++n) bv[bj][n] = bias ? *(const f32x4*)(bias + bcol0 + bj * HALF + 4 * n) : (f32x4){0.f, 0.f, 0.f, 0.f};
#pragma unroll
        for (int ai = 0; ai < 2; ++ai)
#pragma unroll
            for (int m = 0; m < 4; ++m) { bf16_t* rowp = base + (size_t)(row0 + ai * HALF + m * 16) * ldc + col0;
#pragma unroll
                for (int bj = 0; bj < 2; ++bj) { f32x4 v0 = acc[ai][bj][m][0] + bv[bj][0], v1 = acc[ai][bj][m][1] + bv[bj][1];
                    if (ACT == 1) { f32x2 a = gelu_pk((f32x2){v0[0], v0[1]}), b = gelu_pk((f32x2){v0[2], v0[3]}), c = gelu_pk((f32x2){v1[0], v1[1]}), d = gelu_pk((f32x2){v1[2], v1[3]});
                        v0 = (f32x4){a.x, a.y, b.x, b.y}; v1 = (f32x4){c.x, c.y, d.x, d.y}; }
                    if (ACT == 2) {
#pragma unroll
                        for (int j = 0; j < 4; ++j) { v0[j] = 0.5f * v0[j] * (1.0f + erff(v0[j] * 0.70710678f)); v1[j] = 0.5f * v1[j] * (1.0f + erff(v1[j] * 0.70710678f)); } }
                    u32x4 w; w.x = cvt_pk_bf16(v0[0], v0[1]); w.y = cvt_pk_bf16(v0[2], v0[3]); w.z = cvt_pk_bf16(v1[0], v1[1]); w.w = cvt_pk_bf16(v1[2], v1[3]);
                    *(u32x4*)(rowp + bj * HALF) = w; } }
    }
};

struct PanelStats {
    unsigned* xbuf;
    unsigned* cnt;
    unsigned* tmo;
    int ntn; float eps;
    unsigned code;
    __device__ __forceinline__ bool run(const f32x4 (&v)[2][2][4][2], const Unit& u, int wr, int wc, int fr, int fq, PG8_LAS unsigned char* lds, int wid, int lane) const {
        typedef float f32x2v __attribute__((ext_vector_type(2)));
        PG8_LAS f32x2v* P = (PG8_LAS f32x2v*)lds;
        PG8_LAS f32x2v* S = (PG8_LAS f32x2v*)(lds + 8192);
        PG8_LAS unsigned* flag = (PG8_LAS unsigned*)(lds + 8192 + 2048);
#pragma unroll
        for (int ai = 0; ai < 2; ++ai)
#pragma unroll
            for (int m = 0; m < 4; ++m) {
                float s = 0.f;
#pragma unroll
                for (int bj = 0; bj < 2; ++bj)
#pragma unroll
                    for (int n = 0; n < 2; ++n) { const f32x4 x = v[ai][bj][m][n]; s += (x[0] + x[1]) + (x[2] + x[3]); }
                s += __shfl_xor(s, 16); s += __shfl_xor(s, 32);
                const float mw = s * (1.0f / 64.0f); float q = 0.f;
#pragma unroll
                for (int bj = 0; bj < 2; ++bj)
#pragma unroll
                    for (int n = 0; n < 2; ++n) { const f32x4 d = v[ai][bj][m][n] - mw; q += (d[0] * d[0] + d[1] * d[1]) + (d[2] * d[2] + d[3] * d[3]); }
                q += __shfl_xor(q, 16); q += __shfl_xor(q, 32);
                if (fq == 0) P[(ai * HALF + wr * 64 + m * 16 + fr) * 4 + wc] = (f32x2v){mw, q};
            }
        asm volatile("s_waitcnt lgkmcnt(0)" ::: "memory"); __builtin_amdgcn_s_barrier(); asm volatile("" ::: "memory");
#if defined(BROKEN_NO_WAIT)
        if (blockIdx.x >= 64) { const long long t0 = clock64(); while (clock64() - t0 < 60000) __builtin_amdgcn_s_sleep(8); }
#endif
        const int row = wid * 32 + (lane & 31);
        if (lane < 32) {
            const f32x2v a = P[row * 4 + 0], b = P[row * 4 + 1], c = P[row * 4 + 2], d = P[row * 4 + 3];
            const float mt = (a.x + b.x + c.x + d.x) * 0.25f;
            const float da = a.x - mt, db = b.x - mt, dc = c.x - mt, dd = d.x - mt;
            const float m2 = (a.y + b.y) + (c.y + d.y) + 64.0f * ((da * da + db * db) + (dc * dc + dd * dd));
            unsigned long long* slot = (unsigned long long*)xbuf + ((size_t)(u.pm * BM + row) * 4 + u.pn);
            __hip_atomic_store(slot, ((unsigned long long)__float_as_uint(m2) << 32) | __float_as_uint(mt), __ATOMIC_RELAXED, __HIP_MEMORY_SCOPE_AGENT);
        }
        asm volatile("s_waitcnt vmcnt(0)" ::: "memory");
        if (lane == 0) __hip_atomic_fetch_add(cnt + 64 * u.pm, 1u, __ATOMIC_RELAXED, __HIP_MEMORY_SCOPE_AGENT);
        if (wid == 0) {
            bool dead = false; const unsigned long long t0 = __builtin_amdgcn_s_memrealtime(); const unsigned want = 8u * (unsigned)ntn;
            for (;;) {
#if defined(BROKEN_NO_WAIT)
                break;
#endif
                if ((unsigned)__builtin_amdgcn_readfirstlane(__hip_atomic_load(cnt + 64 * u.pm, __ATOMIC_RELAXED, __HIP_MEMORY_SCOPE_AGENT)) >= want) break;
                if (__builtin_amdgcn_s_memrealtime() - t0 > 2000000ull) {
                    if (lane == 0) { unsigned expect = 0u; __hip_atomic_compare_exchange_strong(tmo + 1, &expect, code | (unsigned)(u.pm & 0xff), __ATOMIC_RELAXED, __ATOMIC_RELAXED, __HIP_MEMORY_SCOPE_AGENT);
                                     __hip_atomic_store(tmo, 1u, __ATOMIC_RELAXED, __HIP_MEMORY_SCOPE_AGENT); }
                    dead = true; break; }
                __builtin_amdgcn_s_sleep(2);
            }
            __builtin_amdgcn_fence(__ATOMIC_ACQUIRE, "agent");
            if (lane == 0) flag[0] = dead ? 1u : 0u;
        }
        asm volatile("s_waitcnt vmcnt(0) lgkmcnt(0)" ::: "memory"); __builtin_amdgcn_s_barrier(); asm volatile("" ::: "memory");
        const bool bad = flag[0] != 0u;
        if (lane < 32) {
            const unsigned long long* slot = (const unsigned long long*)xbuf + (size_t)(u.pm * BM + row) * 4; float mt[4], m2[4]; float ms = 0.f;
#pragma unroll
            for (int t = 0; t < 4; ++t) { if (t < ntn) { const unsigned long long w = __hip_atomic_load(slot + t, __ATOMIC_RELAXED, __HIP_MEMORY_SCOPE_AGENT); mt[t] = __uint_as_float((unsigned)w); m2[t] = __uint_as_float((unsigned)(w >> 32)); } else { mt[t] = 0.f; m2[t] = 0.f; } ms += mt[t]; }
            const float mean = ms / (float)ntn; float q = 0.f;
#pragma unroll
            for (int t = 0; t < 4; ++t) if (t < ntn) { const float dm = mt[t] - mean; q += m2[t] + 256.0f * dm * dm; }
            S[row] = (f32x2v){mean, 1.0f / sqrtf(q / (256.0f * (float)ntn) + eps)};
        }
        asm volatile("s_waitcnt lgkmcnt(0)" ::: "memory"); __builtin_amdgcn_s_barrier(); asm volatile("" ::: "memory");
        return bad;
    }
};
struct EpiLnRes {
    static constexpr bool PERM = false, AFTER_DRAIN = true;
    const float* base; float* out; int ldc; const float* bias; PanelStats st; unsigned poison;
    __device__ __forceinline__ void refuse(size_t i0, size_t stride, int M, int N) const { const float q = __builtin_nanf(""); for (size_t i = i0; i < (size_t)M * N; i += stride) out[(i / N) * ldc + i % N] = q;
        if (i0 == 0) { unsigned expect = 0u; __hip_atomic_compare_exchange_strong(st.tmo + 1, &expect, 0x7f0u, __ATOMIC_RELAXED, __ATOMIC_RELAXED, __HIP_MEMORY_SCOPE_AGENT); __hip_atomic_store(st.tmo, 1u, __ATOMIC_RELAXED, __HIP_MEMORY_SCOPE_AGENT); } }
    __device__ __forceinline__ void fused(f32x4 (&acc)[2][2][4][2], const Unit& u, int wr, int wc, int fr, int fq, PG8_LAS unsigned char* lds, int wid, int lane) const {
        typedef float f32x2v __attribute__((ext_vector_type(2)));
        const PG8_LAS f32x2v* S = (const PG8_LAS f32x2v*)(lds + 8192);
        const int col0 = u.pn * BM + wc * 32 + 4 * fq;
#pragma unroll
        for (int bj = 0; bj < 2; ++bj)
#pragma unroll
            for (int n = 0; n < 2; ++n) { const f32x4 bv = bias ? *(const f32x4*)(bias + col0 + bj * HALF + n * 16) : (f32x4){0.f, 0.f, 0.f, 0.f};
#pragma unroll
                for (int ai = 0; ai < 2; ++ai)
#pragma unroll
                    for (int m = 0; m < 4; ++m) acc[ai][bj][m][n] += bv; }
        const bool bad = st.run(acc, u, wr, wc, fr, fq, lds, wid, lane) || poison != 0u;
        const float qnan = __builtin_nanf("");
#pragma unroll
        for (int ai = 0; ai < 2; ++ai)
#pragma unroll
            for (int m = 0; m < 4; ++m) { const int r = ai * HALF + wr * 64 + m * 16 + fr; const f32x2v sr = S[r]; const size_t off = (size_t)(u.pm * BM + r) * ldc + col0;
#pragma unroll
                for (int bj = 0; bj < 2; ++bj)
#pragma unroll
                    for (int n = 0; n < 2; ++n) { const f32x4 bs = *(const f32x4*)(base + off + bj * HALF + n * 16); f32x4 o = bs + (acc[ai][bj][m][n] - sr.x) * sr.y;
                        if (bad) o = (f32x4){qnan, qnan, qnan, qnan}; *(f32x4*)(out + off + bj * HALF + n * 16) = o; }
                asm volatile("" ::: "memory"); }
    }
};
struct EpiLnResLn {
    static constexpr bool PERM = false, AFTER_DRAIN = true;
    const float* base; float* out; bf16_t* xn; int ldc; const float* bias; PanelStats st1, st2; unsigned poison;
    __device__ __forceinline__ void refuse(size_t i0, size_t stride, int M, int N) const { const float q = __builtin_nanf(""); for (size_t i = i0; i < (size_t)M * N; i += stride) { const size_t o = (i / N) * ldc + i % N; out[o] = q; xn[o] = (bf16_t)0x7fc0u; }
        if (i0 == 0) { unsigned expect = 0u; __hip_atomic_compare_exchange_strong(st1.tmo + 1, &expect, 0x7f0u, __ATOMIC_RELAXED, __ATOMIC_RELAXED, __HIP_MEMORY_SCOPE_AGENT); __hip_atomic_store(st1.tmo, 1u, __ATOMIC_RELAXED, __HIP_MEMORY_SCOPE_AGENT); } }
    __device__ __forceinline__ void fused(f32x4 (&acc)[2][2][4][2], const Unit& u, int wr, int wc, int fr, int fq, PG8_LAS unsigned char* lds, int wid, int lane) const {
        typedef float f32x2v __attribute__((ext_vector_type(2))); typedef unsigned u32x2v __attribute__((ext_vector_type(2)));
        const PG8_LAS f32x2v* S = (const PG8_LAS f32x2v*)(lds + 8192);
        const int col0 = u.pn * BM + wc * 32 + 4 * fq;
#pragma unroll
        for (int bj = 0; bj < 2; ++bj)
#pragma unroll
            for (int n = 0; n < 2; ++n) { const f32x4 bv = bias ? *(const f32x4*)(bias + col0 + bj * HALF + n * 16) : (f32x4){0.f, 0.f, 0.f, 0.f};
#pragma unroll
                for (int ai = 0; ai < 2; ++ai)
#pragma unroll
                    for (int m = 0; m < 4; ++m) acc[ai][bj][m][n] += bv; }
        bool bad = st1.run(acc, u, wr, wc, fr, fq, lds, wid, lane) || poison != 0u;
        const float qnan = __builtin_nanf("");
#pragma unroll
        for (int ai = 0; ai < 2; ++ai)
#pragma unroll
            for (int m = 0; m < 4; ++m) { const int r = ai * HALF + wr * 64 + m * 16 + fr; const f32x2v sr = S[r]; const size_t off = (size_t)(u.pm * BM + r) * ldc + col0;
#pragma unroll
                for (int bj = 0; bj < 2; ++bj)
#pragma unroll
                    for (int n = 0; n < 2; ++n) { const f32x4 bs = *(const f32x4*)(base + off + bj * HALF + n * 16); acc[ai][bj][m][n] = bs + (acc[ai][bj][m][n] - sr.x) * sr.y; }
                asm volatile("" : "+v"(acc[ai][0][m][0]), "+v"(acc[ai][0][m][1]), "+v"(acc[ai][1][m][0]), "+v"(acc[ai][1][m][1]));
                if (m & 1) asm volatile("" ::: "memory"); }
        const bool bad1 = bad;
        bad = st2.run(acc, u, wr, wc, fr, fq, lds, wid, lane) || bad;
#pragma unroll
        for (int ai = 0; ai < 2; ++ai)
#pragma unroll
            for (int m = 0; m < 4; ++m) { const int r = ai * HALF + wr * 64 + m * 16 + fr; const f32x2v sr = S[r]; const size_t off = (size_t)(u.pm * BM + r) * ldc + col0;
#pragma unroll
                for (int bj = 0; bj < 2; ++bj)
#pragma unroll
                    for (int n = 0; n < 2; ++n) { const f32x4 x1 = acc[ai][bj][m][n]; *(f32x4*)(out + off + bj * HALF + n * 16) = bad1 ? (f32x4){qnan, qnan, qnan, qnan} : x1;
                        const f32x4 o = (x1 - sr.x) * sr.y; u32x2v w; w.x = cvt_pk_bf16(o[0], o[1]); w.y = cvt_pk_bf16(o[2], o[3]);
                        if (bad) { w.x = 0x7fc07fc0u; w.y = 0x7fc07fc0u; } *(u32x2v*)(xn + off + bj * HALF + n * 16) = w; }
                asm volatile("" ::: "memory"); }
    }
};

template <class Epi, class Sched, bool STAMP = false>
__device__ __forceinline__ void gemm_phase(PG8_LAS unsigned char* lds, const Gemm g, const Sched& S, const Epi& E, unsigned long long* stamps) {
    int tid_l = threadIdx.x; asm volatile("" : "+v"(tid_l));
    const int tid = tid_l, wid = __builtin_amdgcn_readfirstlane(tid >> 6), lane = tid & 63, wr = wid >> 2, wc = wid & 3, fr = lane & 15, fq = lane >> 4;
    const int K = g.K, nt = g.kn / BK;
    int ts_lo = 0, ts_hi = 0, nts = 0; const unsigned long long rt_entry = STAMP ? (unsigned long long)wall_clock64() : 0ull;
#define PG8_STAMP() do { if (STAMP && wid == 0 && nts < 64) { const unsigned long long _c = (unsigned long long)clock64(); \
        ts_lo = (lane == nts) ? (int)(unsigned)_c : ts_lo; ts_hi = (lane == nts) ? (int)(unsigned)(_c >> 32) : ts_hi; ++nts; } } while (0)
    PG8_STAMP();
    unsigned voffA[2], voffB[2];
#pragma unroll
    for (int i = 0; i < 2; ++i) { int R, C; stage_rc(tid * 16 + i * 8192, R, C); const int Rb = Epi::PERM ? ((R & ~31) + perm32(R & 31)) : R;
        voffA[i] = (unsigned)(R * K + C) * 2u; voffB[i] = (unsigned)(Rb * K + C) * 2u; }
    const size_t kstep = (size_t)(BK * 2);
    const size_t hstep = (size_t)HALF * K * 2;
    const size_t tstep = 2 * hstep;
    const unsigned ldsw = (unsigned)wid * 1024u;
    const int aoff = lds_byte(wr * 64 + fr, fq * 8), boff = lds_byte(wc * 32 + fr, fq * 8);
#define PG8_SA(b, h) (((b) * 2 + (h)) * HTB)
#define PG8_SB(b, h) ((4 + (b) * 2 + (h)) * HTB)
#define PG8_STAGE(bufoff, gbase, voff) do { _Pragma("unroll") for (int _i = 0; _i < 2; ++_i) \
        __builtin_amdgcn_global_load_lds((const unsigned*)((const char*)(gbase) + (voff)[_i]), (PG8_LAS unsigned*)(lds + (bufoff) + ldsw + _i * 8192), 16, 0, 0); } while (0)
#define PG8_LDA(dst, b, h) do { _Pragma("unroll") for (int m = 0; m < 4; ++m) _Pragma("unroll") for (int k = 0; k < 2; ++k) dst[m][k] = *(const PG8_LAS bf16x8*)(lds + PG8_SA(b, h) + aoff + m * 2048 + k * 1024); } while (0)
#define PG8_LDB(dst, b, h) do { _Pragma("unroll") for (int n = 0; n < 2; ++n) _Pragma("unroll") for (int k = 0; k < 2; ++k) dst[n][k] = *(const PG8_LAS bf16x8*)(lds + PG8_SB(b, h) + boff + n * 2048 + k * 1024); } while (0)
#define PG8_MMA(ai, bj, At, Bt) do { __builtin_amdgcn_s_setprio(1); _Pragma("unroll") for (int m = 0; m < 4; ++m) _Pragma("unroll") for (int n = 0; n < 2; ++n) _Pragma("unroll") for (int k = 0; k < 2; ++k) \
        acc[ai][bj][m][n] = __builtin_amdgcn_mfma_f32_16x16x32_bf16(Bt[n][k], At[m][k], acc[ai][bj][m][n], 0, 0, 0); __builtin_amdgcn_s_setprio(0); } while (0)
#define PG8_WAIT_V(n) asm volatile("s_waitcnt vmcnt(" #n ")" ::: "memory")
#define PG8_WAIT_L(n) asm volatile("s_waitcnt lgkmcnt(" #n ")" ::: "memory")
#define PG8_BAR __builtin_amdgcn_s_barrier()
#define PG8_SCHED __builtin_amdgcn_sched_barrier(0)
    Unit cur, nxt; int ui = 0;
    if (!S.next(0, cur)) return;
    f32x4 acc[2][2][4][2];
#pragma unroll
    for (int a = 0; a < 2; ++a)
#pragma unroll
        for (int b = 0; b < 2; ++b)
#pragma unroll
            for (int m = 0; m < 4; ++m)
#pragma unroll
                for (int n = 0; n < 2; ++n) acc[a][b][m][n] = (f32x4){0.f, 0.f, 0.f, 0.f};
    bf16x8 At[4][2], B0[2][2], B1[2][2];
    const char* cA = (const char*)g.A + (size_t)cur.pm * tstep; const char* cB = (const char*)g.Bt + (size_t)cur.pn * tstep;
    S.a_ready(cur);
    PG8_STAGE(PG8_SB(0, 0), cB, voffB); PG8_STAGE(PG8_SA(0, 0), cA, voffA); PG8_STAGE(PG8_SB(0, 1), cB + hstep, voffB); PG8_STAGE(PG8_SA(0, 1), cA + hstep, voffA);
    if (wr == 1) PG8_BAR;
    PG8_WAIT_V(4); PG8_BAR;
    PG8_STAGE(PG8_SB(1, 0), cB + kstep, voffB); PG8_STAGE(PG8_SA(1, 0), cA + kstep, voffA); PG8_STAGE(PG8_SB(1, 1), cB + hstep + kstep, voffB);
    PG8_WAIT_V(6); PG8_BAR;
    PG8_STAMP();
    for (;;) {
        const bool has_next = S.next(ui + 1, nxt);
        const char* nA = has_next ? (const char*)g.A + (size_t)nxt.pm * tstep : cA; const char* nB = has_next ? (const char*)g.Bt + (size_t)nxt.pn * tstep : cB;
        for (int t = 0; t < nt; t += 2) {
            const bool last = (t == nt - 2);
            const char* a1 = cA + (size_t)(t + 1) * kstep;
            const char* a2 = last ? nA : cA + (size_t)(t + 2) * kstep; const char* b2 = last ? nB : cB + (size_t)(t + 2) * kstep;
            const char* a3 = a2 + kstep; const char* b3 = b2 + kstep;
            if (last && has_next) S.a_ready(nxt);
            PG8_LDB(B0, 0, 0); PG8_SCHED; PG8_LDA(At, 0, 0); PG8_STAGE(PG8_SA(1, 1), a1 + hstep, voffA);
            PG8_WAIT_L(8); PG8_BAR; PG8_WAIT_L(0); PG8_MMA(0, 0, At, B0); PG8_BAR; PG8_SCHED;
            PG8_LDB(B1, 0, 1); PG8_STAGE(PG8_SB(0, 0), b2, voffB);
            PG8_BAR; PG8_WAIT_L(0); PG8_MMA(0, 1, At, B1); PG8_BAR;
            PG8_LDA(At, 0, 1); PG8_STAGE(PG8_SA(0, 0), a2, voffA);
            PG8_BAR; PG8_WAIT_L(0); PG8_MMA(1, 0, At, B0); PG8_BAR; PG8_SCHED;
            PG8_STAGE(PG8_SB(0, 1), b2 + hstep, voffB);
            PG8_WAIT_V(6); PG8_BAR; PG8_MMA(1, 1, At, B1); PG8_BAR;
            PG8_LDB(B0, 1, 0); PG8_SCHED; PG8_LDA(At, 1, 0); PG8_STAGE(PG8_SA(0, 1), a2 + hstep, voffA);
            PG8_WAIT_L(8); PG8_BAR; PG8_WAIT_L(0); PG8_MMA(0, 0, At, B0); PG8_BAR; PG8_SCHED;
            PG8_LDB(B1, 1, 1); PG8_STAGE(PG8_SB(1, 0), b3, voffB);
            PG8_BAR; PG8_WAIT_L(0); PG8_MMA(0, 1, At, B1); PG8_BAR;
            PG8_LDA(At, 1, 1); PG8_STAGE(PG8_SA(1, 0), a3, voffA);
            PG8_BAR; PG8_WAIT_L(0); PG8_MMA(1, 0, At, B0); PG8_BAR; PG8_SCHED;
            PG8_STAGE(PG8_SB(1, 1), b3 + hstep, voffB);
            PG8_WAIT_V(6); PG8_BAR; PG8_MMA(1, 1, At, B1); PG8_BAR;
        }
        PG8_STAMP();
        if constexpr (!Epi::AFTER_DRAIN) { E(acc, cur, wr, wc, fr, fq); S.done(cur); }
        PG8_STAMP();
        if (!has_next) break;
#pragma unroll
        for (int a = 0; a < 2; ++a)
#pragma unroll
            for (int b = 0; b < 2; ++b)
#pragma unroll
                for (int m = 0; m < 4; ++m)
#pragma unroll
                    for (int n = 0; n < 2; ++n) acc[a][b][m][n] = (f32x4){0.f, 0.f, 0.f, 0.f};
        cur = nxt; cA = nA; cB = nB; ++ui;
    }
    PG8_WAIT_V(0);
    if (wr == 0) PG8_BAR;
    PG8_BAR;
    if constexpr (Epi::AFTER_DRAIN) { E.fused(acc, cur, wr, wc, fr, fq, lds, wid, lane); S.done(cur); }
    PG8_STAMP();
    if (STAMP && wid == 0) { stamps[lane] = lane < nts ? (((unsigned long long)(unsigned)ts_hi << 32) | (unsigned)ts_lo) : 0ull;
        if (lane == 62) stamps[62] = rt_entry; if (lane == 63) stamps[63] = (unsigned long long)wall_clock64(); }
#undef PG8_STAMP
#undef PG8_SA
#undef PG8_SB
#undef PG8_STAGE
#undef PG8_LDA
#undef PG8_LDB
#undef PG8_MMA
#undef PG8_WAIT_V
#undef PG8_WAIT_L
#undef PG8_BAR
#undef PG8_SCHED
}
}

#include <hip/hip_cooperative_groups.h>
#include <cstdio>
namespace cg = cooperative_groups;
using namespace pg8;
#define LAS PG8_LAS
typedef float f32x16 __attribute__((ext_vector_type(16)));
typedef unsigned u32x2 __attribute__((ext_vector_type(2)));
typedef float f32x2 __attribute__((ext_vector_type(2)));

constexpr int D = 1024, NB = 8, SEQ = 2048, CTXL = 256, NLAT = NB * SEQ, NCTX = NB * CTXL, NROW = NLAT + NCTX, DFF = 2816;
constexpr float ALPHA_F = 1.41421356237309515f;
constexpr int LDS_BYTES = 135168;
#define PROBE_MASK 0
#define PROBE_REP(bit) for (int rep_ = 0; rep_ < ((PROBE_MASK & (bit)) ? 2 : 1); ++rep_)

constexpr size_t al256(size_t x) { return (x + 255) & ~(size_t)255; }
constexpr size_t WS_MOD = 0;
constexpr size_t WS_KF = al256(WS_MOD + (size_t)2 * 9 * 9216 * 4);
constexpr size_t WS_KFC = al256(WS_KF + (size_t)512 * 4096 * 4);
constexpr size_t WS_XCTX = al256(WS_KFC + (size_t)512 * 512 * 4);
constexpr size_t WS_AGG = al256(WS_XCTX + (size_t)NCTX * D * 4);
constexpr size_t WS_WFI = al256(WS_AGG + (size_t)2 * 8 * 72 * 512 * 2 * 4);
constexpr size_t SZ_WFI = (size_t)5632 * 1024 * 2;
constexpr size_t WS_WFO = al256(WS_WFI + 4 * SZ_WFI);
constexpr size_t SZ_WFO = (size_t)1024 * 2816 * 2;
constexpr size_t WS_WEI = al256(WS_WFO + 4 * SZ_WFO);
constexpr size_t WS_WEO = al256(WS_WEI + (size_t)2560 * 1024 * 2);
constexpr size_t WS_WRG = al256(WS_WEO + (size_t)1024 * 1024 * 2);
constexpr size_t WS_WMI = al256(WS_WRG + (size_t)2048 * 512 * 2);
constexpr size_t WS_WQU = al256(WS_WMI + (size_t)1280 * 1024 * 2);
constexpr size_t WS_WKU = al256(WS_WQU + (size_t)1536 * 768 * 2);
constexpr size_t WS_WVU = al256(WS_WKU + (size_t)1024 * 256 * 2);
constexpr size_t WS_WMO = al256(WS_WVU + (size_t)1024 * 256 * 2);
constexpr size_t WS_H = al256(WS_WMO + (size_t)1024 * 1024 * 2);
constexpr size_t WS_ACT = al256(WS_H + (size_t)NROW * D * 2);
constexpr size_t WS_G = al256(WS_ACT + (size_t)NROW * DFF * 2);
constexpr size_t WS_XC = al256(WS_G + (size_t)NROW * 2048 * 2);
constexpr size_t WS_YT = al256(WS_XC + (size_t)NROW * 512 * 2);
constexpr size_t WS_BAR = al256(WS_YT + (size_t)512 * NROW * 2);
constexpr size_t WS_END = al256(WS_BAR + 16384);
constexpr size_t WS_UT = WS_ACT;
constexpr size_t WS_URG = al256(WS_UT + (size_t)1536 * NROW * 2);
constexpr size_t WS_P = WS_ACT;
constexpr size_t WS_Q = WS_ACT;
constexpr size_t WS_QN = al256(WS_ACT + (size_t)NLAT * 1536 * 2);
constexpr size_t WS_KVN = al256(WS_QN + (size_t)NLAT * 768 * 2);
constexpr size_t WS_KR = al256(WS_KVN + (size_t)NROW * 256 * 2);
static_assert(WS_KR + (size_t)NROW * 32 * 2 <= WS_G, "layer-1 aliases overflow ACT");
static_assert(WS_URG + (size_t)NROW * 1024 * 2 <= WS_G, "layer-0 aliases overflow ACT");
constexpr size_t WS_K = WS_G;
constexpr size_t WS_VT = WS_G + (size_t)NROW * 1024 * 2;

struct Params { const float* in[34]; float* out; unsigned char* ws; };
enum { I_X = 0, I_C, I_CTX, I_CCTX, I_ADAW, I_ADAB, I_LNG, I_LNB, I_FWI, I_FWO, I_EWI, I_EWO, I_HCW, I_HCB, I_HW1, I_HB1, I_HW2, I_HB2, I_HW3, I_HSF, I_HBIAS,
       I_RCW, I_RCB, I_RAW, I_RAB, I_RXW, I_RXB, I_RLAM, I_MWI, I_MQN, I_MKVN, I_MWQ, I_MWKV, I_MWO };

extern __shared__ __attribute__((aligned(16))) unsigned char lds_raw[];
constexpr int TAB_OFF = LDS_BYTES - 16 - 320;
__device__ __forceinline__ unsigned char* tabptr(int i) {
  const volatile LAS unsigned* t = (const volatile LAS unsigned*)((LAS unsigned char*)lds_raw + TAB_OFF) + 2 * i;
  const unsigned lo = __builtin_amdgcn_readfirstlane(t[0]), hi = __builtin_amdgcn_readfirstlane(t[1]);
  return (unsigned char*)(((size_t)hi << 32) | (size_t)lo);
}
#define PIN(i) ((const float*)tabptr(i))
__device__ __forceinline__ int ltid() { int t = threadIdx.x; asm volatile("" : "+v"(t)); return t; }
#define Q8_EMU 0
__device__ __forceinline__ float q8(float x) { unsigned u = __float_as_uint(x); u += 0x7FFFFu + ((u >> 20) & 1u); u &= 0xFFF00000u; return __uint_as_float(u); }
__device__ __forceinline__ float bf2f(unsigned short b) { return __uint_as_float(((unsigned)b) << 16); }
__device__ __forceinline__ float bflo(unsigned w) { return __uint_as_float(w << 16); }
__device__ __forceinline__ float bfhi(unsigned w) { return __uint_as_float(w & 0xffff0000u); }
__device__ __forceinline__ float wave_sum(float v) {
#pragma unroll
  for (int o = 1; o < 64; o <<= 1) v += __shfl_xor(v, o);
  return v;
}
__device__ __forceinline__ float sigmoidf_(float x) { return 1.0f / (1.0f + __expf(-x)); }

struct EpiSwiGLU {
  static constexpr bool PERM = true, AFTER_DRAIN = false;
  bf16_t* O;
  __device__ __forceinline__ void operator()(const f32x4 (&acc)[2][2][4][2], const Unit& u, int wr, int wc, int fr, int fq) const {
    const int row0 = u.pm * BM + wr * 64 + fr, col0 = u.pn * 128 + wc * 32 + 8 * fq;
#pragma unroll
    for (int ai = 0; ai < 2; ++ai)
#pragma unroll
      for (int m = 0; m < 4; ++m) {
        float v[8];
#pragma unroll
        for (int n = 0; n < 2; ++n)
#pragma unroll
          for (int j = 0; j < 4; ++j) { const float a = acc[ai][0][m][n][j], g = acc[ai][1][m][n][j]; const float sg = __builtin_amdgcn_rcpf(1.0f + __expf(-a)); v[4 * n + j] = a * sg * g; }
        u32x4 w; w.x = cvt_pk_bf16(v[0], v[1]); w.y = cvt_pk_bf16(v[2], v[3]); w.z = cvt_pk_bf16(v[4], v[5]); w.w = cvt_pk_bf16(v[6], v[7]);
        *(u32x4*)(O + (size_t)(row0 + ai * HALF + m * 16) * DFF + col0) = w;
      }
  }
};
struct EpiResid {
  static constexpr bool PERM = true, AFTER_DRAIN = false;
  bf16_t* Y2; const float* mod; int gidx; float gs;
  __device__ __forceinline__ void operator()(const f32x4 (&acc)[2][2][4][2], const Unit& u, int wr, int wc, int fr, int fq) const {
    const int rt = u.pm * BM; const int mr = rt / SEQ;
    const int row0 = rt + wr * 64 + fr, col0 = u.pn * BM + wc * 32 + 8 * fq;
    const float* gp = mod + (size_t)(mr * 9 + gidx) * D + col0;
    f32x4 gv[2][2];
#pragma unroll
    for (int bj = 0; bj < 2; ++bj)
#pragma unroll
      for (int n = 0; n < 2; ++n) gv[bj][n] = *(const f32x4*)(gp + bj * HALF + n * 4) * gs;
#pragma unroll
    for (int ai = 0; ai < 2; ++ai)
#pragma unroll
      for (int m = 0; m < 4; ++m) {
        bf16_t* rowp = Y2 + (size_t)(row0 + ai * HALF + m * 16) * D + col0;
#pragma unroll
        for (int bj = 0; bj < 2; ++bj) { const f32x4 v0 = acc[ai][bj][m][0] * gv[bj][0], v1 = acc[ai][bj][m][1] * gv[bj][1];
          u32x4 w; w.x = cvt_pk_bf16(v0[0], v0[1]); w.y = cvt_pk_bf16(v0[2], v0[3]); w.z = cvt_pk_bf16(v1[0], v1[1]); w.w = cvt_pk_bf16(v1[2], v1[3]);
          *(u32x4*)(rowp + bj * HALF) = w; }
      }
  }
};
struct EpiBf16P {
  static constexpr bool PERM = true, AFTER_DRAIN = false;
  bf16_t* O; size_t ldc;
  __device__ __forceinline__ void operator()(const f32x4 (&acc)[2][2][4][2], const Unit& u, int wr, int wc, int fr, int fq) const {
    const int row0 = u.pm * BM + wr * 64 + fr, col0 = u.pn * BM + wc * 32 + 8 * fq;
#pragma unroll
    for (int ai = 0; ai < 2; ++ai)
#pragma unroll
      for (int m = 0; m < 4; ++m) {
        bf16_t* rowp = O + (size_t)(row0 + ai * HALF + m * 16) * ldc + col0;
#pragma unroll
        for (int bj = 0; bj < 2; ++bj) { const f32x4 v0 = acc[ai][bj][m][0], v1 = acc[ai][bj][m][1];
          u32x4 w; w.x = cvt_pk_bf16(v0[0], v0[1]); w.y = cvt_pk_bf16(v0[2], v0[3]); w.z = cvt_pk_bf16(v1[0], v1[1]); w.w = cvt_pk_bf16(v1[2], v1[3]);
          *(u32x4*)(rowp + bj * HALF) = w; }
      }
  }
};
struct EpiGate {
  static constexpr bool PERM = true, AFTER_DRAIN = false;
  bf16_t* O; const float* ab; const float* xb;
  __device__ __forceinline__ void operator()(const f32x4 (&acc)[2][2][4][2], const Unit& u, int wr, int wc, int fr, int fq) const {
    const int row0 = u.pm * BM + wr * 64 + fr, col0 = u.pn * BM + wc * 32 + 8 * fq;
    f32x4 bv[2][2];
#pragma unroll
    for (int bj = 0; bj < 2; ++bj) { const int c = col0 + bj * HALF, g = c >> 9, e = c & 511; const float* bp = ((g & 1) ? xb : ab) + (g >> 1) * 512 + e;
      bv[bj][0] = *(const f32x4*)bp; bv[bj][1] = *(const f32x4*)(bp + 4); }
#pragma unroll
    for (int ai = 0; ai < 2; ++ai)
#pragma unroll
      for (int m = 0; m < 4; ++m) {
        bf16_t* rowp = O + (size_t)(row0 + ai * HALF + m * 16) * 2048 + col0;
#pragma unroll
        for (int bj = 0; bj < 2; ++bj) { f32x4 v0 = acc[ai][bj][m][0] + bv[bj][0], v1 = acc[ai][bj][m][1] + bv[bj][1];
#pragma unroll
          for (int j = 0; j < 4; ++j) { v0[j] = sigmoidf_(v0[j]); v1[j] = sigmoidf_(v1[j]); }
          u32x4 w; w.x = cvt_pk_bf16(v0[0], v0[1]); w.y = cvt_pk_bf16(v0[2], v0[3]); w.z = cvt_pk_bf16(v1[0], v1[1]); w.w = cvt_pk_bf16(v1[2], v1[3]);
          *(u32x4*)(rowp + bj * HALF) = w; }
      }
  }
};
__device__ __forceinline__ float rope_inv_freq(int p) { return exp2f(-(float)p * (13.287712379549449f / 8.0f)); }
struct EpiQ {
  static constexpr bool PERM = true, AFTER_DRAIN = false;
  bf16_t* O;
  __device__ __forceinline__ void operator()(const f32x4 (&acc)[2][2][4][2], const Unit& u, int wr, int wc, int fr, int fq) const {
    const int row0 = u.pm * BM + wr * 64 + fr, col0 = u.pn * BM + wc * 32 + 8 * fq;
#pragma unroll
    for (int bj = 0; bj < 2; ++bj) {
      const int c8 = col0 + bj * HALF; const int f = c8 % 96; const bool rope = f >= 64; const int rp = f - 64; const int a = (rp >> 4) & 1, e = (rp >> 3) & 1;
      float invf[4];
#pragma unroll
      for (int jj = 0; jj < 4; ++jj) invf[jj] = rope_inv_freq(4 * e + jj);
#pragma unroll
      for (int ai = 0; ai < 2; ++ai)
#pragma unroll
        for (int m = 0; m < 4; ++m) {
          const int row = row0 + ai * HALF + m * 16; const int t = row & (SEQ - 1); const float pos = (float)(a == 0 ? (t >> 6) : (t & 63));
          const f32x4 v0 = acc[ai][bj][m][0], v1 = acc[ai][bj][m][1];
          float v[8] = {v0[0], v0[1], v0[2], v0[3], v1[0], v1[1], v1[2], v1[3]};
          if (rope) {
#pragma unroll
            for (int jj = 0; jj < 4; ++jj) { const float ang = pos * invf[jj]; const float cs = __cosf(ang), sn = __sinf(ang); const float x1 = v[2 * jj], x2 = v[2 * jj + 1];
              v[2 * jj] = x1 * cs - x2 * sn; v[2 * jj + 1] = x2 * cs + x1 * sn; }
          }
          u32x4 w; w.x = cvt_pk_bf16(v[0], v[1]); w.y = cvt_pk_bf16(v[2], v[3]); w.z = cvt_pk_bf16(v[4], v[5]); w.w = cvt_pk_bf16(v[6], v[7]);
          *(u32x4*)(O + (size_t)row * 1536 + c8) = w;
        }
    }
  }
};

enum { MAP_ID = 0, MAP_SWIGLU, MAP_MLAIN, MAP_QUP, MAP_KUP, MAP_VUP, MAP_RG };
struct ConvDesc { int kind, K, ld, tile; const float* W; const float* W2; const float* sc; bf16_t* dst; };
__device__ __forceinline__ void conv_load(const ConvDesc& d, int tid, float (&v)[8]) {
  const int nkt = d.K >> 6; const int kt = d.tile % nkt, nt = d.tile / nkt; const int k0 = kt * 64, n0 = nt * 64;
  const int nn = tid & 63, kq = tid >> 6; const int n = n0 + nn; const int kind = d.kind;
  int col = n;
  if (kind == MAP_SWIGLU) { const int t = n >> 8, h = (n >> 7) & 1, j = n & 127; col = h * DFF + t * 128 + j; }
  else if (kind == MAP_MLAIN) { col = n < 1056 ? n : -1; }
  else if (kind == MAP_QUP) { const int hh = n / 96, f = n % 96; if (f >= 64) { const int rp = f - 64, a = rp >> 4, w = rp & 15, pp = w >> 1, hf = w & 1; col = hh * 96 + 64 + a * 16 + hf * 8 + pp; } }
  else if (kind == MAP_KUP) { col = (n >> 6) * 128 + (n & 63); }
  else if (kind == MAP_VUP) { col = (n >> 6) * 128 + 64 + (n & 63); }
#pragma unroll
  for (int i = 0; i < 8; ++i) {
    const int k = k0 + i * 8 + kq; float x;
    if (kind == MAP_RG) { const int g = n >> 9, e = n & 511, nb = e >> 6; x = ((k >> 6) == nb) ? ((g & 1) ? d.W2 : d.W)[((((g >> 1) * 8 + nb) * 64 + (k & 63)) << 6) + (e & 63)] : 0.f; }
    else x = col >= 0 ? d.W[(size_t)k * d.ld + col] : 0.f;
    if (d.sc) x *= d.sc[k];
    if (Q8_EMU && (kind == MAP_SWIGLU || d.K == 2816)) x = q8(x);
    v[i] = x;
  }
}
__device__ __forceinline__ void conv_store(LAS float* scr, const ConvDesc& d, int tid, const float (&v)[8]) {
  const int nkt = d.K >> 6; const int kt = d.tile % nkt, nt = d.tile / nkt; const int k0 = kt * 64, n0 = nt * 64;
  const int nn = tid & 63, kq = tid >> 6;
#pragma unroll
  for (int i = 0; i < 8; ++i) scr[(i * 8 + kq) * 65 + nn] = v[i];
  __syncthreads();
  { const int nl = tid >> 3, c = tid & 7; const LAS float* s = scr + (8 * c) * 65 + nl;
    u32x4 o; o.x = cvt_pk_bf16(s[0], s[65]); o.y = cvt_pk_bf16(s[2 * 65], s[3 * 65]); o.z = cvt_pk_bf16(s[4 * 65], s[5 * 65]); o.w = cvt_pk_bf16(s[6 * 65], s[7 * 65]);
    *(u32x4*)(d.dst + (size_t)(n0 + nl) * d.K + k0 + 8 * c) = o; }
  __syncthreads();
}
__device__ __forceinline__ void convw_load(const ConvDesc& d, int tid, f32x4 (&v)[8]) {
  const int nkt = d.K >> 6; const int kt = d.tile % nkt, nt = d.tile / nkt; const int k0 = kt * 64;
  const int c4 = (tid & 63) * 4, kq = tid >> 6;
  const int col = d.kind == MAP_SWIGLU ? (c4 < 128 ? nt * 128 + c4 : DFF + nt * 128 + (c4 - 128)) : nt * 256 + c4;
#pragma unroll
  for (int i = 0; i < 8; ++i) v[i] = *(const f32x4*)(d.W + (size_t)(k0 + i * 8 + kq) * d.ld + col);
}
__device__ __forceinline__ void convw_store(LAS float* scr, const ConvDesc& d, int tid, const f32x4 (&v)[8]) {
  const int nkt = d.K >> 6; const int kt = d.tile % nkt, nt = d.tile / nkt; const int k0 = kt * 64, n0 = nt * 256;
  const int c4 = (tid & 63) * 4, kq = tid >> 6;
#pragma unroll
  for (int i = 0; i < 8; ++i) *(LAS f32x4*)(scr + (i * 8 + kq) * 260 + c4) = v[i];
  __syncthreads();
  { const int nl = tid >> 1, ch0 = (tid & 1) * 4;
#pragma unroll
    for (int c = 0; c < 4; ++c) { const LAS float* s = scr + (8 * (ch0 + c)) * 260 + nl;
      u32x4 o; o.x = cvt_pk_bf16(s[0], s[260]); o.y = cvt_pk_bf16(s[2 * 260], s[3 * 260]); o.z = cvt_pk_bf16(s[4 * 260], s[5 * 260]); o.w = cvt_pk_bf16(s[6 * 260], s[7 * 260]);
      *(u32x4*)(d.dst + (size_t)(n0 + nl) * d.K + k0 + 8 * (ch0 + c)) = o; } }
  __syncthreads();
}
__device__ __forceinline__ void adaln_job(LAS float* L, const Params& p, int z, float* MOD, int job, bool fill) {
  const int tid = ltid(); const int l = job / 288, col0 = (job % 288) * 32;
  if (fill) { const float* pc = PIN(I_C); const float* pcc = PIN(I_CCTX); for (int i = tid; i < 9 * 1024; i += 512) { const int r = i >> 10, k = i & 1023; const float x = r < 8 ? pc[r * 1024 + k] : pcc[k]; L[i] = x * sigmoidf_(x); }
    __syncthreads(); }
  const int col = tid & 31, kg = tid >> 5;
  const float* W = PIN(I_ADAW) + (size_t)l * 1024 * 9216 + col0 + col + (size_t)(kg * 64) * 9216;
  float acc[9];
#pragma unroll
  for (int r = 0; r < 9; ++r) acc[r] = 0.f;
#pragma unroll 1
  for (int kb = 0; kb < 64; kb += 16) { float w[16];
#pragma unroll
    for (int j = 0; j < 16; ++j) w[j] = W[(size_t)(kb + j) * 9216];
#pragma unroll
    for (int j = 0; j < 16; ++j)
#pragma unroll
      for (int r = 0; r < 9; ++r) acc[r] += L[r * 1024 + kg * 64 + kb + j] * w[j]; }
  LAS float* part = L + 9 * 1024;
#pragma unroll
  for (int r = 0; r < 9; ++r) part[(kg * 9 + r) * 32 + col] = acc[r];
  __syncthreads();
  if (tid < 288) { const int r = tid >> 5, cc = tid & 31; float s = 0.f;
#pragma unroll
    for (int g = 0; g < 16; ++g) s += part[(g * 9 + r) * 32 + cc];
    MOD[(size_t)(l * 9 + r) * 9216 + col0 + cc] = s + PIN(I_ADAB)[l * 9216 + col0 + cc]; }
  __syncthreads();
}
__device__ __forceinline__ void filter_job(LAS float* Ls, const Params& p, int z, float* KF, int L, int job) {
  const int tid = ltid(); const int pos0 = job * 16;
  LAS float* feats = Ls; LAS float* h1 = Ls + 16 * 33; LAS float* h2 = h1 + 1024;
  for (int e = tid; e < 16 * 33; e += 512) { const int pp = e / 33, i = e % 33; const float pos = (float)(pos0 + pp); const float t = pos / (float)L; float v;
    if (i == 0) v = t;
    else { const int j = (i - 1) & 15; const float band = 1e-4f + (float)j * ((15.0f - 1e-4f) / 15.0f); const float rev = t * band;
      v = (i <= 16) ? __builtin_amdgcn_cosf(rev) : -__builtin_amdgcn_sinf(rev); }
    feats[e] = v; }
  __syncthreads();
  { const int j = tid & 63; const float b1 = PIN(I_HB1)[j], f0 = PIN(I_HSF)[j]; float s0 = b1, s1 = b1; const int p0 = tid >> 6, p1 = p0 + 8;
    const float* pw1 = PIN(I_HW1);
#pragma unroll 11
    for (int i = 0; i < 33; ++i) { const float w = pw1[i * 64 + j]; s0 += feats[p0 * 33 + i] * w; s1 += feats[p1 * 33 + i] * w; }
    h1[p0 * 64 + j] = __sinf(f0 * s0); h1[p1 * 64 + j] = __sinf(f0 * s1); }
  __syncthreads();
  { const int j = tid & 63; const float b2 = PIN(I_HB2)[j], f1 = PIN(I_HSF)[64 + j]; float s0 = b2, s1 = b2; const int p0 = tid >> 6, p1 = p0 + 8;
    const float* pw2 = PIN(I_HW2);
#pragma unroll 16
    for (int i = 0; i < 64; ++i) { const float w = pw2[i * 64 + j]; s0 += h1[p0 * 64 + i] * w; s1 += h1[p1 * 64 + i] * w; }
    h2[p0 * 64 + j] = __sinf(f1 * s0); h2[p1 * 64 + j] = __sinf(f1 * s1); }
  __syncthreads();
  { const float* pw3 = PIN(I_HW3); LAS float* w3l = Ls + 2816; const int chl = tid & 255, ph = tid >> 8, lr = tid >> 6, c4 = (tid & 63) * 4;
#pragma unroll 1
    for (int qq = 0; qq < 4; ++qq) {
      f32x4 tq[8];
#pragma unroll
      for (int it = 0; it < 8; ++it) tq[it] = *(const f32x4*)(pw3 + (size_t)(it * 8 + lr) * 1024 + 256 * qq + c4);
#pragma unroll
      for (int it = 0; it < 8; ++it) *(LAS f32x4*)(w3l + (it * 8 + lr) * 256 + c4) = tq[it];
      __syncthreads();
      float acc[8];
#pragma unroll
      for (int pp = 0; pp < 8; ++pp) acc[pp] = 0.f;
#pragma unroll 4
      for (int i = 0; i < 64; ++i) { const float w = w3l[i * 256 + chl];
#pragma unroll
        for (int pp = 0; pp < 8; ++pp) acc[pp] += h2[(ph * 8 + pp) * 64 + i] * w; }
      const int n = 256 * qq + chl, q = n >> 9, ch = n & 511; const float delta = fabsf(-3.0701134573253945f + (float)ch * ((-15.350567286626973f + 3.0701134573253945f) / 511.0f));
#pragma unroll
      for (int pp = 0; pp < 8; ++pp) { const int d = pos0 + ph * 8 + pp; const float t = (float)d / (float)L; const float val = acc[pp] * (__expf(-t * delta) + 0.05f);
        if (q == 0) KF[(size_t)ch * (2 * L) + L + d] = val; else if (d >= 1) KF[(size_t)ch * (2 * L) + L - d] = val; }
      __syncthreads();
    } }
}

typedef _Float16 f16x4 __attribute__((ext_vector_type(4)));
__device__ __forceinline__ void row_pass(const float* s32lat, const float* s32ctx, const _Float16* s16, _Float16* d16, float* d32, bool do_ln, const float* g, const float* b, bf16_t* H, const float* modn  , int sidx, int nrows, const float* zp, const float* gate8, float gs, const bf16_t* y2) {
  const int lane = ltid() & 63; const int gw = blockIdx.x * 8 + (ltid() >> 6), ngw = gridDim.x * 8;
  constexpr int R = 3;
#pragma unroll 1
  for (int row0 = gw; row0 < nrows; row0 += R * ngw) {
    f32x4 v[R][4]; bool ok[R]; int rows[R];
#pragma unroll
    for (int r = 0; r < R; ++r) { const int row = row0 + r * ngw; ok[r] = row < nrows; const int rr = ok[r] ? row : row0; rows[r] = rr; const bool lat = rr < NLAT;
      if (s16) { const _Float16* sp = s16 + (size_t)rr * D + lane * 4;
#pragma unroll
        for (int j = 0; j < 4; ++j) v[r][j] = __builtin_convertvector(*(const f16x4*)(sp + 256 * j), f32x4); }
      else { const float* sp = (lat ? s32lat + (size_t)rr * D : s32ctx + (size_t)(rr - NLAT) * D) + lane * 4;
#pragma unroll
        for (int j = 0; j < 4; ++j) v[r][j] = *(const f32x4*)(sp + 256 * j); }
      if (y2 && lat) { const bf16_t* yr = y2 + (size_t)rr * D + lane * 4;
#pragma unroll
        for (int j = 0; j < 4; ++j) { const u32x2 w = *(const u32x2*)(yr + 256 * j); v[r][j] = v[r][j] * ALPHA_F + (f32x4){bflo(w.x), bfhi(w.x), bflo(w.y), bfhi(w.y)}; } }
      if (zp && !lat) { const float* zr = zp + (size_t)(rr - NLAT) * D + lane * 4;
#pragma unroll
        for (int j = 0; j < 4; ++j) { const f32x4 y = (*(const f32x4*)(zr + 256 * j) + *(const f32x4*)(zr + (size_t)NCTX * D + 256 * j)) + (*(const f32x4*)(zr + (size_t)2 * NCTX * D + 256 * j) + *(const f32x4*)(zr + (size_t)3 * NCTX * D + 256 * j));
          v[r][j] = v[r][j] * ALPHA_F + (*(const f32x4*)(gate8 + lane * 4 + 256 * j) * gs) * y; } } }
    if (do_ln) {
      float s[R], q[R];
#pragma unroll
      for (int r = 0; r < R; ++r) { s[r] = 0.f;
#pragma unroll
        for (int j = 0; j < 4; ++j) s[r] += (v[r][j][0] + v[r][j][1]) + (v[r][j][2] + v[r][j][3]); }
#pragma unroll
      for (int o = 1; o < 64; o <<= 1) {
#pragma unroll
        for (int r = 0; r < R; ++r) s[r] += __shfl_xor(s[r], o); }
#pragma unroll
      for (int r = 0; r < R; ++r) { const float mean = s[r] * (1.0f / D); q[r] = 0.f;
#pragma unroll
        for (int j = 0; j < 4; ++j) { v[r][j] = v[r][j] - mean; q[r] += (v[r][j][0] * v[r][j][0] + v[r][j][1] * v[r][j][1]) + (v[r][j][2] * v[r][j][2] + v[r][j][3] * v[r][j][3]); } }
#pragma unroll
      for (int o = 1; o < 64; o <<= 1) {
#pragma unroll
        for (int r = 0; r < R; ++r) q[r] += __shfl_xor(q[r], o); }
#pragma unroll
      for (int j = 0; j < 4; ++j) { const f32x4 gg = *(const f32x4*)(g + lane * 4 + 256 * j), bb = *(const f32x4*)(b + lane * 4 + 256 * j);
#pragma unroll
        for (int r = 0; r < R; ++r) { const float rstd = 1.0f / sqrtf(q[r] * (1.0f / D) + 1e-6f); v[r][j] = v[r][j] * rstd * gg + bb; } }
    }
#pragma unroll
    for (int r = 0; r < R; ++r) {
      if (!ok[r]) continue;
      const int row = rows[r];
      if (d16) { _Float16* dp = d16 + (size_t)row * D + lane * 4;
#pragma unroll
        for (int j = 0; j < 4; ++j) *(f16x4*)(dp + 256 * j) = __builtin_convertvector(v[r][j], f16x4); }
      if (d32 && row < NLAT) { float* dp = d32 + (size_t)row * D + lane * 4;
#pragma unroll
        for (int j = 0; j < 4; ++j) *(f32x4*)(dp + 256 * j) = v[r][j]; }
      if (H) {
        const int mr = row < NLAT ? row / SEQ : 8; const float* sh = modn + (size_t)(mr * 9 + sidx) * D; const float* sc = sh + D;
#pragma unroll
        for (int j = 0; j < 4; ++j) { const f32x4 s1 = *(const f32x4*)(sh + lane * 4 + 256 * j), s2 = *(const f32x4*)(sc + lane * 4 + 256 * j); const f32x4 h = v[r][j] * (s2 + 1.0f) + s1;
          u32x2 w; w.x = cvt_pk_bf16(h[0], h[1]); w.y = cvt_pk_bf16(h[2], h[3]); *(u32x2*)(H + (size_t)row * D + lane * 4 + 256 * j) = w; }
      }
    }
  }
}
__device__ __forceinline__ void mla_rownorm(const bf16_t* P, bf16_t* QN, bf16_t* KVN, bf16_t* KR) {
  const int lane = ltid() & 63; const int gw = blockIdx.x * 8 + (ltid() >> 6), ngw = gridDim.x * 8;
  for (int row = gw; row < NROW; row += ngw) {
    const bf16_t* pr = P + (size_t)row * 1280; const bool lat = row < NLAT;
    if (lat) {
      u32x2 w[3]; float ss = 0.f;
#pragma unroll
      for (int j = 0; j < 3; ++j) { w[j] = *(const u32x2*)(pr + lane * 4 + 256 * j); const float a = bflo(w[j].x), b = bfhi(w[j].x), c = bflo(w[j].y), d = bfhi(w[j].y); ss += (a * a + b * b) + (c * c + d * d); }
      const float r = 1.0f / sqrtf(wave_sum(ss) * (1.0f / 768.0f) + 1e-6f);
#pragma unroll
      for (int j = 0; j < 3; ++j) { u32x2 o; o.x = cvt_pk_bf16(bflo(w[j].x) * r, bfhi(w[j].x) * r); o.y = cvt_pk_bf16(bflo(w[j].y) * r, bfhi(w[j].y) * r); *(u32x2*)(QN + (size_t)row * 768 + lane * 4 + 256 * j) = o; }
    }
    { const u32x2 w = *(const u32x2*)(pr + 768 + lane * 4); const float a = bflo(w.x), b = bfhi(w.x), c = bflo(w.y), d = bfhi(w.y);
      const float r = 1.0f / sqrtf(wave_sum((a * a + b * b) + (c * c + d * d)) * (1.0f / 256.0f) + 1e-6f);
      u32x2 o; o.x = cvt_pk_bf16(a * r, b * r); o.y = cvt_pk_bf16(c * r, d * r); *(u32x2*)(KVN + (size_t)row * 256 + lane * 4) = o; }
    if (lane < 16) { const int a = lane >> 3, pp = lane & 7; float x1 = bf2f(pr[1024 + a * 16 + pp]), x2 = bf2f(pr[1024 + a * 16 + 8 + pp]);
      if (lat) { const int t = row & (SEQ - 1); const float pos = (float)(a == 0 ? (t >> 6) : (t & 63)); const float ang = pos * rope_inv_freq(pp); const float cs = __cosf(ang), sn = __sinf(ang);
        const float o1 = x1 * cs - x2 * sn, o2 = x2 * cs + x1 * sn; x1 = o1; x2 = o2; }
      *(unsigned*)(KR + (size_t)row * 32 + a * 16 + 2 * pp) = cvt_pk_bf16(x1, x2); }
  }
}

__device__ __forceinline__ void xc_build(const Params& p, int z, const bf16_t* URG, bf16_t* XC) {
  const float* cw = PIN(I_RCW); const float* cb = PIN(I_RCB);
  for (int it = blockIdx.x * 512 + ltid(); it < NROW * 64; it += gridDim.x * 512) {
    const int row = it >> 6, c8 = (it & 63) * 8; int t, Ls; if (row < NLAT) { t = row & (SEQ - 1); Ls = SEQ; } else { t = (row - NLAT) & (CTXL - 1); Ls = CTXL; }
    float acc[8];
#pragma unroll
    for (int j = 0; j < 8; ++j) acc[j] = cb[c8 + j];
#pragma unroll
    for (int k = 0; k < 4; ++k) { const int tt = t + k - 2; if (tt >= 0 && tt < Ls) { const u32x4 w = *(const u32x4*)(URG + (size_t)(row + k - 2) * 1024 + c8);
        const f32x4 w0 = *(const f32x4*)(cw + k * 512 + c8), w1 = *(const f32x4*)(cw + k * 512 + c8 + 4);
        acc[0] += bflo(w.x) * w0[0]; acc[1] += bfhi(w.x) * w0[1]; acc[2] += bflo(w.y) * w0[2]; acc[3] += bfhi(w.y) * w0[3];
        acc[4] += bflo(w.z) * w1[0]; acc[5] += bfhi(w.z) * w1[1]; acc[6] += bflo(w.w) * w1[2]; acc[7] += bfhi(w.w) * w1[3]; } }
    u32x4 o; o.x = cvt_pk_bf16(acc[0], acc[1]); o.y = cvt_pk_bf16(acc[2], acc[3]); o.z = cvt_pk_bf16(acc[4], acc[5]); o.w = cvt_pk_bf16(acc[6], acc[7]);
    *(u32x4*)(XC + (size_t)row * 512 + c8) = o;
  }
}
constexpr int HY_CSTRIDE = 8224;
__device__ __forceinline__ void hyena_unit(LAS unsigned char* lds, const Params& p, int z, const bf16_t* UT, const float* KFa, bf16_t* YT, int c, int L, int tokbase) {
  const int tid = ltid(), lane = tid & 63, wid = tid >> 6;
  const int OFF = L + 16, NC = 2 * L + 16; const int rstride = L * 2 + 16;
  LAS unsigned char* cp = lds; LAS unsigned char* WT = lds + 8 * HY_CSTRIDE; LAS unsigned char* X0 = WT + 8 * (2048 * 2 + 16);
  { const float bias = PIN(I_HBIAS)[c]; const float* kf = KFa + (size_t)c * (2 * L) + L; const int ngrp = NC >> 3;
#pragma unroll 3
    for (int gidx = tid; gidx < 8 * ngrp; gidx += 512) { const int r = gidx / ngrp, m = gidx - r * ngrp; const int dhi = OFF + r - 8 * m;
      float v[8];
      if (dhi < L && dhi - 7 > -L) { const f32x4 lo = *(const f32x4*)(kf + dhi - 7), hi = *(const f32x4*)(kf + dhi - 3);
        v[0] = hi[3]; v[1] = hi[2]; v[2] = hi[1]; v[3] = hi[0]; v[4] = lo[3]; v[5] = lo[2]; v[6] = lo[1]; v[7] = lo[0]; }
      else {
#pragma unroll
        for (int j = 0; j < 8; ++j) { const int d = dhi - j; v[j] = (d > -L && d < L) ? kf[d] : 0.f; } }
#pragma unroll
      for (int j = 0; j < 8; ++j) if (dhi - j == 0) v[j] += bias;
      u32x4 o; o.x = cvt_pk_bf16(v[0], v[1]); o.y = cvt_pk_bf16(v[2], v[3]); o.z = cvt_pk_bf16(v[4], v[5]); o.w = cvt_pk_bf16(v[6], v[7]);
      *(LAS u32x4*)(cp + r * HY_CSTRIDE + m * 16) = o; } }
  { const float* cw = PIN(I_HCW); const float* cb = PIN(I_HCB);
    float w0[3], w1[3], w2[3], bb[3];
#pragma unroll
    for (int a = 0; a < 3; ++a) { w0[a] = cw[0 * 1536 + a * 512 + c]; w1[a] = cw[1 * 1536 + a * 512 + c]; w2[a] = cw[2 * 1536 + a * 512 + c]; bb[a] = cb[a * 512 + c]; }
    const int cpb = L >> 3;
#pragma unroll 2
    for (int ch = tid; ch < 8 * cpb; ch += 512) { const int b = ch / cpb, t8 = (ch - b * cpb) * 8; float res[3][8];
#pragma unroll
      for (int a = 0; a < 3; ++a) { const bf16_t* rowp = UT + (size_t)(a * 512 + c) * NROW + tokbase + b * L + t8; const u32x4 w = *(const u32x4*)rowp;
        float x[10]; x[0] = t8 > 0 ? bf2f(rowp[-1]) : 0.f; x[9] = t8 + 8 < L ? bf2f(rowp[8]) : 0.f;
        x[1] = bflo(w.x); x[2] = bfhi(w.x); x[3] = bflo(w.y); x[4] = bfhi(w.y); x[5] = bflo(w.z); x[6] = bfhi(w.z); x[7] = bflo(w.w); x[8] = bfhi(w.w);
#pragma unroll
        for (int j = 0; j < 8; ++j) res[a][j] = x[j] * w0[a] + x[j + 1] * w1[a] + x[j + 2] * w2[a] + bb[a]; }
      u32x4 ow, ox;
      ow.x = cvt_pk_bf16(res[2][0] * res[1][0], res[2][1] * res[1][1]); ow.y = cvt_pk_bf16(res[2][2] * res[1][2], res[2][3] * res[1][3]);
      ow.z = cvt_pk_bf16(res[2][4] * res[1][4], res[2][5] * res[1][5]); ow.w = cvt_pk_bf16(res[2][6] * res[1][6], res[2][7] * res[1][7]);
      ox.x = cvt_pk_bf16(res[0][0], res[0][1]); ox.y = cvt_pk_bf16(res[0][2], res[0][3]); ox.z = cvt_pk_bf16(res[0][4], res[0][5]); ox.w = cvt_pk_bf16(res[0][6], res[0][7]);
      *(LAS u32x4*)(WT + b * rstride + t8 * 2) = ow; *(LAS u32x4*)(X0 + b * rstride + t8 * 2) = ox; }
  }
  __syncthreads();
  { const int n = lane & 15, g = lane >> 4, bq = n & 7; const int i = lane & 15, q = i >> 3, r = i & 7;
    const int ngroups = L >> 6;
    const LAS unsigned char* bbase = WT + bq * rstride + g * 16;
    const LAS unsigned char* abase = cp + r * HY_CSTRIDE + (8 * g - 8 * q + OFF) * 2;
    for (int grp = wid; grp < ngroups; grp += 8) {
      f32x4 acc[4];
#pragma unroll
      for (int ii = 0; ii < 4; ++ii) acc[ii] = (f32x4){0.f, 0.f, 0.f, 0.f};
      const int t0 = grp * 64;
      for (int J = 0; J < (L >> 5); ++J) {
        const bf16x8 bf = *(const LAS bf16x8*)(bbase + J * 64);
#pragma unroll
        for (int ii = 0; ii < 4; ++ii) { const bf16x8 af = *(const LAS bf16x8*)(abase + (32 * J - t0 - 16 * ii) * 2);
          acc[ii] = __builtin_amdgcn_mfma_f32_16x16x32_bf16(af, bf, acc[ii], 0, 0, 0); }
      }
      if (n < 8) {
#pragma unroll
        for (int ii = 0; ii < 4; ++ii) { const int t = t0 + 16 * ii + 4 * g; const u32x2 xw = *(const LAS u32x2*)(X0 + n * rstride + t * 2);
          u32x2 o; o.x = cvt_pk_bf16(acc[ii][0] * bflo(xw.x), acc[ii][1] * bfhi(xw.x)); o.y = cvt_pk_bf16(acc[ii][2] * bflo(xw.y), acc[ii][3] * bfhi(xw.y));
          *(u32x2*)(YT + (size_t)c * NROW + tokbase + n * L + t) = o; }
      }
    }
  }
  __syncthreads();
}
__device__ __forceinline__ void yt_transpose(LAS unsigned char* lds, const bf16_t* YT, bf16_t* Y, int job) {
  const int tid = ltid(); const int ct = job & 7, tt = job >> 3; const int c0 = ct * 64, tok0 = tt * 64;
  LAS unsigned short* T = (LAS unsigned short*)lds;
  { const int i = tid >> 3, ch = tid & 7; const u32x4 w = *(const u32x4*)(YT + (size_t)(c0 + i) * NROW + tok0 + ch * 8); *(LAS u32x4*)(T + i * 72 + ch * 8) = w; }
  __syncthreads();
  { const int t = tid >> 3, cc = (tid & 7) * 8; unsigned short v[8];
#pragma unroll
    for (int j = 0; j < 8; ++j) v[j] = T[(cc + j) * 72 + t];
    u32x4 o; o.x = v[0] | ((unsigned)v[1] << 16); o.y = v[2] | ((unsigned)v[3] << 16); o.z = v[4] | ((unsigned)v[5] << 16); o.w = v[6] | ((unsigned)v[7] << 16);
    *(u32x4*)(Y + (size_t)(tok0 + t) * 1024 + c0 + cc) = o; }
  __syncthreads();
}
constexpr int SC_CL = 32, SC_NC = 72, SC_NCTX = 8;
__device__ __forceinline__ int scan_row0(int b, int chunk) { return chunk < SC_NCTX ? NLAT + b * CTXL + chunk * SC_CL : b * SEQ + (chunk - SC_NCTX) * SC_CL; }
__device__ __forceinline__ void rg_coef(float r, float ig, float xc, float cl, float& a, float& bb) {
  const float la = r * cl; a = __builtin_amdgcn_exp2f(la * 1.4426950408889634f); const float x = 2.0f * la;
  float om = -x * (1.0f + x * (0.5f + x * (0.16666667f + x * (0.041666668f + x * (0.0083333338f + x * 0.0013888889f)))));
  om = (x < -0.5f) ? 1.0f - a * a : om;
  bb = __builtin_amdgcn_sqrtf(fmaxf(om, 0.f)) * (ig * xc);
}
__device__ __forceinline__ float scan_cl(const Params& p, int z, int dir, int ch) { const float lam = PIN(I_RLAM)[dir * 512 + ch]; return -8.0f * log1pf(__expf(-lam)); }
constexpr int SC_XROW = 1040;
__device__ __forceinline__ void scan_xc_load(const bf16_t* XC, int job, int tid, u32x4 (&xr)[4]) {
  const int b = job / SC_NC, chunk = job % SC_NC; const int row0 = scan_row0(b, chunk);
#pragma unroll
  for (int it = 0; it < 4; ++it) { const int id = it * 512 + tid; const int r = id >> 6, c8 = (id & 63) * 8; xr[it] = *(const u32x4*)(XC + (size_t)(row0 + r) * 512 + c8); }
}
__device__ __forceinline__ void scan_pass_a(LAS unsigned char* lds, const Params& p, int z, const bf16_t* XC, const bf16_t* WRG, unsigned* COEF, float* AGG, int job, int tid, const u32x4 (&xr)[4]) {
  const int lane = tid & 63, w = tid >> 6; const int b = job / SC_NC, chunk = job % SC_NC; const int row0 = scan_row0(b, chunk);
  LAS unsigned* coef = (LAS unsigned*)lds;
  LAS unsigned char* xcl = lds + 65536;
#pragma unroll
  for (int it = 0; it < 4; ++it) { const int id = it * 512 + tid; const int r = id >> 6, c8 = (id & 63) * 8; *(LAS u32x4*)(xcl + r * SC_XROW + c8 * 2) = xr[it]; }
  const int n = lane & 15, g = lane >> 4;
  __syncthreads();
  bf16x8 af[2][2];
#pragma unroll
  for (int mb = 0; mb < 2; ++mb)
#pragma unroll
    for (int ks = 0; ks < 2; ++ks) af[mb][ks] = *(const LAS bf16x8*)(xcl + (16 * mb + n) * SC_XROW + (64 * w + 32 * ks + 8 * g) * 2);
#pragma unroll 1
  for (int dir = 0; dir < 2; ++dir) {
    bf16x8 wf[4][2][2];
#pragma unroll
    for (int nblk = 0; nblk < 4; ++nblk)
#pragma unroll
      for (int ty = 0; ty < 2; ++ty) { const bf16_t* wp = WRG + (size_t)((dir * 2 + ty) * 512 + 64 * w + 16 * nblk + n) * 512 + 64 * w + 8 * g; wf[nblk][ty][0] = *(const bf16x8*)wp; wf[nblk][ty][1] = *(const bf16x8*)(wp + 32); }
#pragma unroll
    for (int nblk = 0; nblk < 4; ++nblk) {
      const int ch = 64 * w + 16 * nblk + n;
      f32x4 ar[2], ai[2];
#pragma unroll
      for (int mb = 0; mb < 2; ++mb) { ar[mb] = (f32x4){0.f, 0.f, 0.f, 0.f}; ai[mb] = (f32x4){0.f, 0.f, 0.f, 0.f};
        ar[mb] = __builtin_amdgcn_mfma_f32_16x16x32_bf16(af[mb][0], wf[nblk][0][0], ar[mb], 0, 0, 0); ar[mb] = __builtin_amdgcn_mfma_f32_16x16x32_bf16(af[mb][1], wf[nblk][0][1], ar[mb], 0, 0, 0);
        ai[mb] = __builtin_amdgcn_mfma_f32_16x16x32_bf16(af[mb][0], wf[nblk][1][0], ai[mb], 0, 0, 0); ai[mb] = __builtin_amdgcn_mfma_f32_16x16x32_bf16(af[mb][1], wf[nblk][1][1], ai[mb], 0, 0, 0); }
      const float biasr = PIN(I_RAB)[dir * 512 + ch], biasi = PIN(I_RXB)[dir * 512 + ch]; const float cl = scan_cl(p, z, dir, ch);
#pragma unroll
      for (int mb = 0; mb < 2; ++mb)
#pragma unroll
        for (int jj = 0; jj < 4; ++jj) { const int row = 16 * mb + 4 * g + jj;
          const float r = __fdividef(1.0f, 1.0f + __expf(-(ar[mb][jj] + biasr))), ig = __fdividef(1.0f, 1.0f + __expf(-(ai[mb][jj] + biasi))); const float xc = bf2f(*(const LAS unsigned short*)(xcl + row * SC_XROW + ch * 2));
          const float rq = bflo(cvt_pk_bf16(r, 0.f)), iq = bflo(cvt_pk_bf16(ig, 0.f));
          const float la = rq * cl; const float a = __builtin_amdgcn_exp2f(la * 1.4426950408889634f); const float x = 2.0f * la;
          float om = -x * (1.0f + x * (0.5f + x * (0.16666667f + x * (0.041666668f + x * (0.0083333338f + x * 0.0013888889f)))));
          om = (x < -0.5f) ? 1.0f - a * a : om;
          const float bb = __builtin_amdgcn_sqrtf(fmaxf(om, 0.f)) * (iq * xc);
          coef[row * 512 + ch] = cvt_pk_bf16(la, bb); }
    }
    __syncthreads();
    { const int ch = tid; float A = 1.f, B = 0.f; unsigned* cg_ = COEF + (size_t)row0 * 1024 + dir * 512 + ch;
#pragma unroll 8
      for (int tt = 0; tt < SC_CL; ++tt) { const int t = dir ? SC_CL - 1 - tt : tt; const unsigned c = coef[t * 512 + ch]; cg_[(size_t)t * 1024] = c;
        const float a = __builtin_amdgcn_exp2f(bflo(c) * 1.4426950408889634f); A *= a; B = B * a + bfhi(c); }
      float* ag = AGG + ((size_t)((dir * 8 + b) * SC_NC + chunk) * 512 + ch) * 2; ag[0] = A; ag[1] = B; }
    __syncthreads();
  }
}
__device__ __forceinline__ float scan_carry(const float* AGG, int dir, int b, int chunk, int ch) {
  const int pos = dir == 0 ? chunk : (chunk < SC_NCTX ? SC_NCTX - 1 - chunk : (SC_NC + SC_NCTX - 1) - chunk);
  float h = 0.f;
#pragma unroll 1
  for (int ob = 0; ob < pos; ob += 24) { float aa[24], bb[24];
#pragma unroll
    for (int j = 0; j < 24; ++j) { const int o = ob + j; const int oo = o < pos ? o : 0; const int cj = dir == 0 ? oo : (oo < SC_NCTX ? SC_NCTX - 1 - oo : (SC_NC + SC_NCTX - 1) - oo);
      const f32x2 v = *(const f32x2*)(AGG + ((size_t)((dir * 8 + b) * SC_NC + cj) * 512 + ch) * 2); aa[j] = o < pos ? v.x : 1.f; bb[j] = o < pos ? v.y : 0.f; }
#pragma unroll
    for (int j = 0; j < 24; ++j) h = aa[j] * h + bb[j]; }
  return h;
}
__device__ __forceinline__ void scan_pass_b(LAS unsigned char* lds, const unsigned* COEF, const bf16_t* URG, const float* AGG, bf16_t* Y, int job) {
  const int ch = ltid(); const int b = job / SC_NC, chunk = job % SC_NC; const int row0 = scan_row0(b, chunk);
  LAS float* hf = (LAS float*)lds;
  const unsigned* c0 = COEF + (size_t)row0 * 1024 + ch;
  { float h = scan_carry(AGG, 0, b, chunk, ch);
#pragma unroll 1
    for (int tb = 0; tb < SC_CL; tb += 16) { unsigned cc[16];
#pragma unroll
      for (int j = 0; j < 16; ++j) cc[j] = c0[(size_t)(tb + j) * 1024];
#pragma unroll
      for (int j = 0; j < 16; ++j) { const float a = __builtin_amdgcn_exp2f(bflo(cc[j]) * 1.4426950408889634f); h = a * h + bfhi(cc[j]); hf[(tb + j) * 512 + ch] = h; } } }
  { float h = scan_carry(AGG, 1, b, chunk, ch);
#pragma unroll 1
    for (int tb = 0; tb < SC_CL; tb += 16) { unsigned cc[16]; float gg[16];
#pragma unroll
      for (int j = 0; j < 16; ++j) { const int t = SC_CL - 1 - (tb + j); cc[j] = c0[(size_t)t * 1024 + 512]; gg[j] = bf2f(URG[(size_t)(row0 + t) * 1024 + 512 + ch]); }
#pragma unroll
      for (int j = 0; j < 16; ++j) { const int t = SC_CL - 1 - (tb + j); const float a = __builtin_amdgcn_exp2f(bflo(cc[j]) * 1.4426950408889634f); h = a * h + bfhi(cc[j]);
        const float gt = gg[j]; const float zz = 0.7978845608028654f * (gt + 0.044715f * gt * gt * gt);
        const float th = 1.0f - 2.0f * __builtin_amdgcn_rcpf(1.0f + __expf(2.0f * zz)); const float ge = 0.5f * gt * (1.0f + th);
        Y[(size_t)(row0 + t) * 1024 + 512 + ch] = (unsigned short)(cvt_pk_bf16((h + hf[t * 512 + ch]) * ge, 0.f) & 0xffffu); } } }
}

__device__ __forceinline__ void attn_phase(LAS unsigned char* lds, const bf16_t* Q, const bf16_t* Kb, const bf16_t* KR, const bf16_t* VT, bf16_t* O) {
  const int tid = threadIdx.x, wid = tid >> 6, lane = tid & 63, l32 = lane & 31, hf = lane >> 5;
  constexpr int KROW = 208, KBUF = 64 * KROW, VROW = 136, VBUF = 64 * VROW;
  LAS unsigned char* Kl = lds; LAS unsigned char* Vl = lds + 2 * KBUF;
  const int G = gridDim.x; const float cs = 0.10206207261596575f * 1.4426950408889634f;
  const int kkey = tid >> 3, kpart = tid & 7, rkey = (tid >> 2) & 63, rpart = tid & 3, vdv = tid >> 3, vpart = tid & 7;
  for (int u = blockIdx.x; u < 1024; u += G) {
    int bh, qb;
    if (G == 256) { const int xcd = blockIdx.x & 7, within = blockIdx.x >> 3, r = u >> 8; bh = xcd * 16 + r * 4 + (within >> 3); qb = within & 7; } else { bh = u >> 3; qb = u & 7; }
    const int b = bh >> 4, h = bh & 15;
    const int q = qb * 256 + wid * 32 + l32;
    const bf16_t* qp = Q + (size_t)(b * SEQ + q) * 1536 + h * 96 + hf * 8;
    bf16x8 qf[6];
#pragma unroll
    for (int ks = 0; ks < 6; ++ks) qf[ks] = *(const bf16x8*)(qp + ks * 16);
    f32x16 o0, o1;
#pragma unroll
    for (int i = 0; i < 16; ++i) { o0[i] = 0.f; o1[i] = 0.f; }
    float mrun = -1e30f, lsum = 0.f;
    u32x4 kreg, rreg, vreg;
#define ATT_LOAD(j) do { const int tb_ = (j) < 32 ? b * SEQ + (j) * 64 : NLAT + b * CTXL + ((j) - 32) * 64; \
      kreg = *(const u32x4*)(Kb + (size_t)(tb_ + kkey) * 1024 + h * 64 + kpart * 8); \
      if (tid < 256) rreg = *(const u32x4*)(KR + (size_t)(tb_ + rkey) * 32 + rpart * 8); \
      vreg = *(const u32x4*)(VT + (size_t)(h * 64 + vdv) * NROW + tb_ + vpart * 8); } while (0)
#define ATT_STORE(buf) do { *(LAS u32x4*)(Kl + (buf) * KBUF + kkey * KROW + kpart * 16) = kreg; \
      if (tid < 256) *(LAS u32x4*)(Kl + (buf) * KBUF + rkey * KROW + 128 + rpart * 16) = rreg; \
      *(LAS u32x2*)(Vl + (buf) * VBUF + vdv * VROW + vpart * 16) = (u32x2){vreg.x, vreg.y}; *(LAS u32x2*)(Vl + (buf) * VBUF + vdv * VROW + vpart * 16 + 8) = (u32x2){vreg.z, vreg.w}; } while (0)
    ATT_LOAD(0); ATT_STORE(0); __syncthreads();
    for (int j = 0; j < 36; ++j) {
      if (j + 1 < 36) ATT_LOAD(j + 1);
      const int cur = j & 1;
      f32x16 s0, s1;
#pragma unroll
      for (int i = 0; i < 16; ++i) { s0[i] = 0.f; s1[i] = 0.f; }
      const LAS unsigned char* kb0 = Kl + cur * KBUF + l32 * KROW + hf * 16;
#pragma unroll
      for (int ks = 0; ks < 6; ++ks) { const bf16x8 a0 = *(const LAS bf16x8*)(kb0 + ks * 32), a1 = *(const LAS bf16x8*)(kb0 + 32 * KROW + ks * 32);
        s0 = __builtin_amdgcn_mfma_f32_32x32x16_bf16(a0, qf[ks], s0, 0, 0, 0); s1 = __builtin_amdgcn_mfma_f32_32x32x16_bf16(a1, qf[ks], s1, 0, 0, 0); }
      float tmax = s0[0];
#pragma unroll
      for (int i = 1; i < 16; ++i) tmax = fmaxf(tmax, s0[i]);
#pragma unroll
      for (int i = 0; i < 16; ++i) tmax = fmaxf(tmax, s1[i]);
      tmax = fmaxf(tmax, __shfl_xor(tmax, 32));
      const float mnew = fmaxf(mrun, tmax * cs); const float alpha = __builtin_amdgcn_exp2f(mrun - mnew); mrun = mnew;
      float psum = 0.f;
#pragma unroll
      for (int i = 0; i < 16; ++i) { s0[i] = __builtin_amdgcn_exp2f(s0[i] * cs - mnew); s1[i] = __builtin_amdgcn_exp2f(s1[i] * cs - mnew); psum += s0[i] + s1[i]; }
      lsum = lsum * alpha + psum;
#pragma unroll
      for (int i = 0; i < 16; ++i) { o0[i] *= alpha; o1[i] *= alpha; }
      const LAS unsigned char* vb0 = Vl + cur * VBUF + l32 * VROW + hf * 8;
#pragma unroll
      for (int kb = 0; kb < 2; ++kb)
#pragma unroll
        for (int k2 = 0; k2 < 2; ++k2) {
          bf16x8 pf; { unsigned w0, w1, w2, w3;
            if (kb == 0) { w0 = cvt_pk_bf16(s0[8 * k2 + 0], s0[8 * k2 + 1]); w1 = cvt_pk_bf16(s0[8 * k2 + 2], s0[8 * k2 + 3]); w2 = cvt_pk_bf16(s0[8 * k2 + 4], s0[8 * k2 + 5]); w3 = cvt_pk_bf16(s0[8 * k2 + 6], s0[8 * k2 + 7]); }
            else { w0 = cvt_pk_bf16(s1[8 * k2 + 0], s1[8 * k2 + 1]); w1 = cvt_pk_bf16(s1[8 * k2 + 2], s1[8 * k2 + 3]); w2 = cvt_pk_bf16(s1[8 * k2 + 4], s1[8 * k2 + 5]); w3 = cvt_pk_bf16(s1[8 * k2 + 6], s1[8 * k2 + 7]); }
            const u32x4 pw = {w0, w1, w2, w3}; pf = __builtin_bit_cast(bf16x8, pw); }
          const int koff = (32 * kb + 16 * k2) * 2;
          { const u32x2 va = *(const LAS u32x2*)(vb0 + koff), vb = *(const LAS u32x2*)(vb0 + koff + 16); const u32x4 vw = {va.x, va.y, vb.x, vb.y};
            o0 = __builtin_amdgcn_mfma_f32_32x32x16_bf16(__builtin_bit_cast(bf16x8, vw), pf, o0, 0, 0, 0); }
          { const u32x2 va = *(const LAS u32x2*)(vb0 + 32 * VROW + koff), vb = *(const LAS u32x2*)(vb0 + 32 * VROW + koff + 16); const u32x4 vw = {va.x, va.y, vb.x, vb.y};
            o1 = __builtin_amdgcn_mfma_f32_32x32x16_bf16(__builtin_bit_cast(bf16x8, vw), pf, o1, 0, 0, 0); }
        }
      if (j + 1 < 36) ATT_STORE(cur ^ 1);
      __syncthreads();
    }
#undef ATT_LOAD
#undef ATT_STORE
    const float inv = 1.0f / (lsum + __shfl_xor(lsum, 32));
    bf16_t* op = O + (size_t)(b * SEQ + q) * 1024 + h * 64 + 4 * hf;
#pragma unroll
    for (int i = 0; i < 4; ++i) {
      u32x2 w; w.x = cvt_pk_bf16(o0[4 * i] * inv, o0[4 * i + 1] * inv); w.y = cvt_pk_bf16(o0[4 * i + 2] * inv, o0[4 * i + 3] * inv); *(u32x2*)(op + 8 * i) = w;
      w.x = cvt_pk_bf16(o1[4 * i] * inv, o1[4 * i + 1] * inv); w.y = cvt_pk_bf16(o1[4 * i + 2] * inv, o1[4 * i + 3] * inv); *(u32x2*)(op + 32 + 8 * i) = w;
    }
  }
}

__device__ __forceinline__ int wide_count(int sel) { return sel == 0 ? 752 : (sel == 3 ? 64 : 528); }
__device__ __forceinline__ ConvDesc wide_desc(const Params& p, int z, unsigned char* ws, int sel, int it) {
  ConvDesc d; int r = it; d.W2 = nullptr; d.sc = nullptr; d.kind = MAP_ID;
  if (sel == 3) { d.W = PIN(I_MWO); d.K = 1024; d.ld = 1024; d.dst = (bf16_t*)(ws + WS_WMO); }
  else { const int m = sel == 4 ? 3 : sel;
    if (r < 352) { d.kind = MAP_SWIGLU; d.W = PIN(I_FWI) + (size_t)m * 1024 * 5632; d.K = 1024; d.ld = 5632; d.dst = (bf16_t*)(ws + WS_WFI + m * SZ_WFI); }
    else if ((r -= 352) < 176) { d.W = PIN(I_FWO) + (size_t)m * 2816 * 1024; d.K = 2816; d.ld = 1024; d.dst = (bf16_t*)(ws + WS_WFO + m * SZ_WFO); }
    else if ((r -= 176) < 160) { d.W = PIN(I_EWI); d.K = 1024; d.ld = 2560; d.dst = (bf16_t*)(ws + WS_WEI); }
    else { r -= 160; d.W = PIN(I_EWO); d.K = 1024; d.ld = 1024; d.dst = (bf16_t*)(ws + WS_WEO); } }
  d.tile = r; return d;
}
__device__ __forceinline__ void conv_wide_list(LAS float* L, const Params& p, int z, unsigned char* ws, int sel, int t0, int tstride) {
  const int total = wide_count(sel); const int tid = ltid(); f32x4 cur[8], nxt[8];
  if (t0 < total) convw_load(wide_desc(p, z, ws, sel, t0), tid, cur);
#pragma unroll 1
  for (int it = t0; it < total; it += tstride) {
    const bool has = it + tstride < total;
    if (has) convw_load(wide_desc(p, z, ws, sel, it + tstride), tid, nxt);
    convw_store(L, wide_desc(p, z, ws, sel, it), tid, cur);
#pragma unroll
    for (int i = 0; i < 8; ++i) cur[i] = nxt[i];
  }
}
__device__ __forceinline__ int small_count(int sel) { return sel == 0 ? 256 : 736; }
__device__ __forceinline__ ConvDesc small_desc(const Params& p, int z, unsigned char* ws, int sel, int it) {
  ConvDesc d; int r = it; d.W2 = nullptr; d.sc = nullptr;
  if (sel == 0) { d.kind = MAP_RG; d.W = PIN(I_RAW); d.W2 = PIN(I_RXW); d.K = 512; d.ld = 0; d.dst = (bf16_t*)(ws + WS_WRG); }
  else if (r < 320) { d.kind = MAP_MLAIN; d.W = PIN(I_MWI); d.K = 1024; d.ld = 1056; d.dst = (bf16_t*)(ws + WS_WMI); }
  else if ((r -= 320) < 288) { d.kind = MAP_QUP; d.W = PIN(I_MWQ); d.sc = PIN(I_MQN); d.K = 768; d.ld = 1536; d.dst = (bf16_t*)(ws + WS_WQU); }
  else if ((r -= 288) < 64) { d.kind = MAP_KUP; d.W = PIN(I_MWKV); d.sc = PIN(I_MKVN); d.K = 256; d.ld = 2048; d.dst = (bf16_t*)(ws + WS_WKU); }
  else { r -= 64; d.kind = MAP_VUP; d.W = PIN(I_MWKV); d.sc = PIN(I_MKVN); d.K = 256; d.ld = 2048; d.dst = (bf16_t*)(ws + WS_WVU); }
  d.tile = r; return d;
}
__device__ __forceinline__ void conv_small_list(LAS float* L, const Params& p, int z, unsigned char* ws, int sel, int t0, int tstride) {
  const int total = small_count(sel); const int tid = ltid(); float cur[8], nxt[8];
  if (t0 < total) conv_load(small_desc(p, z, ws, sel, t0), tid, cur);
#pragma unroll 1
  for (int it = t0; it < total; it += tstride) {
    const bool has = it + tstride < total;
    if (has) conv_load(small_desc(p, z, ws, sel, it + tstride), tid, nxt);
    conv_store(L, small_desc(p, z, ws, sel, it), tid, cur);
#pragma unroll
    for (int i = 0; i < 8; ++i) cur[i] = nxt[i];
  }
}

#define XB_TMO      128
#define XB_XCNT(j)  (256  + 64 * (j))
#define XB_XSUB(j)  (1280 + 64 * (j))
#define XB_XGEN(j)  (2304 + 64 * (j))
#define XB_TOP      3328
#define XB_TOPGEN   3392
#define XCD_BAR_WORDS 3456
#define XB_SPIN_CAP (1u << 18)

__device__ __forceinline__ unsigned xb_ld(unsigned* p)              { return __hip_atomic_load(p, __ATOMIC_RELAXED, __HIP_MEMORY_SCOPE_AGENT); }
__device__ __forceinline__ unsigned xb_add(unsigned* p, unsigned v) { return __hip_atomic_fetch_add(p, v, __ATOMIC_RELAXED, __HIP_MEMORY_SCOPE_AGENT); }
__device__ __forceinline__ unsigned xb_xcc_id() { return (unsigned)__builtin_amdgcn_s_getreg((3 << 11) | 20) & 0xFu; }
#define XB_SPIN(cond, bar) do { unsigned _sp = 0; while (cond) { __builtin_amdgcn_s_sleep(1); \
    if ((++_sp & 255u) == 0u) { if (xb_ld(&(bar)[XB_TMO])) break; if (_sp > XB_SPIN_CAP) { atomicAdd(&(bar)[XB_TMO], 1u); break; } } } } while (0)

struct XcdBarrier {
    unsigned* bar; unsigned x;
    volatile LAS unsigned* st;
};

__device__ __forceinline__ XcdBarrier xcd_barrier_post(unsigned* bar, volatile LAS unsigned* st) {
    XcdBarrier b; b.bar = bar; b.x = xb_xcc_id(); b.st = st;
    if (threadIdx.x == 0) (void)xb_add(&bar[XB_XCNT(b.x)], 1u);
    return b;
}
__device__ __forceinline__ void xcd_barrier_complete(unsigned* bar, unsigned x, unsigned& nloc, unsigned& nx) {
    const unsigned G = gridDim.x * gridDim.y * gridDim.z;
    unsigned sum, cnt, mine, sp = 0u;
    for (;;) {
        sum = 0u; cnt = 0u; mine = 0u;
#pragma unroll
        for (unsigned j = 0; j < 16; ++j) { const unsigned c = xb_ld(&bar[XB_XCNT(j)]); sum += c; cnt += (c > 0u) ? 1u : 0u; mine = (j == x) ? c : mine; }
        if (sum == G) break;
        __builtin_amdgcn_s_sleep(1);
        if ((++sp & 255u) == 0u) { if (xb_ld(&bar[XB_TMO])) break; if (sp > XB_SPIN_CAP) { atomicAdd(&bar[XB_TMO], 1u); break; } }
    }
    nloc = mine > 0u ? mine : 1u; nx = cnt > 0u ? cnt : 1u;
}

__device__ __forceinline__ void xcd_barrier(const XcdBarrier& b) {
    asm volatile("s_waitcnt vmcnt(0)" ::: "memory");
    __syncthreads();
    if (threadIdx.x == 0) {
        unsigned* bar = b.bar;
        __builtin_amdgcn_s_waitcnt(0);
        unsigned nloc = b.st[0], nx = b.st[1];
        if (nloc == 0u) { xcd_barrier_complete(bar, b.x, nloc, nx); b.st[0] = nloc; b.st[1] = nx; }
        const unsigned old = xb_add(&bar[XB_XSUB(b.x)], 1u);
        const unsigned gen = old / nloc;
        if (old + 1u == (gen + 1u) * nloc) {
            __builtin_amdgcn_fence(__ATOMIC_RELEASE, "agent");
            asm volatile("s_waitcnt vmcnt(0)" ::: "memory");
            const unsigned og = xb_add(&bar[XB_TOP], 1u);
            const unsigned tg = og / nx;
            if (og + 1u == (tg + 1u) * nx) xb_add(&bar[XB_TOPGEN], 1u);
            else XB_SPIN(xb_ld(&bar[XB_TOPGEN]) == tg, bar);
            __builtin_amdgcn_fence(__ATOMIC_ACQUIRE, "agent");
            xb_add(&bar[XB_XGEN(b.x)], 1u);
            asm volatile("s_waitcnt vmcnt(0)" ::: "memory");
        } else {
            XB_SPIN(xb_ld(&bar[XB_XGEN(b.x)]) == gen, bar);
            __builtin_amdgcn_fence(__ATOMIC_ACQUIRE, "agent");
            asm volatile("s_waitcnt vmcnt(0)" ::: "memory");
        }
    }
    __syncthreads();
}


__device__ __forceinline__ unsigned char* launder_ptr(const void* q) { unsigned lo = (unsigned)(size_t)q, hi = (unsigned)((size_t)q >> 32); asm volatile("" : "+v"(lo), "+v"(hi));
  lo = __builtin_amdgcn_readfirstlane(lo); hi = __builtin_amdgcn_readfirstlane(hi); return (unsigned char*)(((size_t)hi << 32) | (size_t)lo); }
#define PHASE_BEGIN const int z = 0; unsigned char* ws = tabptr(35); float* xout = (float*)tabptr(34); (void)ws; (void)xout; (void)z
#define P_MOD ((float*)(ws + WS_MOD))
#define P_KF ((float*)(ws + WS_KF))
#define P_KFC ((float*)(ws + WS_KFC))
#define P_XCTX ((float*)(ws + WS_XCTX))
#define P_AGG ((float*)(ws + WS_AGG))
#define P_H ((bf16_t*)(ws + WS_H))
#define P_ACT ((bf16_t*)(ws + WS_ACT))
#define P_G ((bf16_t*)(ws + WS_G))
#define P_XC ((bf16_t*)(ws + WS_XC))
#define P_YT ((bf16_t*)(ws + WS_YT))
#define P_UT ((bf16_t*)(ws + WS_UT))
#define P_URG ((bf16_t*)(ws + WS_URG))
#define P_P ((bf16_t*)(ws + WS_P))
#define P_Q ((bf16_t*)(ws + WS_Q))
#define P_QN ((bf16_t*)(ws + WS_QN))
#define P_KVN ((bf16_t*)(ws + WS_KVN))
#define P_KR ((bf16_t*)(ws + WS_KR))
#define P_K ((bf16_t*)(ws + WS_K))
#define P_VT ((bf16_t*)(ws + WS_VT))
__global__ void __launch_bounds__(512) mk_fwd(Params p) {
  LAS unsigned char* lds = (LAS unsigned char*)lds_raw;
  const int G = gridDim.x, bid = blockIdx.x;
  if (threadIdx.x == 0) { LAS unsigned long long* tab = (LAS unsigned long long*)(lds + TAB_OFF);
#pragma unroll
    for (int i = 0; i < 34; ++i) tab[i] = (unsigned long long)(size_t)p.in[i];
    tab[34] = (unsigned long long)(size_t)p.out; tab[35] = (unsigned long long)(size_t)p.ws; }
  volatile LAS unsigned* bst = (volatile LAS unsigned*)(lds + LDS_BYTES - 16);
  if (threadIdx.x == 0) { bst[0] = 0u; bst[1] = 0u; }
  __syncthreads();
  if (p.ws == nullptr) cg::this_grid().sync();
  (void)xcd_barrier_post((unsigned*)(tabptr(35) + WS_BAR), bst);
#define GSYNC() do { XcdBarrier b_; b_.bar = (unsigned*)(tabptr(35) + WS_BAR); b_.x = xb_xcc_id(); b_.st = (volatile LAS unsigned*)(lds + LDS_BYTES - 16); xcd_barrier(b_); } while (0)

  PROBE_REP(1) {
    PHASE_BEGIN;
    LAS float* L = (LAS float*)lds;
    { bool first = true; for (int job = bid; job < 576; job += G) { adaln_job(L, p, z, P_MOD, job, first); first = false; } }
    for (int job = bid; job < 144; job += G) { if (job < 128) filter_job(L, p, z, P_KF, SEQ, job); else filter_job(L, p, z, P_KFC, CTXL, job - 128); }
    conv_wide_list(L, p, z, ws, 0, bid, G);
    conv_small_list(L, p, z, ws, 0, bid, G);
  }
  GSYNC();
  PROBE_REP(1) { PHASE_BEGIN; row_pass(PIN(I_X), PIN(I_CTX), nullptr, nullptr, nullptr, false, nullptr, nullptr, P_H, P_MOD, 0, NROW, nullptr, nullptr, 0.f, nullptr); }
  GSYNC();

  if (PROBE_MASK & 16) { for (int i = 0; i < 20; ++i) GSYNC(); }
#pragma unroll 1
  for (int st = 0; st < 6; ++st) {
    const int l = st / 3, k = st % 3;
    const int Mrows = (st >= 4) ? NLAT : NROW;
    int rsel;
    if (k != 1) {
      PROBE_REP(64) { PHASE_BEGIN; const int wi = l * 2 + (k == 0 ? 0 : 1);
        Gemm g; g.A = P_H; g.Bt = (const bf16_t*)(ws + WS_WFI + wi * SZ_WFI); g.M = Mrows; g.N = 5632; g.K = 1024; g.kn = 1024;
        StaticOrder S; S.init(g.M, g.N, G, bid); EpiSwiGLU E; E.O = P_ACT; gemm_phase<EpiSwiGLU, StaticOrder, false>(lds, g, S, E, nullptr);
        { PHASE_BEGIN; int wsel = -1, ssel = -1; if (st == 0) wsel = 1; else if (st == 2) wsel = 2; else if (st == 3) { wsel = 3; ssel = 1; }
          const int t0 = G == 256 ? bid - 48 : bid, ts = G == 256 ? 208 : G; LAS float* L = (LAS float*)lds;
          if (rep_ == 0 && t0 >= 0) { if (ssel >= 0) conv_small_list(L, p, z, ws, ssel, t0, ts); if (wsel >= 0) conv_wide_list(L, p, z, ws, wsel, t0, ts); } } }
      GSYNC();
      rsel = 0;
    } else if (l == 0) {
      PROBE_REP(128)
#pragma unroll 1
      for (int gi = 0; gi < 2; ++gi) {
        PHASE_BEGIN; Gemm g; EpiBf16P E; int c;
        if (gi == 0) { g.A = (const bf16_t*)(ws + WS_WEI); g.Bt = P_H; g.M = 1536; g.N = NROW; g.K = 1024; g.kn = 1024; E.O = P_UT; E.ldc = NROW; c = bid; }
        else { g.A = P_H; g.Bt = (const bf16_t*)(ws + WS_WEI) + (size_t)1536 * 1024; g.M = NROW; g.N = 1024; g.K = 1024; g.kn = 1024; E.O = P_URG; E.ldc = 1024; c = (bid + G - (432 % G)) % G; }
        StaticOrder S; S.init(g.M, g.N, G, c); gemm_phase<EpiBf16P, StaticOrder, false>(lds, g, S, E, nullptr);
      }
      GSYNC();
      PROBE_REP(2) { PHASE_BEGIN; xc_build(p, z, P_URG, P_XC);
#pragma unroll 1
        for (int u = bid; u < 1024; u += G) { const bool lat = u < 512; hyena_unit(lds, p, z, P_UT, lat ? P_KF : P_KFC, P_YT, lat ? u : u - 512, lat ? SEQ : CTXL, lat ? 0 : NLAT); } }
      GSYNC();
      PROBE_REP(4) { PHASE_BEGIN;
        for (int job = bid; job < 8 * SC_NC; job += G) { const int tid = ltid(); u32x4 xr[4]; scan_xc_load(P_XC, job, tid, xr); scan_pass_a(lds, p, z, P_XC, (const bf16_t*)(ws + WS_WRG), (unsigned*)P_G, P_AGG, job, tid, xr); }
        for (int job = bid; job < 8 * (NROW / 64); job += G) yt_transpose(lds, P_YT, P_H, job); }
      GSYNC();
      PROBE_REP(4) { PHASE_BEGIN; for (int job = bid; job < 8 * SC_NC; job += G) scan_pass_b(lds, (const unsigned*)P_G, P_URG, P_AGG, P_H, job); }
      GSYNC();
      rsel = 1;
    } else {
      PROBE_REP(256) { PHASE_BEGIN; Gemm g; g.A = P_H; g.Bt = (const bf16_t*)(ws + WS_WMI); g.M = NROW; g.N = 1280; g.K = 1024; g.kn = 1024; EpiBf16P E; E.O = P_P; E.ldc = 1280;
        StaticOrder S; S.init(g.M, g.N, G, bid); gemm_phase<EpiBf16P, StaticOrder, false>(lds, g, S, E, nullptr);
        { PHASE_BEGIN; const int t0 = G == 256 ? bid - 104 : bid, ts = G == 256 ? 152 : G; if (rep_ == 0 && t0 >= 0) conv_wide_list((LAS float*)lds, p, z, ws, 4, t0, ts); } }
      GSYNC();
      { PHASE_BEGIN; mla_rownorm(P_P, P_QN, P_KVN, P_KR); }
      GSYNC();
      PROBE_REP(256) { PHASE_BEGIN; Gemm g; g.A = P_QN; g.Bt = (const bf16_t*)(ws + WS_WQU); g.M = NLAT; g.N = 1536; g.K = 768; g.kn = 768; EpiQ E; E.O = P_Q;
        StaticOrder S; S.init(g.M, g.N, G, bid); gemm_phase<EpiQ, StaticOrder, false>(lds, g, S, E, nullptr); }
      PROBE_REP(256)
#pragma unroll 1
      for (int gi = 0; gi < 2; ++gi) {
        PHASE_BEGIN; Gemm g; EpiBf16P E; int c;
        if (gi == 0) { g.A = P_KVN; g.Bt = (const bf16_t*)(ws + WS_WKU); g.M = NROW; g.N = 1024; g.K = 256; g.kn = 256; E.O = P_K; E.ldc = 1024; c = (bid + G - (384 % G)) % G; }
        else { g.A = (const bf16_t*)(ws + WS_WVU); g.Bt = P_KVN; g.M = 1024; g.N = NROW; g.K = 256; g.kn = 256; E.O = P_VT; E.ldc = NROW; c = (bid + G - ((384 + 288) % G)) % G; }
        StaticOrder S; S.init(g.M, g.N, G, c); gemm_phase<EpiBf16P, StaticOrder, false>(lds, g, S, E, nullptr);
      }
      GSYNC();
      PROBE_REP(8) { PHASE_BEGIN; attn_phase(lds, P_Q, P_K, P_KR, P_VT, P_H); }
      GSYNC();
      rsel = 2;
    }
    PROBE_REP(512) { PHASE_BEGIN; Gemm g; EpiResid E; g.M = NLAT; g.N = 1024; E.Y2 = P_XC; E.mod = P_MOD + (size_t)l * 9 * 9216;
      if (rsel == 0) { g.A = P_ACT; g.Bt = (const bf16_t*)(ws + WS_WFO + (l * 2 + (k == 0 ? 0 : 1)) * SZ_WFO); g.K = 2816; g.kn = 2816; E.gidx = k == 0 ? 2 : 8; E.gs = 0.5f; }
      else if (rsel == 1) { g.A = P_H; g.Bt = (const bf16_t*)(ws + WS_WEO); g.K = 1024; g.kn = 1024; E.gidx = 5; E.gs = 1.0f; }
      else { g.A = P_H; g.Bt = (const bf16_t*)(ws + WS_WMO); g.K = 1024; g.kn = 1024; E.gidx = 5; E.gs = 1.0f; }
      StaticOrder S; S.init(g.M, g.N, G, bid); gemm_phase<EpiResid, StaticOrder, false>(lds, g, S, E, nullptr); }
    if (Mrows == NROW) {
#pragma unroll 1
      for (int s = 0; s < 4; ++s) { PHASE_BEGIN; Gemm g; EpiF32 E; int kt0, ktn; const bf16_t* A; const bf16_t* B;
        if (rsel == 0) { kt0 = s < 2 ? 12 * s : 24 + 10 * (s - 2); ktn = s < 2 ? 12 : 10; A = P_ACT; B = (const bf16_t*)(ws + WS_WFO + (l * 2 + (k == 0 ? 0 : 1)) * SZ_WFO); g.K = 2816; }
        else { kt0 = 4 * s; ktn = 4; A = P_H; B = (const bf16_t*)(ws + WS_WEO); g.K = 1024; }
        g.A = A + (size_t)NLAT * g.K + kt0 * 64; g.Bt = B + kt0 * 64; g.M = NCTX; g.N = 1024; g.kn = ktn * 64;
        E.C = (float*)(ws + WS_G) + (size_t)s * NCTX * D; E.ldc = D; E.bias = nullptr;
        StaticOrder S; S.init(g.M, g.N, G, (bid + G - ((128 + 32 * s) % G)) % G); gemm_phase<EpiF32, StaticOrder, false>(lds, g, S, E, nullptr); }
    }
    GSYNC();
    { PHASE_BEGIN; const float* lg = PIN(I_LNG) + (size_t)(l * 3 + k) * D; const float* lb = PIN(I_LNB) + (size_t)(l * 3 + k) * D;
      const bool hw = st < 5; const float* modn = P_MOD + (size_t)((k < 2) ? l : l + 1) * 9 * 9216; const int sidx = (k < 2) ? 3 * k + 3 : 0;
      const int gidx = k == 0 ? 2 : (k == 1 ? 5 : 8); const float* gate8 = P_MOD + (size_t)l * 9 * 9216 + (size_t)(8 * 9 + gidx) * D;
      _Float16* x16a = (_Float16*)xout; _Float16* x16b = (_Float16*)(ws + WS_G);
      row_pass(PIN(I_X), PIN(I_CTX), st == 0 ? nullptr : (st == 5 ? x16b : x16a), st < 4 ? x16a : (st == 4 ? x16b : nullptr), st == 5 ? xout : nullptr, true, lg, lb, hw ? P_H : nullptr, modn, sidx, Mrows, Mrows == NROW ? (const float*)(ws + WS_G) : nullptr, gate8, k == 1 ? 1.0f : 0.5f, P_XC); }
    if (st < 5) GSYNC();
  }
}

extern "C" void kernel_launch(void* const* d_in, const int* in_sizes, int n_in, void* d_out, int out_size, void* d_ws, size_t ws_size, hipStream_t stream) {
  static int grid_blocks = 0;
  if (!grid_blocks) {
    int dev = 0, cus = 0, per_cu = 0;
    if (n_in != 34 || out_size != NLAT * D || ws_size < WS_END) { fprintf(stderr, "kernel_launch: unexpected problem (n_in %d out %d ws %zu need %zu)\n", n_in, out_size, ws_size, (size_t)WS_END); grid_blocks = -1; return; }
    (void)hipGetDevice(&dev);
    (void)hipDeviceGetAttribute(&cus, hipDeviceAttributeMultiprocessorCount, dev);
    (void)hipFuncSetAttribute((const void*)mk_fwd, hipFuncAttributeMaxDynamicSharedMemorySize, LDS_BYTES);
    (void)hipOccupancyMaxActiveBlocksPerMultiprocessor(&per_cu, (const void*)mk_fwd, 512, LDS_BYTES);
    if (per_cu < 1 || cus < 1) { fprintf(stderr, "kernel_launch: occupancy %d cus %d\n", per_cu, cus); grid_blocks = -1; return; }
    grid_blocks = cus;
  }
  if (grid_blocks < 0) return;
  Params p{};
  for (int i = 0; i < 34; ++i) p.in[i] = (const float*)d_in[i];
  p.out = (float*)d_out; p.ws = (unsigned char*)d_ws;
  if (hipMemsetAsync((unsigned char*)d_ws + WS_BAR, 0, 16384, stream) != hipSuccess) { fprintf(stderr, "kernel_launch: memset of the barrier words failed\n"); return; }
  void* args[] = {&p};
  hipError_t e = hipLaunchCooperativeKernel((const void*)mk_fwd, dim3(grid_blocks), dim3(512), args, LDS_BYTES, stream);
  if (e != hipSuccess) fprintf(stderr, "cooperative launch failed: %s (grid %d)\n", hipGetErrorString(e), grid_blocks);
}
```
